# Optimizing an MI355X kernel written in HIP

```python
import jax, jax.numpy as jnp
from jax import lax
import numpy as np

D_MODEL = 4096
BATCH = 4
SEQ = 4096
DEPTH = 1

N_MEM = 256
EPS = 1e-6

GLA_HEADS = 4
GLA_DK = 256
GLA_DV = 512
GLA_RANK = 16
GLA_TAU = 16.0
GLA_CHUNK = 16
GLA_QK = GLA_HEADS * GLA_DK
GLA_V = GLA_HEADS * GLA_DV

CONV_WIDTH = 2048
CONV_K = 3

XA_HEADS = 4
XA_DH = 512
XA_W = XA_HEADS * XA_DH

N_BRANCH = 3

PEER_HEADS = 8
PEER_NKEYS = 128
PEER_DQ = 256
PEER_TOPK = 16
PEER_EXPERTS = PEER_NKEYS * PEER_NKEYS
PEER_BLOCK = 128

SPLIT_SIZES = (GLA_QK, GLA_QK, GLA_V, GLA_V, GLA_RANK, CONV_WIDTH, CONV_WIDTH, CONV_WIDTH, XA_W, N_BRANCH * D_MODEL)
IN_WIDTH = sum(SPLIT_SIZES)

kernel_name = "hybrid_gla_shortconv_memxattn_peer"


def rms_norm(x, g):
    xf = x.astype(jnp.float32)
    y = xf * lax.rsqrt(jnp.mean(xf * xf, axis=-1, keepdims=True) + EPS)
    return (y * g.astype(jnp.float32)).astype(x.dtype)


def gla_chunked(q, k, v, log_a):
    B, S, H, dk = q.shape
    dv = v.shape[-1]
    n = S // GLA_CHUNK

    def to_chunks(t):
        return t.reshape(B, n, GLA_CHUNK, H, t.shape[-1]).transpose(1, 0, 3, 2, 4).astype(jnp.float32)

    qc, kc, vc, ac = to_chunks(q), to_chunks(k), to_chunks(v), to_chunks(log_a)
    b = jnp.cumsum(ac, axis=3)
    b_last = b[:, :, :, -1:, :]
    q_t = qc * jnp.exp(b) * (dk ** -0.5)
    k_in = kc * jnp.exp(-b)
    k_out = kc * jnp.exp(b_last - b)
    decay = jnp.exp(b_last[:, :, :, 0, :])

    causal = jnp.tril(jnp.ones((GLA_CHUNK, GLA_CHUNK), dtype=bool))
    att = jnp.einsum('nbhtd,nbhsd->nbhts', q_t, k_in)
    att = jnp.where(causal, att, 0.0)
    o_intra = jnp.einsum('nbhts,nbhsv->nbhtv', att, vc)

    def step(state, inp):
        q_i, k_i, v_i, d_i = inp
        o = jnp.einsum('bhtd,bhdv->bhtv', q_i, state)
        state = d_i[..., None] * state + jnp.einsum('bhsd,bhsv->bhdv', k_i, v_i)
        return state, o

    s0 = jnp.zeros((B, H, dk, dv), jnp.float32)
    _, o_inter = lax.scan(step, s0, (q_t, k_out, vc, decay))
    o = (o_intra + o_inter).transpose(1, 0, 3, 2, 4).reshape(B, S, H, dv)
    return o


def causal_short_conv(u, w):
    S = u.shape[1]
    up = jnp.pad(u, ((0, 0), (CONV_K - 1, 0), (0, 0)))
    y = w[0] * up[:, CONV_K - 1:CONV_K - 1 + S]
    for j in range(1, CONV_K):
        y = y + w[j] * up[:, CONV_K - 1 - j:CONV_K - 1 - j + S]
    return y


def memory_cross_attention(q, mem_kv):
    B, S, _ = q.shape
    M = mem_kv.shape[1]
    qh = q.reshape(B, S, XA_HEADS, XA_DH)
    kh = mem_kv[..., :XA_W].reshape(B, M, XA_HEADS, XA_DH)
    vh = mem_kv[..., XA_W:].reshape(B, M, XA_HEADS, XA_DH)
    s = jnp.einsum('bshd,bmhd->bhsm', qh, kh).astype(jnp.float32) * (XA_DH ** -0.5)
    p = jax.nn.softmax(s, axis=-1).astype(vh.dtype)
    o = jnp.einsum('bhsm,bmhd->bshd', p, vh)
    return o.reshape(B, S, XA_W)


def peer(h, w_q, sub_keys, u_tab, v_tab):
    B, S, D = h.shape
    T = B * S
    hf = h.reshape(T, D)
    q = (hf @ w_q).reshape(T, PEER_HEADS, 2, PEER_DQ // 2)
    s = jnp.einsum('thcd,hckd->thck', q, sub_keys).astype(jnp.float32)
    sv, si = lax.top_k(s, PEER_TOPK)
    cand = sv[:, :, 0, :, None] + sv[:, :, 1, None, :]
    cand_idx = si[:, :, 0, :, None] * PEER_NKEYS + si[:, :, 1, None, :]
    cv, ci = lax.top_k(cand.reshape(T, PEER_HEADS, PEER_TOPK * PEER_TOPK), PEER_TOPK)
    eidx = jnp.take_along_axis(cand_idx.reshape(T, PEER_HEADS, PEER_TOPK * PEER_TOPK), ci, axis=-1)
    g = jax.nn.softmax(cv, axis=-1)

    nb = T // PEER_BLOCK
    xb = hf.reshape(nb, PEER_BLOCK, D)
    ib = eidx.reshape(nb, PEER_BLOCK, PEER_HEADS * PEER_TOPK)
    gb = g.reshape(nb, PEER_BLOCK, PEER_HEADS * PEER_TOPK)

    def block(args):
        x_i, idx_i, g_i = args
        u_sel = u_tab[idx_i]
        a = jnp.einsum('tkd,td->tk', u_sel, x_i).astype(jnp.float32)
        wgt = (g_i * jax.nn.gelu(a, approximate=False)).astype(v_tab.dtype)
        v_sel = v_tab[idx_i]
        return jnp.einsum('tk,tkd->td', wgt, v_sel)

    out = lax.map(block, (xb, ib, gb))
    return out.reshape(B, S, D).astype(h.dtype)


def setup_inputs(seed: int = 0) -> dict:
    key = jax.random.key(seed)
    ks = jax.random.split(key, 24)
    f32 = jnp.float32
    D = D_MODEL

    def nrm(k, shape, scale):
        return jax.random.normal(k, shape, f32) * scale

    def gain(k, shape):
        return 1.0 + 0.02 * jax.random.normal(k, shape, f32)

    return {
        "x": jax.random.normal(ks[0], (BATCH, SEQ, D), f32),
        "mem": jax.random.normal(ks[1], (BATCH, N_MEM, D), f32),
        "norm_mix": gain(ks[2], (DEPTH, D)),
        "w_in": nrm(ks[3], (DEPTH, D, IN_WIDTH), D ** -0.5),
        "w_a_up": nrm(ks[4], (DEPTH, GLA_RANK, GLA_QK), GLA_RANK ** -0.5),
        "b_a": nrm(ks[5], (DEPTH, GLA_QK), 0.1),
        "gla_norm": gain(ks[6], (DEPTH, GLA_DV)),
        "conv_w": nrm(ks[7], (DEPTH, CONV_K, CONV_WIDTH), CONV_K ** -0.5),
        "w_br_gla": nrm(ks[8], (DEPTH, GLA_V, D), GLA_V ** -0.5),
        "w_br_conv": nrm(ks[9], (DEPTH, CONV_WIDTH, D), CONV_WIDTH ** -0.5),
        "w_mem_kv": nrm(ks[10], (DEPTH, D, 2 * XA_W), D ** -0.5),
        "w_br_xa": nrm(ks[11], (DEPTH, XA_W, D), XA_W ** -0.5),
        "b_gate": nrm(ks[12], (DEPTH, N_BRANCH * D), 0.1),
        "w_o": nrm(ks[13], (DEPTH, D, D), D ** -0.5),
        "mem_norm": gain(ks[14], (D,)),
        "norm_ffn": gain(ks[15], (DEPTH, D)),
        "peer_wq": nrm(ks[16], (DEPTH, D, PEER_HEADS * PEER_DQ), D ** -0.5),
        "peer_subkeys": nrm(ks[17], (DEPTH, PEER_HEADS, 2, PEER_NKEYS, PEER_DQ // 2), (PEER_DQ // 2) ** -0.5),
        "peer_u": nrm(ks[18], (DEPTH, PEER_EXPERTS, D), D ** -0.5),
        "peer_v": nrm(ks[19], (DEPTH, PEER_EXPERTS, D), (PEER_HEADS * PEER_TOPK) ** -0.5),
        "final_norm": gain(ks[20], (D,)),
    }


def reference(x, mem, norm_mix, w_in, w_a_up, b_a, gla_norm, conv_w, w_br_gla, w_br_conv,
              w_mem_kv, w_br_xa, b_gate, w_o, mem_norm, norm_ffn, peer_wq, peer_subkeys,
              peer_u, peer_v, final_norm):
    B, S, D = x.shape
    split_at = [int(c) for c in np.cumsum(SPLIT_SIZES)[:-1]]
    mem_n = rms_norm(mem, mem_norm)

    for l in range(DEPTH):
        hn = rms_norm(x, norm_mix[l])
        proj = hn @ w_in[l]
        q_g, k_g, v_g, r_g, a_lr, c_b, c_c, c_h, q_x, gates = jnp.split(proj, split_at, axis=-1)

        log_a = jax.nn.log_sigmoid((a_lr @ w_a_up[l] + b_a[l]).astype(jnp.float32)) / GLA_TAU
        o_g = gla_chunked(q_g.reshape(B, S, GLA_HEADS, GLA_DK),
                          k_g.reshape(B, S, GLA_HEADS, GLA_DK),
                          v_g.reshape(B, S, GLA_HEADS, GLA_DV),
                          log_a.reshape(B, S, GLA_HEADS, GLA_DK))
        o_g = rms_norm(o_g, gla_norm[l]).reshape(B, S, GLA_V).astype(x.dtype)
        y_gla = (o_g * jax.nn.silu(r_g)) @ w_br_gla[l]

        y_conv = (c_b * causal_short_conv(c_c * c_h, conv_w[l])) @ w_br_conv[l]

        mem_kv = mem_n @ w_mem_kv[l]
        y_xa = memory_cross_attention(q_x, mem_kv) @ w_br_xa[l]

        g = jax.nn.sigmoid((gates + b_gate[l]).astype(jnp.float32)).astype(x.dtype).reshape(B, S, N_BRANCH, D)
        merged = g[:, :, 0] * y_gla + g[:, :, 1] * y_conv + g[:, :, 2] * y_xa
        x = x + merged @ w_o[l]

        x = x + peer(rms_norm(x, norm_ffn[l]), peer_wq[l], peer_subkeys[l], peer_u[l], peer_v[l])

    return rms_norm(x, final_norm)
```

```cpp
#include <hip/hip_runtime.h>
#include <cstdio>
#include <cstdint>

#define LAS __attribute__((address_space(3)))
typedef unsigned short bf16_t;
typedef short bf16x8 __attribute__((ext_vector_type(8)));
typedef float f32x4 __attribute__((ext_vector_type(4)));
typedef float f32x2 __attribute__((ext_vector_type(2)));
typedef unsigned u32x4 __attribute__((ext_vector_type(4)));
typedef unsigned u32x2 __attribute__((ext_vector_type(2)));
typedef __bf16 bf16x2v __attribute__((ext_vector_type(2)));
typedef int i32x8 __attribute__((ext_vector_type(8)));
typedef int i32x4 __attribute__((ext_vector_type(4)));
typedef unsigned u32x8 __attribute__((ext_vector_type(8)));

constexpr int T = 16384, D = 4096, SEQ = 4096, NBATCH = 4, MEMT = 1024;
constexpr int NPAD = 26880;
constexpr int O_QG = 0, O_KG = 1024, O_VG = 2048, O_RG = 4096, O_CB = 6144, O_CC = 8192, O_CH = 10240, O_QX = 12288, O_GT = 14336, O_AL = 26624;
constexpr float EPS = 1e-6f;
constexpr int GLA_BLK = 74752;

#ifndef I8_MASK
#define I8_MASK 0x7f
#endif
constexpr int SEG_START[9] = {0, 2048, 4096, 6144, 8192, 10240, 12288, 14336, 26624};
constexpr int SEG_BIT[8] = {0, 1, 2, 3, 4, 5, -1, 6};
constexpr bool seg_i8(int s) { return SEG_BIT[s] >= 0 && ((I8_MASK >> SEG_BIT[s]) & 1); }
constexpr size_t seg_pitch(int s) { return SEG_BIT[s] < 0 ? 0 : (seg_i8(s) ? 4096 : 8192); }
constexpr size_t seg_off(int s) { size_t o = 0; for (int t = 0; t < s; ++t) o += (size_t)(SEG_START[t + 1] - SEG_START[t]) * seg_pitch(t); return o; }
constexpr bool V_I8 = seg_i8(1);
constexpr int count_tiles(bool want8) { int n = 0; for (int s = 0; s < 8; ++s) if (s != 1 && SEG_BIT[s] >= 0 && seg_i8(s) == want8) n += (SEG_START[s + 1] - SEG_START[s]) / 256; return n; }
constexpr int NT8 = count_tiles(true), NTB = count_tiles(false);
constexpr int NU_B = 64 * NTB + 64 + (V_I8 ? 0 : 512) + 64, NU_8 = 64 * NT8 + (V_I8 ? 512 : 0);
__device__ __forceinline__ size_t w_row_off(int n) {
    size_t o = 0;
#pragma unroll
    for (int s = 0; s < 8; ++s) if (n >= SEG_START[s] && n < SEG_START[s + 1]) o = seg_off(s) + (size_t)(n - SEG_START[s]) * seg_pitch(s);
    return o;
}
__device__ __forceinline__ bool w_row_is8(int n) {
    bool r = false;
#pragma unroll
    for (int s = 0; s < 8; ++s) if (n >= SEG_START[s] && n < SEG_START[s + 1]) r = seg_i8(s);
    return r;
}
__device__ __forceinline__ int map_tile(int idx, bool want8) {
    int t = 104;
#pragma unroll
    for (int s = 7; s >= 0; --s) { }
    int rem = idx; bool found = false;
#pragma unroll
    for (int s = 0; s < 8; ++s) { if (s == 1 || SEG_BIT[s] < 0 || seg_i8(s) != want8) continue; const int len = (SEG_START[s + 1] - SEG_START[s]) / 256;
        if (!found && rem < len) { t = SEG_START[s] / 256 + rem; found = true; } rem -= len; }
    return t;
}
constexpr size_t MiB = 1u << 20;
constexpr size_t WS_CTL = 0, CTL_BYTES = 1 * MiB;
constexpr size_t WS_MEMN = 1 * MiB, WS_KVM = 9 * MiB  , WS_ALR = 17 * MiB, WS_SUBK = 18 * MiB, WS_EIDX = 19 * MiB, WS_GW = 27 * MiB;
constexpr size_t WS_WBR = 64 * MiB  , WS_WO = 112 * MiB, WS_WPQ = 144 * MiB, WS_WKV = 160 * MiB;
constexpr size_t WS_UB = 192 * MiB, WS_VB = 224 * MiB;
constexpr size_t WS_HN8 = 320 * MiB;
constexpr size_t WS_W8 = 448 * MiB;
constexpr size_t WS_WAL = 56 * MiB;
constexpr size_t WS_SHN = 35 * MiB + 512 * 1024, WS_SW = 35 * MiB + 768 * 1024;
constexpr size_t WS_SWPQ = 35 * MiB + 896 * 1024;
constexpr size_t CTL_CMAXPQ = 384 * 1024;
constexpr size_t CTL_CMAX = 256 * 1024;
constexpr size_t WS_SU = 35 * MiB, WS_SV = WS_SU + 65536, WS_SH = WS_SV + 65536, WS_SHS = WS_SH + 65536;
constexpr size_t WS_H8 = 914 * MiB;
constexpr size_t WS_WTIN = 448 * MiB;
constexpr size_t WS_GLAB = 448 * MiB, WS_PROB = 521 * MiB  , WS_OG = 585 * MiB;
constexpr size_t WS_WQX = 40 * MiB;
constexpr size_t WS_WKT = 384 * MiB;
constexpr size_t WS_VWT = 320 * MiB;
constexpr size_t WS_HN = 658 * MiB;
constexpr size_t WS_MERGED = 658 * MiB;
constexpr size_t WS_QG = 786 * MiB, WS_KG = 818 * MiB, WS_VT = 850 * MiB, WS_RG = 914 * MiB, WS_CB = 978 * MiB, WS_CC = 1042 * MiB, WS_CH = 1106 * MiB, WS_QX = 1170 * MiB;
constexpr size_t WS_GT = 1234 * MiB;
constexpr size_t WS_HQ = 1234 * MiB, WS_PQ = 1362 * MiB;
constexpr size_t WS_END = 1618 * MiB;
static_assert(WS_GLAB + (size_t)16 * 64 * GLA_BLK <= WS_PROB, "gla blocks");

constexpr int LDS_BYTES = 163840;
constexpr int LDS_EX = 131072;
constexpr int LDS_MISC = LDS_BYTES - 256;

__device__ __forceinline__ float bf2f(unsigned b) { return __uint_as_float(b << 16); }
__device__ __forceinline__ float bflo(unsigned w) { return __uint_as_float(w << 16); }
__device__ __forceinline__ float bfhi(unsigned w) { return __uint_as_float(w & 0xffff0000u); }
__device__ __forceinline__ unsigned f2bf(float f) { unsigned u = __float_as_uint(f); return (u + 0x7fffu + ((u >> 16) & 1u)) >> 16; }
__device__ __forceinline__ unsigned pk2(float lo, float hi) { const f32x2 v = {lo, hi}; const bf16x2v b = __builtin_convertvector(v, bf16x2v); return __builtin_bit_cast(unsigned, b); }
__device__ __forceinline__ float dot2bf(unsigned a, unsigned b, float c) { return __builtin_amdgcn_fdot2_f32_bf16(__builtin_bit_cast(bf16x2v, a), __builtin_bit_cast(bf16x2v, b), c, false); }
__device__ __forceinline__ float wave_sum(float v) {
#pragma unroll
    for (int o = 1; o < 64; o <<= 1) v += __shfl_xor(v, o);
    return v;
}
__device__ __forceinline__ float wave_max(float v) {
#pragma unroll
    for (int o = 1; o < 64; o <<= 1) v = fmaxf(v, __shfl_xor(v, o));
    return v;
}
__device__ __forceinline__ float fast_sigmoid(float x) { return __builtin_amdgcn_rcpf(1.0f + __expf(-x)); }
__device__ __forceinline__ float inv_sigmoid(float x) { return 1.0f + __expf(fminf(-x, 69.0f)); }
#define LDS_WAIT() asm volatile("s_waitcnt lgkmcnt(0)" ::: "memory")
#define VM_WAIT() asm volatile("s_waitcnt vmcnt(0)" ::: "memory")

#define XB_TMO      128
#define XB_XCNT(j)  (256  + 64 * (j))
#define XB_XSUB(j)  (1280 + 64 * (j))
#define XB_XGEN(j)  (2304 + 64 * (j))
#define XB_TOP      3328
#define XB_TOPGEN   3392
#define XCD_BAR_WORDS 3456
#define XB_SPIN_CAP (1u << 24)
__device__ __forceinline__ unsigned xb_ld(unsigned* p)              { return __hip_atomic_load(p, __ATOMIC_RELAXED, __HIP_MEMORY_SCOPE_AGENT); }
__device__ __forceinline__ unsigned xb_add(unsigned* p, unsigned v) { return __hip_atomic_fetch_add(p, v, __ATOMIC_RELAXED, __HIP_MEMORY_SCOPE_AGENT); }
__device__ __forceinline__ unsigned xb_xcc_id() { return (unsigned)__builtin_amdgcn_s_getreg((3 << 11) | 20) & 0xFu; }
#define XB_SPIN(cond, bar) do { unsigned _sp = 0; while (cond) { __builtin_amdgcn_s_sleep(1); \
    if ((++_sp & 255u) == 0u) { if (xb_ld(&(bar)[XB_TMO])) break; if (_sp > XB_SPIN_CAP) { atomicAdd(&(bar)[XB_TMO], 1u); break; } } } } while (0)
struct XcdBarrier { unsigned* bar; unsigned x; volatile LAS unsigned* st; };
__device__ __forceinline__ XcdBarrier xcd_barrier_post(unsigned* bar, volatile LAS unsigned* st) {
    XcdBarrier b; b.bar = bar; b.x = xb_xcc_id(); b.st = st;
    if (threadIdx.x == 0) (void)xb_add(&bar[XB_XCNT(b.x)], 1u);
    return b;
}
__device__ __forceinline__ void xcd_barrier_complete(unsigned* bar, unsigned x, unsigned& nloc, unsigned& nx) {
    const unsigned G = gridDim.x * gridDim.y * gridDim.z;
    unsigned sum, cnt, mine, sp = 0u;
    for (;;) {
        sum = 0u; cnt = 0u; mine = 0u;
#pragma unroll
        for (unsigned j = 0; j < 16; ++j) { const unsigned c = xb_ld(&bar[XB_XCNT(j)]); sum += c; cnt += (c > 0u) ? 1u : 0u; mine = (j == x) ? c : mine; }
        if (sum == G) break;
        __builtin_amdgcn_s_sleep(1);
        if ((++sp & 255u) == 0u) { if (xb_ld(&bar[XB_TMO])) break; if (sp > XB_SPIN_CAP) { atomicAdd(&bar[XB_TMO], 1u); break; } }
    }
    nloc = mine > 0u ? mine : 1u; nx = cnt > 0u ? cnt : 1u;
}
__device__ __forceinline__ void xcd_barrier(const XcdBarrier& b) {
    asm volatile("s_waitcnt vmcnt(0)" ::: "memory");
    __syncthreads();
    if (threadIdx.x == 0) {
        unsigned* bar = b.bar;
        __builtin_amdgcn_s_waitcnt(0);
        unsigned nloc = b.st[0], nx = b.st[1];
        if (nloc == 0u) { xcd_barrier_complete(bar, b.x, nloc, nx); b.st[0] = nloc; b.st[1] = nx; }
        const unsigned old = xb_add(&bar[XB_XSUB(b.x)], 1u);
        const unsigned gen = old / nloc;
        if (old + 1u == (gen + 1u) * nloc) {
            __builtin_amdgcn_fence(__ATOMIC_RELEASE, "agent");
            asm volatile("s_waitcnt vmcnt(0)" ::: "memory");
            const unsigned og = xb_add(&bar[XB_TOP], 1u);
            const unsigned tg = og / nx;
            if (og + 1u == (tg + 1u) * nx) xb_add(&bar[XB_TOPGEN], 1u);
            else XB_SPIN(xb_ld(&bar[XB_TOPGEN]) == tg, bar);
            __builtin_amdgcn_fence(__ATOMIC_ACQUIRE, "agent");
            xb_add(&bar[XB_XGEN(b.x)], 1u);
            asm volatile("s_waitcnt vmcnt(0)" ::: "memory");
        } else {
            XB_SPIN(xb_ld(&bar[XB_XGEN(b.x)]) == gen, bar);
            __builtin_amdgcn_fence(__ATOMIC_ACQUIRE, "agent");
            asm volatile("s_waitcnt vmcnt(0)" ::: "memory");
        }
    }
    __syncthreads();
}

namespace gg {
constexpr int BM = 256, BK = 64, HALF = 128, HTB = HALF * BK * 2, STAGE_BYTES = 8 * HTB;
__device__ __forceinline__ int lds_byte(int r, int c) { const int st = (r >> 4) * 2 + (c >> 5), rr = r & 15, cc = c & 31, ob = rr * 64 + cc * 2; return st * 1024 + (ob ^ (((ob >> 9) & 1) << 5)); }
__device__ __forceinline__ void stage_rc(int b, int& R, int& C) { const int st = b / 1024, sb = b % 1024, swz = sb ^ (((sb >> 9) & 1) << 5); R = (st >> 1) * 16 + swz / 64; C = (st & 1) * 32 + (swz % 64) / 2; }
__device__ __forceinline__ int perm32(int rho) { const int n = rho >> 4, i = rho & 15; return 8 * (i >> 2) + 4 * n + (i & 3); }
struct Unit { const char* A; const char* B; int kind, pm, pn, aux; };
typedef f32x4 Acc[2][2][4][2];

template <int MODE, bool RX = false, class Epi, class Sched>
__device__ __forceinline__ void gemm_phase(LAS unsigned char* lds, const int ldaB, const int ldbB, const int nt, const Sched& S, const Epi& E) {
    int tid = threadIdx.x; asm volatile("" : "+v"(tid));
    const int wid = __builtin_amdgcn_readfirstlane(tid >> 6), lane = tid & 63, wr = wid >> 2, wc = wid & 3, fr = lane & 15, fq = lane >> 4;
    unsigned voffA[2], voffB[2];
#pragma unroll
    for (int i = 0; i < 2; ++i) { int R, C; stage_rc(tid * 16 + i * 8192, R, C); const int Rb = (R & ~31) + perm32(R & 31);
        voffA[i] = (unsigned)(R * ldaB + C * 2); voffB[i] = (unsigned)(Rb * ldbB + C * 2); }
    const size_t kstep = (size_t)(BK * 2);
    const size_t hstepA = (size_t)HALF * ldaB, hstepB = (size_t)HALF * ldbB;
    const unsigned ldsw = (unsigned)wid * 1024u;
    const int aoff = lds_byte(wr * 64 + fr, fq * 8), boff = lds_byte(wc * 32 + fr, fq * 8);
#define PG8_SA(b, h) (((b) * 2 + (h)) * HTB)
#define PG8_SB(b, h) ((4 + (b) * 2 + (h)) * HTB)
#define PG8_STAGE(bufoff, gbase, voff) do { _Pragma("unroll") for (int _i = 0; _i < 2; ++_i) \
        __builtin_amdgcn_global_load_lds((const unsigned*)((const char*)(gbase) + (voff)[_i]), (LAS unsigned*)(lds + (bufoff) + ldsw + _i * 8192), 16, 0, 0); } while (0)
#define PG8_LDA(dst, b, h) do { _Pragma("unroll") for (int m = 0; m < 4; ++m) { if constexpr (MODE == 1) { const u32x4 p0_ = *(const LAS u32x4*)(lds + PG8_SA(b, h) + aoff + m * 2048), p1_ = *(const LAS u32x4*)(lds + PG8_SA(b, h) + aoff + m * 2048 + 1024); \
        dst##8[m] = __builtin_shufflevector(p0_, p1_, 0, 1, 2, 3, 4, 5, 6, 7); } else { _Pragma("unroll") for (int k = 0; k < 2; ++k) dst[m][k] = *(const LAS bf16x8*)(lds + PG8_SA(b, h) + aoff + m * 2048 + k * 1024); } } } while (0)
#define PG8_LDB(dst, b, h) do { _Pragma("unroll") for (int n = 0; n < 2; ++n) { if constexpr (MODE == 1) { const u32x4 p0_ = *(const LAS u32x4*)(lds + PG8_SB(b, h) + boff + n * 2048), p1_ = *(const LAS u32x4*)(lds + PG8_SB(b, h) + boff + n * 2048 + 1024); \
        dst##8[n] = __builtin_shufflevector(p0_, p1_, 0, 1, 2, 3, 4, 5, 6, 7); } else { _Pragma("unroll") for (int k = 0; k < 2; ++k) dst[n][k] = *(const LAS bf16x8*)(lds + PG8_SB(b, h) + boff + n * 2048 + k * 1024); } } } while (0)
#define PG8_MMA(ai, bj, At, Bt) do { __builtin_amdgcn_s_setprio(1); _Pragma("unroll") for (int m = 0; m < 4; ++m) _Pragma("unroll") for (int n = 0; n < 2; ++n) { \
        if constexpr (MODE == 1) { asm volatile("v_mfma_scale_f32_16x16x128_f8f6f4 %0, %1, %2, %0, %3, %3 op_sel_hi:[0,0,0]" : "+v"(acc[ai][bj][m][n]) : "v"(Bt##8[n]), "v"(At##8[m]), "v"(sc127)); } \
        else if constexpr (MODE == 2) { _Pragma("unroll") for (int k = 0; k < 2; ++k) acc[ai][bj][m][n] = __builtin_bit_cast(f32x4, __builtin_amdgcn_mfma_i32_16x16x64_i8(__builtin_bit_cast(i32x4, Bt[n][k]), __builtin_bit_cast(i32x4, At[m][k]), __builtin_bit_cast(i32x4, acc[ai][bj][m][n]), 0, 0, 0)); } \
        else { _Pragma("unroll") for (int k = 0; k < 2; ++k) acc[ai][bj][m][n] = __builtin_amdgcn_mfma_f32_16x16x32_bf16(Bt[n][k], At[m][k], acc[ai][bj][m][n], 0, 0, 0); } } \
        __builtin_amdgcn_s_setprio(0); } while (0)
#define PG8_WAIT_V(n) asm volatile("s_waitcnt vmcnt(" #n ")" ::: "memory")
#define PG8_WAIT_V2(flag) asm volatile("s_cmp_lg_u32 %0, 0\n\ts_cbranch_scc1 1f\n\ts_waitcnt vmcnt(8)\n\ts_branch 2f\n1:\n\ts_waitcnt vmcnt(24)\n2:" :: "s"(flag) : "scc", "memory")
#define PG8_WAIT_L(n) asm volatile("s_waitcnt lgkmcnt(" #n ")" ::: "memory")
#define PG8_BAR __builtin_amdgcn_s_barrier()
#define PG8_SCHED __builtin_amdgcn_sched_barrier(0)
    Unit cur, nxt; int ui = 0;
    if (!S.next(0, cur)) return;
    Acc acc;
#pragma unroll
    for (int a = 0; a < 2; ++a)
#pragma unroll
        for (int b = 0; b < 2; ++b)
#pragma unroll
            for (int m = 0; m < 4; ++m)
#pragma unroll
                for (int n = 0; n < 2; ++n) acc[a][b][m][n] = (f32x4){0.f, 0.f, 0.f, 0.f};
    bf16x8 At[4][2], B0[2][2], B1[2][2]; u32x8 At8[4], B08[2], B18[2]; const int sc127 = 127;
    const char* cA = cur.A; const char* cB = cur.B;
    PG8_STAGE(PG8_SB(0, 0), cB, voffB); PG8_STAGE(PG8_SB(0, 1), cB + hstepB, voffB); PG8_STAGE(PG8_SA(0, 0), cA, voffA); PG8_STAGE(PG8_SA(0, 1), cA + hstepA, voffA);
    if (wr == 1) PG8_BAR;
    PG8_WAIT_V(2); PG8_BAR;
    PG8_STAGE(PG8_SB(1, 0), cB + kstep, voffB); PG8_STAGE(PG8_SA(1, 0), cA + kstep, voffA); PG8_STAGE(PG8_SB(1, 1), cB + hstepB + kstep, voffB);
    PG8_WAIT_V(6); PG8_BAR;
    bool relax = false;
    for (;;) {
        const bool has_next = S.next(ui + 1, nxt);
        const char* nA = has_next ? nxt.A : cA; const char* nB = has_next ? nxt.B : cB;
        const int unt = cur.aux ? cur.aux : nt;
#define PG8_PAIR(W0) { \
            const bool last = (t == unt - 2); const int rxf = __builtin_amdgcn_readfirstlane((relax && t == 0) ? 1 : 0); \
            const char* a1 = cA + (size_t)(t + 1) * kstep; \
            const char* a2 = last ? nA : cA + (size_t)(t + 2) * kstep; const char* b2 = last ? nB : cB + (size_t)(t + 2) * kstep; \
            const char* a3 = a2 + kstep; const char* b3 = b2 + kstep; \
              \
            PG8_LDB(B0, 0, 0); PG8_LDB(B1, 0, 1); PG8_SCHED; PG8_LDA(At, 0, 0); PG8_STAGE(PG8_SA(1, 1), a1 + hstepA, voffA); \
            if constexpr (RX) PG8_WAIT_V2(rxf); else PG8_WAIT_V(8); PG8_WAIT_L(0); PG8_BAR; PG8_MMA(0, 0, At, B0); PG8_MMA(0, 1, At, B1); PG8_BAR; PG8_SCHED; \
              \
            PG8_LDA(At, 0, 1); PG8_STAGE(PG8_SB(0, 0), b2, voffB); PG8_STAGE(PG8_SB(0, 1), b2 + hstepB, voffB); PG8_STAGE(PG8_SA(0, 0), a2, voffA); \
            if constexpr (RX) PG8_WAIT_V2(rxf); else PG8_WAIT_V(8); PG8_WAIT_L(0); PG8_BAR; PG8_MMA(1, 0, At, B0); PG8_MMA(1, 1, At, B1); PG8_BAR; PG8_SCHED; \
              \
            PG8_LDB(B0, 1, 0); PG8_LDB(B1, 1, 1); PG8_SCHED; PG8_LDA(At, 1, 0); PG8_STAGE(PG8_SA(0, 1), a2 + hstepA, voffA); \
            PG8_WAIT_V(8); PG8_WAIT_L(0); PG8_BAR; PG8_MMA(0, 0, At, B0); PG8_MMA(0, 1, At, B1); PG8_BAR; PG8_SCHED; \
              \
            PG8_LDA(At, 1, 1); PG8_STAGE(PG8_SB(1, 0), b3, voffB); PG8_STAGE(PG8_SB(1, 1), b3 + hstepB, voffB); PG8_STAGE(PG8_SA(1, 0), a3, voffA); \
            PG8_WAIT_V(8); PG8_WAIT_L(0); PG8_BAR; PG8_MMA(1, 0, At, B0); PG8_MMA(1, 1, At, B1); PG8_BAR; PG8_SCHED; }
        for (int t = 0; t < unt; t += 2) PG8_PAIR(8)
#undef PG8_PAIR
        if constexpr (MODE == 1) asm volatile("s_nop 15\n\ts_nop 15" ::: "memory");
        if (wr == 0) PG8_BAR;
        const bool reset = E(acc, cur, wr, wc, fr, fq, wid, lane);
        if constexpr (RX) relax = (E.nst(cur) >= 16);
        asm volatile("" ::: "memory");
        if (!has_next) break;
        if (reset) {
#pragma unroll
            for (int a = 0; a < 2; ++a)
#pragma unroll
                for (int b = 0; b < 2; ++b)
#pragma unroll
                    for (int m = 0; m < 4; ++m)
#pragma unroll
                        for (int n = 0; n < 2; ++n) acc[a][b][m][n] = (f32x4){0.f, 0.f, 0.f, 0.f};
        }
        cur = nxt; cA = nA; cB = nB; ++ui;
        if (wr == 1) PG8_BAR;
    }
    PG8_WAIT_V(0);
    PG8_BAR;
#undef PG8_SA
#undef PG8_SB
#undef PG8_STAGE
#undef PG8_LDA
#undef PG8_LDB
#undef PG8_MMA
#undef PG8_WAIT_V
#undef PG8_WAIT_L
#undef PG8_BAR
#undef PG8_SCHED
}

__device__ __forceinline__ bool tile_order(long L, int nM, int nN, int& pm, int& pn) {
    const int nwg = nM * nN; if (L >= nwg) return false;
    const int q = nwg / 8, xcd = (int)(L % 8), off = (int)(L / 8); const int wgid = xcd * q + off;
    const int nig = 8 * nN, gid = wgid / nig, fm = gid * 8;
    pm = fm + ((wgid % nig) % 8); pn = (wgid % nig) / 8; return true;
}
__device__ __forceinline__ void store_bf16_tile(const Acc& acc, bf16_t* base, int ldc, int row0, int col0, int wr, int wc, int fr, int fq) {
#pragma unroll
    for (int ai = 0; ai < 2; ++ai)
#pragma unroll
        for (int m = 0; m < 4; ++m) { bf16_t* rowp = base + (size_t)(row0 + ai * HALF + wr * 64 + m * 16 + fr) * ldc + col0 + wc * 32 + 8 * fq;
#pragma unroll
            for (int bj = 0; bj < 2; ++bj) { const f32x4 v0 = acc[ai][bj][m][0], v1 = acc[ai][bj][m][1];
                u32x4 w; w.x = pk2(v0[0], v0[1]); w.y = pk2(v0[2], v0[3]); w.z = pk2(v1[0], v1[1]); w.w = pk2(v1[2], v1[3]);
                *(u32x4*)(rowp + bj * HALF) = w; } }
}
}

struct Args { const float* in[21]; float* out; unsigned char* ws; };
struct Frame {
    LAS unsigned char* lds;
    int tid, lane, wave, G, bid;
    unsigned char* ws;
    __device__ __forceinline__ void refresh() { int t = threadIdx.x; asm volatile("" : "+v"(t)); tid = t; lane = t & 63; wave = __builtin_amdgcn_readfirstlane(t >> 6); }
};

__device__ __forceinline__ int src_col(int n) { return n < 6144 ? n : (n < O_AL ? n + 16 : (n < O_AL + 16 ? n - O_AL + 6144 : -1)); }
__device__ __forceinline__ void transpose_item(const float* W, int K, int N, int NT, bf16_t* WT, LAS float* scr, int item, int lane, bool remap, unsigned char* W8 = nullptr, bf16_t* WQ = nullptr, const unsigned* cmax = nullptr, float* sw = nullptr, bool i8perm = false) {
    const int nblk = NT / 32, kb = item / nblk, nb = item % nblk, k0 = 64 * kb, n0 = 32 * nb;
    const int q = lane & 7, r8 = lane >> 3;
    const int n = n0 + 4 * q; const int src = remap ? src_col(n) : n;
    f32x4 v[8];
#pragma unroll
    for (int i = 0; i < 8; ++i) v[i] = (src >= 0) ? *(const f32x4*)(W + (size_t)(k0 + 8 * i + r8) * N + src) : (f32x4){0.f, 0.f, 0.f, 0.f};
    if (remap && n0 >= O_QX && n0 < O_GT) {
#pragma unroll
        for (int i = 0; i < 8; ++i) *(u32x2*)(WQ + (size_t)(k0 + 8 * i + r8) * 2048 + (n0 - O_QX) + 4 * q) = (u32x2){pk2(v[i].x, v[i].y), pk2(v[i].z, v[i].w)};
        return;
    }
#pragma unroll
    for (int i = 0; i < 8; ++i) { LAS float* d = scr + (8 * i + r8) * 33 + 4 * q; d[0] = v[i].x; d[1] = v[i].y; d[2] = v[i].z; d[3] = v[i].w; }
    LDS_WAIT(); asm volatile("" ::: "memory");
    const int c = lane & 7;
    if (i8perm) {
#pragma unroll
        for (int j = 0; j < 4; ++j) { const int nn = (lane >> 3) + 8 * j; const LAS float* s = scr + (8 * c) * 33 + nn;
            const float mx = fmaxf(__uint_as_float(xb_ld((unsigned*)cmax + n0 + nn)), 1e-30f), inv = 127.0f / mx;
            int qv[8];
#pragma unroll
            for (int e = 0; e < 8; ++e) qv[e] = (int)rintf(s[e * 33] * inv) & 255;
            *(u32x2*)(W8 + (size_t)(n0 + nn) * K + k0 + 8 * c) = (u32x2){(unsigned)(qv[0] | (qv[2] << 8) | (qv[4] << 16) | (qv[6] << 24)), (unsigned)(qv[1] | (qv[3] << 8) | (qv[5] << 16) | (qv[7] << 24))};
            if (kb == 0 && c == 0) sw[n0 + nn] = mx * (1.0f / 127.0f); }
    } else if (remap && n0 < O_AL && w_row_is8(n0)) {
#pragma unroll
        for (int j = 0; j < 4; ++j) { const int nn = (lane >> 3) + 8 * j; const LAS float* s = scr + (8 * c) * 33 + nn;
            const float mx = fmaxf(__uint_as_float(xb_ld((unsigned*)cmax + src_col(n0 + nn))), 1e-30f), inv = 127.0f / mx;
            int qv[8];
#pragma unroll
            for (int e = 0; e < 8; ++e) qv[e] = (int)rintf(s[e * 33] * inv) & 255;
            *(u32x2*)(W8 + w_row_off(n0 + nn) + k0 + 8 * c) = (u32x2){(unsigned)(qv[0] | (qv[1] << 8) | (qv[2] << 16) | (qv[3] << 24)), (unsigned)(qv[4] | (qv[5] << 8) | (qv[6] << 16) | (qv[7] << 24))};
            if (kb == 0 && c == 0) sw[n0 + nn] = mx * (1.0f / 127.0f); }
    } else if (remap && n0 < O_AL) {
#pragma unroll
        for (int j = 0; j < 4; ++j) { const int nn = (lane >> 3) + 8 * j; const LAS float* s = scr + (8 * c) * 33 + nn;
            u32x4 o; o.x = pk2(s[0 * 33], s[1 * 33]); o.y = pk2(s[2 * 33], s[3 * 33]); o.z = pk2(s[4 * 33], s[5 * 33]); o.w = pk2(s[6 * 33], s[7 * 33]);
            *(u32x4*)(W8 + w_row_off(n0 + nn) + (size_t)(k0 + 8 * c) * 2) = o; }
    } else {
        const int rowoff = remap ? O_AL : 0;
#pragma unroll
        for (int j = 0; j < 4; ++j) { const int nn = (lane >> 3) + 8 * j; const LAS float* s = scr + (8 * c) * 33 + nn;
            u32x4 o; o.x = pk2(s[0 * 33], s[1 * 33]); o.y = pk2(s[2 * 33], s[3 * 33]); o.z = pk2(s[4 * 33], s[5 * 33]); o.w = pk2(s[6 * 33], s[7 * 33]);
            *(u32x4*)(WT + (size_t)(n0 - rowoff + nn) * K + k0 + 8 * c) = o; }
    }
    LDS_WAIT(); asm volatile("" ::: "memory");
}
__device__ __forceinline__ void rms_row_bf16(const float* xrow, const float* gain, bf16_t* orow, int lane) {
    const f32x4* xr = (const f32x4*)xrow + lane;
    f32x4 v[16]; float s = 0.f;
#pragma unroll
    for (int j = 0; j < 16; ++j) { v[j] = xr[64 * j]; s += (v[j].x * v[j].x + v[j].y * v[j].y) + (v[j].z * v[j].z + v[j].w * v[j].w); }
    const float rstd = rsqrtf(wave_sum(s) * (1.f / D) + EPS);
    u32x2* o8 = (u32x2*)orow + lane; const f32x4* gr = (const f32x4*)gain + lane;
#pragma unroll
    for (int j = 0; j < 16; ++j) { const f32x4 g = gr[64 * j]; u32x2 w; w.x = pk2(v[j].x * rstd * g.x, v[j].y * rstd * g.y); w.y = pk2(v[j].z * rstd * g.z, v[j].w * rstd * g.w); o8[64 * j] = w; }
}
__device__ __forceinline__ void rms_row_bf16_i8n(const float* xrow, const float* gain, bf16_t* orow, unsigned char* o8row, float* scale, int lane) {
    const f32x4* xr = (const f32x4*)xrow + lane;
    f32x4 v[16]; float s = 0.f;
#pragma unroll
    for (int j = 0; j < 16; ++j) { v[j] = xr[64 * j]; s += (v[j].x * v[j].x + v[j].y * v[j].y) + (v[j].z * v[j].z + v[j].w * v[j].w); }
    const float rstd = rsqrtf(wave_sum(s) * (1.f / D) + EPS);
    u32x2* o8 = (u32x2*)orow + lane; const f32x4* gr = (const f32x4*)gain + lane; float m = 0.f;
#pragma unroll
    for (int j = 0; j < 16; ++j) { const f32x4 g = gr[64 * j]; v[j].x *= rstd * g.x; v[j].y *= rstd * g.y; v[j].z *= rstd * g.z; v[j].w *= rstd * g.w;
        u32x2 w; w.x = pk2(v[j].x, v[j].y); w.y = pk2(v[j].z, v[j].w); o8[64 * j] = w;
        m = fmaxf(m, fmaxf(fmaxf(fabsf(v[j].x), fabsf(v[j].y)), fmaxf(fabsf(v[j].z), fabsf(v[j].w)))); }
    m = fmaxf(wave_max(m), 1e-30f); const float inv = 127.0f / m;
    if (lane == 0) *scale = m * (1.0f / 127.0f);
    unsigned* o4 = (unsigned*)o8row + lane;
#pragma unroll
    for (int j = 0; j < 16; ++j) { const int q0 = (int)rintf(v[j].x * inv), q1 = (int)rintf(v[j].y * inv), q2 = (int)rintf(v[j].z * inv), q3 = (int)rintf(v[j].w * inv);
        o4[64 * j] = (unsigned)(q0 & 255) | ((unsigned)(q1 & 255) << 8) | ((unsigned)(q2 & 255) << 16) | ((unsigned)(q3 & 255) << 24); }
}
__device__ __forceinline__ void rms_row_i8(const float* xrow, const float* gain, unsigned char* o8row, float* scale, float* hsum, int lane) {
    const f32x4* xr = (const f32x4*)xrow + 2 * lane;
    f32x4 v[16]; float s = 0.f;
#pragma unroll
    for (int j = 0; j < 8; ++j) { v[2 * j] = xr[128 * j]; v[2 * j + 1] = xr[128 * j + 1]; }
#pragma unroll
    for (int j = 0; j < 16; ++j) s += (v[j].x * v[j].x + v[j].y * v[j].y) + (v[j].z * v[j].z + v[j].w * v[j].w);
    const float rstd = rsqrtf(wave_sum(s) * (1.f / D) + EPS);
    const f32x4* gr = (const f32x4*)gain + 2 * lane; float m = 0.f;
#pragma unroll
    for (int j = 0; j < 8; ++j) {
#pragma unroll
        for (int q = 0; q < 2; ++q) { const f32x4 g = gr[128 * j + q]; f32x4& x = v[2 * j + q]; x.x *= rstd * g.x; x.y *= rstd * g.y; x.z *= rstd * g.z; x.w *= rstd * g.w;
            m = fmaxf(m, fmaxf(fmaxf(fabsf(x.x), fabsf(x.y)), fmaxf(fabsf(x.z), fabsf(x.w)))); }
        }
    m = fmaxf(wave_max(m), 1e-30f); const float inv = 127.0f / m;
    int isum = 0;
#pragma unroll
    for (int j = 0; j < 8; ++j) { const f32x4 a = v[2 * j], b = v[2 * j + 1];
        const int q0 = (int)rintf(a.x * inv), q1 = (int)rintf(a.y * inv), q2 = (int)rintf(a.z * inv), q3 = (int)rintf(a.w * inv), q4 = (int)rintf(b.x * inv), q5 = (int)rintf(b.y * inv), q6 = (int)rintf(b.z * inv), q7 = (int)rintf(b.w * inv);
        isum += (q0 + q1) + (q2 + q3) + (q4 + q5) + (q6 + q7);
        u32x2 w; w.x = (unsigned)(q0 & 255) | ((unsigned)(q2 & 255) << 8) | ((unsigned)(q4 & 255) << 16) | ((unsigned)(q6 & 255) << 24);
        w.y = (unsigned)(q1 & 255) | ((unsigned)(q3 & 255) << 8) | ((unsigned)(q5 & 255) << 16) | ((unsigned)(q7 & 255) << 24);
        ((u32x2*)o8row)[lane + 64 * j] = w; }
#pragma unroll
    for (int o = 1; o < 64; o <<= 1) isum += __shfl_xor(isum, o);
    if (lane == 0) { *scale = m * (1.0f / 127.0f); *hsum = (float)isum; }
}
__device__ __forceinline__ void cvt_table(const float* src, bf16_t* dst, size_t n8, size_t gt, size_t ngt) {
    for (size_t i = gt; i < n8; i += ngt) { const f32x4 a = ((const f32x4*)src)[2 * i], b = ((const f32x4*)src)[2 * i + 1];
        u32x4 w; w.x = pk2(a.x, a.y); w.y = pk2(a.z, a.w); w.z = pk2(b.x, b.y); w.w = pk2(b.z, b.w); ((u32x4*)dst)[i] = w; }
}
__device__ __forceinline__ void quant_row_i4(const float* xrow, unsigned char* orow, float* scale, int lane) {
    const f32x4* xr = (const f32x4*)xrow + 2 * lane;
    f32x4 v[16]; float s = 0.f;
#pragma unroll
    for (int j = 0; j < 8; ++j) { v[2 * j] = xr[128 * j]; v[2 * j + 1] = xr[128 * j + 1]; }
#pragma unroll
    for (int j = 0; j < 16; ++j) s += (v[j].x * v[j].x + v[j].y * v[j].y) + (v[j].z * v[j].z + v[j].w * v[j].w);
    const float sc = fmaxf(2.5f * sqrtf(wave_sum(s) * (1.f / D)) * (1.f / 7.f), 1e-30f), inv = 1.0f / sc;
    if (lane == 0) *scale = sc;
    unsigned* o4 = (unsigned*)orow + lane;
#pragma unroll
    for (int j = 0; j < 8; ++j) { const f32x4 a = v[2 * j], b = v[2 * j + 1]; const float e[8] = {a.x, a.y, a.z, a.w, b.x, b.y, b.z, b.w}; unsigned w = 0u;
#pragma unroll
        for (int i = 0; i < 8; ++i) { const int q = (int)fminf(fmaxf(rintf(e[i] * inv), -7.f), 7.f) + 8; w |= (unsigned)q << (4 * i); }
        o4[64 * j] = w; }
}
__device__ __forceinline__ int nth_block(int j, bool want8) {
    int nb = -1;
#pragma unroll
    for (int s = 0; s < 9; ++s) { const int b0 = (s < 8 ? SEG_START[s] : O_AL) / 32, b1 = (s < 8 ? SEG_START[s + 1] : NPAD) / 32; const bool is8 = s < 8 && seg_i8(s);
        if (is8 == want8) { if (nb < 0 && j >= 0 && j < b1 - b0) nb = b0 + j; j -= (b1 - b0); } }
    return nb;
}
constexpr int count_blocks8() { int n = 0; for (int s = 0; s < 8; ++s) if (seg_i8(s)) n += (SEG_START[s + 1] - SEG_START[s]) / 32; return n; }
constexpr int NB8 = count_blocks8(), NBX = NPAD / 32 - NB8;
__device__ __forceinline__ void p0_prologue_a(Frame& F, const Args& a) {
    LAS float* scr = (LAS float*)(F.lds + F.wave * 16384);
    const int gw = F.bid * 8 + F.wave, NGW = F.G * 8;
    unsigned char* ws = F.ws;
    constexpr int I_BR = 32 * 128, I_O = 64 * 128, I_KV = 64 * 128;
    constexpr int I_X = 64 * NBX;
    constexpr int NITEMS = 3 * I_BR + I_O + I_KV + I_X;
    for (int it = gw; it < NITEMS; it += NGW) {
        int r = it;
        if (r < I_X) { const int nb = nth_block(r >> 6, false); transpose_item(a.in[3], D, 26640, NPAD, (bf16_t*)(ws + WS_WAL), scr, (r & 63) * (NPAD / 32) + nb, F.lane, true, ws + WS_W8, (bf16_t*)(ws + WS_WQX), (const unsigned*)(ws + WS_CTL + CTL_CMAX), (float*)(ws + WS_SW)); continue; } r -= I_X;
        if (r < I_BR) { transpose_item(a.in[8], 2048, D, D, (bf16_t*)(ws + WS_WBR), scr, r, F.lane, false); continue; } r -= I_BR;
        if (r < I_BR) { transpose_item(a.in[9], 2048, D, D, (bf16_t*)(ws + WS_WBR + 16 * MiB), scr, r, F.lane, false); continue; } r -= I_BR;
        if (r < I_BR) { transpose_item(a.in[11], 2048, D, D, (bf16_t*)(ws + WS_WBR + 32 * MiB), scr, r, F.lane, false); continue; } r -= I_BR;
        if (r < I_O) { transpose_item(a.in[13], D, D, D, (bf16_t*)(ws + WS_WO), scr, r, F.lane, false); continue; } r -= I_O;
        transpose_item(a.in[10], D, D, D, (bf16_t*)(ws + WS_WKV), scr, r, F.lane, false);
    }
    for (int m = gw; m < T; m += NGW) rms_row_bf16_i8n(a.in[0] + (size_t)m * D, a.in[2], (bf16_t*)(ws + WS_HN) + (size_t)m * D, ws + WS_HN8 + (size_t)m * D, (float*)(ws + WS_SHN) + m, F.lane);
    for (int m = gw; m < MEMT; m += NGW) rms_row_bf16(a.in[1] + (size_t)m * D, a.in[14], (bf16_t*)(ws + WS_MEMN) + (size_t)m * D, F.lane);
    const size_t gt = (size_t)F.bid * 512 + F.tid, ngt = (size_t)F.G * 512;
    cvt_table(a.in[17], (bf16_t*)(ws + WS_SUBK), (size_t)8 * 2 * 128 * 128 / 8, gt, ngt);
    { unsigned* cmq = (unsigned*)(ws + WS_CTL + CTL_CMAXPQ);
      for (int u = F.bid; u < 256; u += F.G) { const float* wp = a.in[16] + (size_t)(16 * u) * 2048 + 4 * F.tid; f32x4 m = (f32x4){0.f, 0.f, 0.f, 0.f};
#pragma unroll
          for (int r = 0; r < 16; ++r) { const f32x4 v = *(const f32x4*)(wp + (size_t)r * 2048); m.x = fmaxf(m.x, fabsf(v.x)); m.y = fmaxf(m.y, fabsf(v.y)); m.z = fmaxf(m.z, fabsf(v.z)); m.w = fmaxf(m.w, fabsf(v.w)); }
          atomicMax(cmq + 4 * F.tid + 0, __float_as_uint(m.x)); atomicMax(cmq + 4 * F.tid + 1, __float_as_uint(m.y)); atomicMax(cmq + 4 * F.tid + 2, __float_as_uint(m.z)); atomicMax(cmq + 4 * F.tid + 3, __float_as_uint(m.w)); } }
}
__device__ __forceinline__ void p0_weights8(Frame& F, const Args& a) {
    LAS float* scr = (LAS float*)(F.lds + F.wave * 16384); LAS float* smax = (LAS float*)(F.lds + 131072); LAS float* bmax = smax + 256;
    unsigned char* ws = F.ws; const int lane = F.lane, q = lane & 7, r8 = lane >> 3, c = lane & 7;
    const float* W = a.in[3]; float* sw = (float*)(ws + WS_SW);
    for (int b = F.bid; b < NB8; b += F.G) {
        const int nb = nth_block(b, true), n0 = 32 * nb, src = src_col(n0 + 4 * q);
        const float* wp = W + (size_t)(512 * F.wave + r8) * 26640 + src;
        f32x4 mx = (f32x4){0.f, 0.f, 0.f, 0.f};
#pragma unroll 1
        for (int h = 0; h < 2; ++h) { f32x4 v[32];
#pragma unroll
            for (int i = 0; i < 32; ++i) v[i] = *(const f32x4*)(wp + (size_t)(256 * h + 8 * i) * 26640);
#pragma unroll
            for (int i = 0; i < 32; ++i) { mx.x = fmaxf(mx.x, fabsf(v[i].x)); mx.y = fmaxf(mx.y, fabsf(v[i].y)); mx.z = fmaxf(mx.z, fabsf(v[i].z)); mx.w = fmaxf(mx.w, fabsf(v[i].w)); } }
#pragma unroll
        for (int o_ = 8; o_ < 64; o_ <<= 1) { mx.x = fmaxf(mx.x, __shfl_xor(mx.x, o_)); mx.y = fmaxf(mx.y, __shfl_xor(mx.y, o_)); mx.z = fmaxf(mx.z, __shfl_xor(mx.z, o_)); mx.w = fmaxf(mx.w, __shfl_xor(mx.w, o_)); }
        if (lane < 8) { LAS float* d = smax + F.wave * 32 + 4 * q; d[0] = mx.x; d[1] = mx.y; d[2] = mx.z; d[3] = mx.w; }
        __syncthreads();
        if (F.tid < 32) { float m = 0.f;
#pragma unroll
            for (int w = 0; w < 8; ++w) m = fmaxf(m, smax[w * 32 + F.tid]);
            m = fmaxf(m, 1e-30f); bmax[F.tid] = m; sw[n0 + F.tid] = m * (1.0f / 127.0f); }
        __syncthreads();
        float inv[4]; size_t roff[4];
#pragma unroll
        for (int j = 0; j < 4; ++j) { const int nn = r8 + 8 * j; inv[j] = 127.0f / bmax[nn]; roff[j] = w_row_off(n0 + nn); }
        f32x4 v[16], vn[16];
#pragma unroll
        for (int i = 0; i < 16; ++i) v[i] = *(const f32x4*)(wp + (size_t)(8 * i) * 26640);
#pragma unroll 1
        for (int cp = 0; cp < 4; ++cp) {
            if (cp < 3) {
#pragma unroll
                for (int i = 0; i < 16; ++i) vn[i] = *(const f32x4*)(wp + (size_t)(128 * (cp + 1) + 8 * i) * 26640); }
#pragma unroll
            for (int hc = 0; hc < 2; ++hc) {
#pragma unroll
                for (int i = 0; i < 8; ++i) { LAS float* d = scr + (8 * i + r8) * 33 + 4 * q; const f32x4 x = v[8 * hc + i]; d[0] = x.x; d[1] = x.y; d[2] = x.z; d[3] = x.w; }
                LDS_WAIT(); asm volatile("" ::: "memory");
                const int k0 = 512 * F.wave + 128 * cp + 64 * hc;
#pragma unroll
                for (int j = 0; j < 4; ++j) { const int nn = r8 + 8 * j; const LAS float* s_ = scr + (8 * c) * 33 + nn; int qv[8];
#pragma unroll
                    for (int e_ = 0; e_ < 8; ++e_) qv[e_] = (int)rintf(s_[e_ * 33] * inv[j]) & 255;
                    *(u32x2*)(ws + WS_W8 + roff[j] + k0 + 8 * c) = (u32x2){(unsigned)(qv[0] | (qv[1] << 8) | (qv[2] << 16) | (qv[3] << 24)), (unsigned)(qv[4] | (qv[5] << 8) | (qv[6] << 16) | (qv[7] << 24))}; }
                LDS_WAIT(); asm volatile("" ::: "memory");
            }
#pragma unroll
            for (int i = 0; i < 16; ++i) v[i] = vn[i];
        }
        __syncthreads();
    }
}
__device__ __forceinline__ void peer_wq_convert(Frame& F, const Args& a) {
    LAS float* scr = (LAS float*)(F.lds + F.wave * 16384);
    const int gw = F.bid * 8 + F.wave, NGW = F.G * 8; unsigned char* ws = F.ws;
    for (int it = gw; it < 64 * 64; it += NGW)
        transpose_item(a.in[16], D, 2048, 2048, nullptr, scr, it, F.lane, false, ws + WS_WPQ, nullptr, (const unsigned*)(ws + WS_CTL + CTL_CMAXPQ), (float*)(ws + WS_SWPQ), true);
}

struct P1Sched {
    const char *hn, *wreg, *wal, *memn, *wkv; int G, c;
    __device__ __forceinline__ bool next(int i, gg::Unit& u) const {
        long L = (long)i * G + c; u.aux = 0;
        if (L < 64 * NTB) { int pm, pn; gg::tile_order(L, 64, NTB > 0 ? NTB : 1, pm, pn); pn = map_tile(pn, false);
            u.kind = 0; u.pm = pm; u.pn = pn; u.A = hn + (size_t)pm * 256 * D * 2; u.B = wreg + w_row_off(256 * pn); return true; }
        L -= 64 * NTB;
        if (L < 64) { u.kind = 0; u.pm = (int)L; u.pn = 104; u.A = hn + (size_t)L * 256 * D * 2; u.B = wal; return true; }
        L -= 64;
        if (!V_I8) { if (L < 512) { u.kind = 1; u.pm = (int)(L % 8); u.pn = (int)(L / 8); u.A = wreg + w_row_off(O_VG + 256 * u.pm); u.B = hn + (size_t)u.pn * 256 * D * 2; return true; } L -= 512; }
        if (L < 64) { u.kind = 2; u.pm = (int)(L % 4); u.pn = (int)(L / 4); u.A = memn + (size_t)u.pm * 256 * D * 2; u.B = wkv + (size_t)u.pn * 256 * D * 2; return true; }
        return false;
    }
};
struct I8Sched {
    const char *hn8, *wreg; int G, c;
    __device__ __forceinline__ bool next(int i, gg::Unit& u) const {
        const int rb = NU_B % G, ext = (rb > 0 && NU_8 >= 2 * (G - rb)) ? 2 * (G - rb) : 0, x = (NU_8 - ext) / G, rem = (NU_8 - ext) % G;
        const int cnt1 = x + (c < rem ? 1 : 0);
        long L; u.aux = 0;
        if (i < cnt1) L = (long)i * G + c; else if (ext > 0 && c >= rb && i - cnt1 < 2) L = (long)x * G + rem + 2 * (c - rb) + (i - cnt1); else return false;
        if (L < 64 * NT8) { int pm, pn; gg::tile_order(L, 64, NT8 > 0 ? NT8 : 1, pm, pn); pn = map_tile(pn, true);
            u.kind = 0; u.pm = pm; u.pn = pn; u.A = hn8 + (size_t)pm * 256 * D; u.B = wreg + w_row_off(256 * pn); return true; }
        L -= 64 * NT8;
        if (V_I8 && L < 512) { u.kind = 1; u.pm = (int)(L % 8); u.pn = (int)(L / 8); u.A = wreg + w_row_off(O_VG + 256 * u.pm); u.B = hn8 + (size_t)u.pn * 256 * D; return true; }
        return false;
    }
};
struct I8Epi {
    unsigned char* ws; const float* bgate;
    __device__ __forceinline__ int nst(const gg::Unit& u) const { return 16; }
    __device__ __forceinline__ bool operator()(gg::Acc& acc, const gg::Unit& u, int wr, int wc, int fr, int fq, int wid, int lane) const {
        bf16_t* base; int ldc, col0, mode = 0; const int row0 = u.pm * 256; const float *rs, *cs;
        const float* shn = (const float*)(ws + WS_SHN); const float* sw = (const float*)(ws + WS_SW);
        if (u.kind == 0) { const int c0 = u.pn * 256; rs = shn + row0; cs = sw + c0;
            if (c0 < O_KG) { base = (bf16_t*)(ws + WS_QG); ldc = 1024; col0 = c0; }
            else if (c0 < O_VG) { base = (bf16_t*)(ws + WS_KG); ldc = 1024; col0 = c0 - O_KG; }
            else if (c0 < O_CB) { base = (bf16_t*)(ws + WS_RG); ldc = 2048; col0 = c0 - O_RG; }
            else if (c0 < O_CC) { base = (bf16_t*)(ws + WS_CB); ldc = 2048; col0 = c0 - O_CB; }
            else if (c0 < O_CH) { base = (bf16_t*)(ws + WS_CC); ldc = 2048; col0 = c0 - O_CC; }
            else if (c0 < O_QX) { base = (bf16_t*)(ws + WS_CH); ldc = 2048; col0 = c0 - O_CH; }
            else { base = (bf16_t*)(ws + WS_GT); ldc = 12288; col0 = c0 - O_GT; mode = 1; }
        } else { base = (bf16_t*)(ws + WS_VT); ldc = T; col0 = u.pn * 256; rs = sw + O_VG + row0; cs = shn + col0; }
        float rvv[2][4]; f32x4 cv[2][2], bv[2][2];
#pragma unroll
        for (int ai = 0; ai < 2; ++ai)
#pragma unroll
            for (int m = 0; m < 4; ++m) rvv[ai][m] = rs[ai * 128 + wr * 64 + m * 16 + fr];
#pragma unroll
        for (int bj = 0; bj < 2; ++bj) { const float* cp = cs + bj * 128 + wc * 32 + 8 * fq; cv[bj][0] = *(const f32x4*)cp; cv[bj][1] = *(const f32x4*)(cp + 4);
            bv[bj][0] = (f32x4){0.f, 0.f, 0.f, 0.f}; bv[bj][1] = bv[bj][0];
            if (mode == 1) { const float* bp = bgate + col0 + bj * 128 + wc * 32 + 8 * fq; bv[bj][0] = *(const f32x4*)bp; bv[bj][1] = *(const f32x4*)(bp + 4); } }
#pragma unroll
        for (int bj = 0; bj < 2; ++bj) { const f32x4 c0v = cv[bj][0], c1v = cv[bj][1], b0 = bv[bj][0], b1 = bv[bj][1];
#pragma unroll
            for (int ai = 0; ai < 2; ++ai)
#pragma unroll
                for (int m = 0; m < 4; ++m) { const int r = ai * 128 + wr * 64 + m * 16 + fr; const float rv = rvv[ai][m];
                    const i32x4 i0 = __builtin_bit_cast(i32x4, acc[ai][bj][m][0]), i1 = __builtin_bit_cast(i32x4, acc[ai][bj][m][1]);
                    f32x4 v0 = (f32x4){(float)i0[0], (float)i0[1], (float)i0[2], (float)i0[3]} * (c0v * rv) + b0, v1 = (f32x4){(float)i1[0], (float)i1[1], (float)i1[2], (float)i1[3]} * (c1v * rv) + b1;
                    if (mode == 1) {
#pragma unroll
                        for (int j = 0; j < 4; ++j) { v0[j] = inv_sigmoid(v0[j]); v1[j] = inv_sigmoid(v1[j]); } }
                    u32x4 w; w.x = pk2(v0[0], v0[1]); w.y = pk2(v0[2], v0[3]); w.z = pk2(v1[0], v1[1]); w.w = pk2(v1[2], v1[3]);
                    *(u32x4*)(base + (size_t)(row0 + r) * ldc + col0 + bj * 128 + wc * 32 + 8 * fq) = w; } }
        return true;
    }
};
struct P1Epi {
    unsigned char* ws; const float* bgate;
    __device__ __forceinline__ int nst(const gg::Unit& u) const { return 0; }
    __device__ __forceinline__ bool operator()(gg::Acc& acc, const gg::Unit& u, int wr, int wc, int fr, int fq, int wid, int lane) const {
        bf16_t* base; int ldc, col0, mode = 0; const int row0 = u.pm * 256;
        if (u.kind == 0) { const int c0 = u.pn * 256;
            if (c0 < O_KG) { base = (bf16_t*)(ws + WS_QG); ldc = 1024; col0 = c0; }
            else if (c0 < O_VG) { base = (bf16_t*)(ws + WS_KG); ldc = 1024; col0 = c0 - O_KG; }
            else if (c0 < O_CB) { base = (bf16_t*)(ws + WS_RG); ldc = 2048; col0 = c0 - O_RG; }
            else if (c0 < O_CC) { base = (bf16_t*)(ws + WS_CB); ldc = 2048; col0 = c0 - O_CB; }
            else if (c0 < O_CH) { base = (bf16_t*)(ws + WS_CC); ldc = 2048; col0 = c0 - O_CC; }
            else if (c0 < O_QX) { base = (bf16_t*)(ws + WS_CH); ldc = 2048; col0 = c0 - O_CH; }
            else if (c0 < O_GT) { base = (bf16_t*)(ws + WS_QX); ldc = 2048; col0 = c0 - O_QX; }
            else if (c0 < O_AL) { base = (bf16_t*)(ws + WS_GT); ldc = 12288; col0 = c0 - O_GT; mode = 1; }
            else { base = nullptr; ldc = 0; col0 = 0; mode = 2; }
        } else if (u.kind == 1) { base = (bf16_t*)(ws + WS_VT); ldc = T; col0 = u.pn * 256; }
        else { base = (bf16_t*)(ws + WS_KVM); ldc = 4096; col0 = u.pn * 256; }
        if (mode == 0) { gg::store_bf16_tile(acc, base, ldc, row0, col0, wr, wc, fr, fq); }
        else if (mode == 1) {
#pragma unroll
            for (int bj = 0; bj < 2; ++bj) { const float* bp = bgate + col0 + bj * 128 + wc * 32 + 8 * fq; const f32x4 b0 = *(const f32x4*)bp, b1 = *(const f32x4*)(bp + 4);
#pragma unroll
                for (int ai = 0; ai < 2; ++ai)
#pragma unroll
                    for (int m = 0; m < 4; ++m) { f32x4 v0 = acc[ai][bj][m][0] + b0, v1 = acc[ai][bj][m][1] + b1;
#pragma unroll
                        for (int j = 0; j < 4; ++j) { v0[j] = inv_sigmoid(v0[j]); v1[j] = inv_sigmoid(v1[j]); }
                        u32x4 w; w.x = pk2(v0[0], v0[1]); w.y = pk2(v0[2], v0[3]); w.z = pk2(v1[0], v1[1]); w.w = pk2(v1[2], v1[3]);
                        *(u32x4*)(base + (size_t)(row0 + ai * 128 + wr * 64 + m * 16 + fr) * ldc + col0 + bj * 128 + wc * 32 + 8 * fq) = w; } }
        } else {
            if (wc == 0 && fq < 2) { float* alr = (float*)(ws + WS_ALR);
#pragma unroll
                for (int ai = 0; ai < 2; ++ai)
#pragma unroll
                    for (int m = 0; m < 4; ++m) { float* p = alr + (size_t)(row0 + ai * 128 + wr * 64 + m * 16 + fr) * 16 + 8 * fq;
                        *(f32x4*)p = acc[ai][0][m][0]; *(f32x4*)(p + 4) = acc[ai][0][m][1]; } }
        }
        return true;
    }
};

constexpr int PREP_ROWB = 528;
constexpr int PREP_QT = 0, PREP_KI = 2 * 64 * PREP_ROWB, PREP_ALR = 4 * 64 * PREP_ROWB;
constexpr int PREP_KOT_ROWB = 144;
__device__ __forceinline__ void gla_prep_unit(Frame& F, const Args& a, int unit) {
    const int hp = unit & 1, n = (unit >> 1) & 63, b = unit >> 7;
    const int tid = F.tid, hh = tid >> 8, c = tid & 255, h = 2 * hp + hh, lane = F.lane, wid = F.wave;
    const int tok0 = b * SEQ + n * 64;
    unsigned char* ws = F.ws;
    LAS float* alr_s = (LAS float*)(F.lds + PREP_ALR);
    LAS unsigned char* qt_s = F.lds + PREP_QT + hh * 64 * PREP_ROWB;
    LAS unsigned char* ki_s = F.lds + PREP_KI + hh * 64 * PREP_ROWB;
    if (tid < 256) ((LAS f32x4*)alr_s)[tid] = ((const f32x4*)((const float*)(ws + WS_ALR) + (size_t)tok0 * 16))[tid];
    float w[16];
#pragma unroll
    for (int r = 0; r < 16; ++r) w[r] = a.in[4][r * 1024 + h * 256 + c];
    const float ba = a.in[5][h * 256 + c];
    __syncthreads();
    float bt[64]; float cum = 0.f;
#pragma unroll
    for (int t = 0; t < 64; ++t) {
        float z = ba;
#pragma unroll
        for (int r = 0; r < 16; ++r) z += alr_s[t * 16 + r] * w[r];
        const float ls = fminf(z, 0.f) - __logf(1.0f + __expf(-fabsf(z)));
        cum += ls * (1.0f / 16.0f); bt[t] = cum;
    }
    const bf16_t* qg = (const bf16_t*)(ws + WS_QG) + (size_t)tok0 * 1024 + h * 256 + c;
    const bf16_t* kg = (const bf16_t*)(ws + WS_KG) + (size_t)tok0 * 1024 + h * 256 + c;
#pragma unroll
    for (int t = 0; t < 64; ++t) {
        const float q = bf2f(qg[(size_t)t * 1024]), k = bf2f(kg[(size_t)t * 1024]);
        const float eb = __expf(bt[t]);
        *(LAS bf16_t*)(qt_s + t * PREP_ROWB + c * 2) = (bf16_t)f2bf(q * eb * 0.0625f);
        *(LAS bf16_t*)(ki_s + t * PREP_ROWB + c * 2) = (bf16_t)f2bf(k * __expf(-bt[t]));
    }
    unsigned char* blk = ws + WS_GLAB + (size_t)((b * 4 + h) * 64 + n) * GLA_BLK;
    ((float*)(blk + 73728))[c] = __expf(cum);
    __syncthreads();
    {
        const int whh = wid >> 2, mb = wid & 3, fr = lane & 15, fq = lane >> 4;
        LAS unsigned char* qs = F.lds + PREP_QT + whh * 64 * PREP_ROWB; LAS unsigned char* ks = F.lds + PREP_KI + whh * 64 * PREP_ROWB;
        unsigned char* wblk = ws + WS_GLAB + (size_t)((b * 4 + 2 * hp + whh) * 64 + n) * GLA_BLK;
        bf16_t* attf = (bf16_t*)(wblk + 65536);
#pragma unroll
        for (int nb = 0; nb < 4; ++nb) {
            f32x4 acc = (f32x4){0.f, 0.f, 0.f, 0.f};
            if (nb <= mb) {
#pragma unroll
                for (int kk = 0; kk < 8; ++kk) {
                    const bf16x8 av = *(const LAS bf16x8*)(qs + (16 * mb + fr) * PREP_ROWB + (32 * kk + 8 * fq) * 2);
                    const bf16x8 bv = *(const LAS bf16x8*)(ks + (16 * nb + fr) * PREP_ROWB + (32 * kk + 8 * fq) * 2);
                    acc = __builtin_amdgcn_mfma_f32_16x16x32_bf16(av, bv, acc, 0, 0, 0);
                }
            }
            const int s = 16 * nb + fr;
#pragma unroll
            for (int j = 0; j < 4; ++j) { const int t = 16 * mb + 4 * fq + j; const float v = (s <= t) ? acc[j] : 0.f;
                attf[((mb * 2 + (s >> 5)) * 64 + (t & 15) + 16 * ((s & 31) >> 3)) * 8 + (s & 7)] = (bf16_t)f2bf(v); }
        }
        u32x4* qtf = (u32x4*)wblk;
#pragma unroll
        for (int i = 0; i < 8; ++i) { const int f = (wid & 3) * 8 + i, mb2 = f >> 3, kk = f & 7;
            const LAS unsigned char* rowp = qs + (16 * mb2 + fr) * PREP_ROWB + (32 * kk + 4 * fq) * 2;
            const u32x2 lo = *(const LAS u32x2*)rowp, hi = *(const LAS u32x2*)(rowp + 32);
            u32x4 o; o.x = lo.x; o.y = lo.y; o.z = hi.x; o.w = hi.y; qtf[f * 64 + lane] = o; }
    }
    __syncthreads();
    {
        LAS unsigned char* kot = F.lds + hh * 256 * PREP_KOT_ROWB + c * PREP_KOT_ROWB;
#pragma unroll
        for (int t8 = 0; t8 < 8; ++t8) { float v[8];
#pragma unroll
            for (int j = 0; j < 8; ++j) { const int t = t8 * 8 + j; v[j] = bf2f(kg[(size_t)t * 1024]) * __expf(cum - bt[t]); }
            u32x4 o; o.x = pk2(v[0], v[1]); o.y = pk2(v[2], v[3]); o.z = pk2(v[4], v[5]); o.w = pk2(v[6], v[7]);
            *(LAS u32x4*)(kot + t8 * 16) = o; }
    }
    __syncthreads();
    {
        const int whh = wid >> 2, fr = lane & 15, fq = lane >> 4;
        unsigned char* wblk = ws + WS_GLAB + (size_t)((b * 4 + 2 * hp + whh) * 64 + n) * GLA_BLK;
        u32x4* kof = (u32x4*)(wblk + 32768);
        const LAS unsigned char* kb = F.lds + whh * 256 * PREP_KOT_ROWB;
#pragma unroll
        for (int i = 0; i < 8; ++i) { const int f = (wid & 3) * 8 + i, mbc = f >> 1, kk2 = f & 1;
            kof[f * 64 + lane] = *(const LAS u32x4*)(kb + (16 * mbc + fr) * PREP_KOT_ROWB + (32 * kk2 + 8 * fq) * 2); }
    }
    __syncthreads();
}

__device__ __forceinline__ void conv_phase(Frame& F, const Args& a, int wg, int nwg) {
    unsigned char* ws = F.ws;
    const size_t gt = (size_t)wg * 512 + F.tid, ngt = (size_t)nwg * 512;
    u32x4* cb = (u32x4*)(ws + WS_CB); const u32x4* cc = (const u32x4*)(ws + WS_CC); const u32x4* ch = (const u32x4*)(ws + WS_CH);
    const float* cw = a.in[7];
    for (size_t p = gt; p < (size_t)T * 256; p += ngt) {
        const int t = (int)(p >> 8), c8 = (int)(p & 255) * 8, pos = t & (SEQ - 1);
        float accv[8];
#pragma unroll
        for (int j = 0; j < 8; ++j) accv[j] = 0.f;
#pragma unroll
        for (int d = 0; d < 3; ++d) {
            if (pos >= d) { const u32x4 x = cc[p - (size_t)d * 256], y = ch[p - (size_t)d * 256];
                const f32x4 w0 = *(const f32x4*)(cw + d * 2048 + c8), w1 = *(const f32x4*)(cw + d * 2048 + c8 + 4);
                accv[0] += w0.x * (bflo(x.x) * bflo(y.x)); accv[1] += w0.y * (bfhi(x.x) * bfhi(y.x));
                accv[2] += w0.z * (bflo(x.y) * bflo(y.y)); accv[3] += w0.w * (bfhi(x.y) * bfhi(y.y));
                accv[4] += w1.x * (bflo(x.z) * bflo(y.z)); accv[5] += w1.y * (bfhi(x.z) * bfhi(y.z));
                accv[6] += w1.z * (bflo(x.w) * bflo(y.w)); accv[7] += w1.w * (bfhi(x.w) * bfhi(y.w)); }
        }
        const u32x4 bv = cb[p]; u32x4 o;
        o.x = pk2(bflo(bv.x) * accv[0], bfhi(bv.x) * accv[1]); o.y = pk2(bflo(bv.y) * accv[2], bfhi(bv.y) * accv[3]);
        o.z = pk2(bflo(bv.z) * accv[4], bfhi(bv.z) * accv[5]); o.w = pk2(bflo(bv.w) * accv[6], bfhi(bv.w) * accv[7]);
        cb[p] = o;
    }
}

struct XsSched {
    const char *hn, *wkt; int G, c;
    __device__ __forceinline__ bool next(int i, gg::Unit& u) const {
        const long L = (long)i * G + c; if (L >= 256) return false;
        const int xcd = (int)(L % 8), off = (int)(L / 8), w = xcd * 32 + off;
        const int pm = w >> 2, h = w & 3, b = pm >> 4;
        u.kind = 0; u.pm = pm; u.pn = h; u.aux = 0;
        u.A = hn + (size_t)pm * 256 * D * 2; u.B = wkt + ((size_t)(b * 1024 + h * 256) * D) * 2; return true;
    }
};
struct WkSched {
    const char *kvm, *wqx; int G, c;
    __device__ __forceinline__ bool next(int i, gg::Unit& u) const {
        const long L = (long)i * G + c; if (L >= 256) return false;
        const int bh = (int)(L >> 4), ntile = (int)(L & 15), b = bh >> 2, h = bh & 3;
        u.kind = 0; u.pm = b * 4 + h; u.pn = ntile; u.aux = 0;
        u.A = kvm + ((size_t)(b * 256) * 4096 + h * 512) * 2; u.B = wqx + ((size_t)(ntile * 256) * 2048 + h * 512) * 2; return true;
    }
};
struct WkEpi {
    bf16_t* wkt;
    __device__ __forceinline__ int nst(const gg::Unit& u) const { return 16; }
    __device__ __forceinline__ bool operator()(gg::Acc& acc, const gg::Unit& u, int wr, int wc, int fr, int fq, int wid, int lane) const {
        gg::store_bf16_tile(acc, wkt, D, u.pm * 256, u.pn * 256, wr, wc, fr, fq); return true;
    }
};
struct XsEpi {
    bf16_t* prob; LAS unsigned char* ex;
    __device__ __forceinline__ int nst(const gg::Unit& u) const { return 0; }
    __device__ __forceinline__ bool operator()(gg::Acc& acc, const gg::Unit& u, int wr, int wc, int fr, int fq, int wid, int lane) const {
        LAS float* MX = (LAS float*)ex; LAS float* SM = (LAS float*)(ex + 4096);
        const float sc = 0.04419417382f * 1.44269504089f;
#pragma unroll
        for (int ai = 0; ai < 2; ++ai)
#pragma unroll
            for (int m = 0; m < 4; ++m) { float v = -3.0e38f;
#pragma unroll
                for (int bj = 0; bj < 2; ++bj)
#pragma unroll
                    for (int n = 0; n < 2; ++n) { const f32x4 x = acc[ai][bj][m][n]; v = fmaxf(v, fmaxf(fmaxf(x[0], x[1]), fmaxf(x[2], x[3]))); }
                v = fmaxf(v, __shfl_xor(v, 16)); v = fmaxf(v, __shfl_xor(v, 32));
                if (fq == 0) MX[(ai * 128 + wr * 64 + m * 16 + fr) * 4 + wc] = v; }
        LDS_WAIT(); __builtin_amdgcn_s_barrier(); asm volatile("" ::: "memory");
#pragma unroll
        for (int ai = 0; ai < 2; ++ai)
#pragma unroll
            for (int m = 0; m < 4; ++m) { const f32x4 q = *(const LAS f32x4*)(MX + (ai * 128 + wr * 64 + m * 16 + fr) * 4);
                const float rm = fmaxf(fmaxf(q[0], q[1]), fmaxf(q[2], q[3])); float s = 0.f;
#pragma unroll
                for (int bj = 0; bj < 2; ++bj)
#pragma unroll
                    for (int n = 0; n < 2; ++n) {
#pragma unroll
                        for (int j = 0; j < 4; ++j) { const float e = __builtin_amdgcn_exp2f((acc[ai][bj][m][n][j] - rm) * sc); acc[ai][bj][m][n][j] = e; s += e; } }
                s += __shfl_xor(s, 16); s += __shfl_xor(s, 32);
                if (fq == 0) SM[(ai * 128 + wr * 64 + m * 16 + fr) * 4 + wc] = s; }
        LDS_WAIT(); __builtin_amdgcn_s_barrier(); asm volatile("" ::: "memory");
        const int b = u.pm >> 4, panel = u.pm & 15, h = u.pn;
#pragma unroll
        for (int ai = 0; ai < 2; ++ai)
#pragma unroll
            for (int m = 0; m < 4; ++m) { const f32x4 q = *(const LAS f32x4*)(SM + (ai * 128 + wr * 64 + m * 16 + fr) * 4);
                const float inv = 1.0f / ((q[0] + q[1]) + (q[2] + q[3]));
                bf16_t* rowp = prob + (size_t)(b * SEQ + panel * 256 + ai * 128 + wr * 64 + m * 16 + fr) * 2048 + h * 256 + wc * 32 + 8 * fq;
#pragma unroll
                for (int bj = 0; bj < 2; ++bj) { const f32x4 v0 = acc[ai][bj][m][0] * inv, v1 = acc[ai][bj][m][1] * inv;
                    u32x4 w; w.x = pk2(v0[0], v0[1]); w.y = pk2(v0[2], v0[3]); w.z = pk2(v1[0], v1[1]); w.w = pk2(v1[2], v1[3]);
                    *(u32x4*)(rowp + bj * 128) = w; } }
        return true;
    }
};

__device__ __forceinline__ void gla_scan_unit(Frame& F, const Args& a, int unit) {
    const int dvq = unit & 3, h = (unit >> 2) & 3, b = unit >> 4;
    const int lane = F.lane, wid = F.wave, fr = lane & 15, fq = lane >> 4;
    unsigned char* ws = F.ws;
    const unsigned char* blk0 = ws + WS_GLAB + (size_t)((b * 4 + h) * 64) * GLA_BLK;
    const int dvcol = 16 * (8 * dvq + wid);
    const bf16_t* vt = (const bf16_t*)(ws + WS_VT) + (size_t)(h * 512 + dvcol + fr) * T + (size_t)b * SEQ + 8 * fq;
    bf16_t* og = (bf16_t*)(ws + WS_OG) + (size_t)(b * SEQ) * 2048 + h * 512 + dvcol + fr;
    f32x4 S[16];
#pragma unroll
    for (int i = 0; i < 16; ++i) S[i] = (f32x4){0.f, 0.f, 0.f, 0.f};
    for (int p = wid; p < 73; p += 8)
        __builtin_amdgcn_global_load_lds((const unsigned*)(blk0 + (size_t)p * 1024 + lane * 16), (LAS unsigned*)(F.lds + p * 1024), 16, 0, 0);
    bf16x8 vf[2], vn[2];
    vf[0] = *(const bf16x8*)(vt); vf[1] = *(const bf16x8*)(vt + 32);
    vn[0] = vf[0]; vn[1] = vf[1];
    VM_WAIT(); __syncthreads();
    for (int n = 0; n < 64; ++n) {
        LAS unsigned char* buf = F.lds + (n & 1) * GLA_BLK;
        if (n < 63) {
            const unsigned char* nb = blk0 + (size_t)(n + 1) * GLA_BLK; LAS unsigned char* dst = F.lds + ((n + 1) & 1) * GLA_BLK;
            for (int p = wid; p < 73; p += 8)
                __builtin_amdgcn_global_load_lds((const unsigned*)(nb + (size_t)p * 1024 + lane * 16), (LAS unsigned*)(dst + p * 1024), 16, 0, 0);
            vn[0] = *(const bf16x8*)(vt + 64 * (n + 1)); vn[1] = *(const bf16x8*)(vt + 64 * (n + 1) + 32);
        }
        f32x4 o[4];
#pragma unroll
        for (int mb = 0; mb < 4; ++mb) o[mb] = (f32x4){0.f, 0.f, 0.f, 0.f};
#pragma unroll
        for (int kk = 0; kk < 8; ++kk) {
            u32x4 bw; bw.x = pk2(S[2 * kk][0], S[2 * kk][1]); bw.y = pk2(S[2 * kk][2], S[2 * kk][3]); bw.z = pk2(S[2 * kk + 1][0], S[2 * kk + 1][1]); bw.w = pk2(S[2 * kk + 1][2], S[2 * kk + 1][3]);
            const bf16x8 bfr = __builtin_bit_cast(bf16x8, bw);
#pragma unroll
            for (int mb = 0; mb < 4; ++mb) { const bf16x8 af = *(const LAS bf16x8*)(buf + ((mb * 8 + kk) * 64 + lane) * 16);
                o[mb] = __builtin_amdgcn_mfma_f32_16x16x32_bf16(af, bfr, o[mb], 0, 0, 0); }
        }
#pragma unroll
        for (int kk = 0; kk < 2; ++kk)
#pragma unroll
            for (int mb = 0; mb < 4; ++mb) { const bf16x8 af = *(const LAS bf16x8*)(buf + 65536 + ((mb * 2 + kk) * 64 + lane) * 16);
                o[mb] = __builtin_amdgcn_mfma_f32_16x16x32_bf16(af, vf[kk], o[mb], 0, 0, 0); }
        {
            bf16_t* op = og + (size_t)(64 * n) * 2048;
#pragma unroll
            for (int mb = 0; mb < 4; ++mb)
#pragma unroll
                for (int j = 0; j < 4; ++j) op[(size_t)(16 * mb + 4 * fq + j) * 2048] = (bf16_t)f2bf(o[mb][j]);
        }
#pragma unroll
        for (int mb = 0; mb < 16; ++mb) {
            const f32x4 dc = *(const LAS f32x4*)(buf + 73728 + (16 * mb + 4 * fq) * 4);
            S[mb] = S[mb] * dc;
#pragma unroll
            for (int kk = 0; kk < 2; ++kk) { const bf16x8 af = *(const LAS bf16x8*)(buf + 32768 + ((mb * 2 + kk) * 64 + lane) * 16);
                S[mb] = __builtin_amdgcn_mfma_f32_16x16x32_bf16(af, vf[kk], S[mb], 0, 0, 0); }
        }
        vf[0] = vn[0]; vf[1] = vn[1];
        VM_WAIT(); __syncthreads();
    }
}

struct VwSched {
    const char *wxa, *kvm; int G, c;
    __device__ __forceinline__ bool next(int i, gg::Unit& u) const {
        const long L = (long)i * G + c; if (L >= 256) return false;
        const int bh = (int)(L >> 4), pm = (int)(L & 15), b = bh >> 2, h = bh & 3;
        u.kind = 0; u.pm = b * 16 + pm; u.pn = h; u.aux = 0;
        u.A = wxa + ((size_t)(pm * 256) * 2048 + h * 512) * 2; u.B = kvm + ((size_t)(b * 256) * 4096 + 2048 + h * 512) * 2; return true;
    }
};
struct VwEpi {
    bf16_t* vwt;
    __device__ __forceinline__ int nst(const gg::Unit& u) const { return 16; }
    __device__ __forceinline__ bool operator()(gg::Acc& acc, const gg::Unit& u, int wr, int wc, int fr, int fq, int wid, int lane) const {
        gg::store_bf16_tile(acc, vwt, 2048, u.pm * 256, u.pn * 256, wr, wc, fr, fq); return true;
    }
};

__device__ __forceinline__ void gla_post_phase(Frame& F, const Args& a) {
    unsigned char* ws = F.ws;
    const int gw = F.bid * 8 + F.wave, NGW = F.G * 8, lane = F.lane;
    const float* gn = a.in[6];
    const f32x4 g0 = *(const f32x4*)(gn + lane * 8), g1 = *(const f32x4*)(gn + lane * 8 + 4);
    for (int t = gw; t < T; t += NGW) {
        const u32x4* orow = (const u32x4*)((const bf16_t*)(ws + WS_OG) + (size_t)t * 2048); u32x4* rrow = (u32x4*)((bf16_t*)(ws + WS_RG) + (size_t)t * 2048);
#pragma unroll
        for (int h = 0; h < 4; ++h) {
            const u32x4 ov = orow[h * 64 + lane], rv = rrow[h * 64 + lane];
            float o[8] = {bflo(ov.x), bfhi(ov.x), bflo(ov.y), bfhi(ov.y), bflo(ov.z), bfhi(ov.z), bflo(ov.w), bfhi(ov.w)};
            float r[8] = {bflo(rv.x), bfhi(rv.x), bflo(rv.y), bfhi(rv.y), bflo(rv.z), bfhi(rv.z), bflo(rv.w), bfhi(rv.w)};
            float s = 0.f;
#pragma unroll
            for (int j = 0; j < 8; ++j) s += o[j] * o[j];
            const float rstd = rsqrtf(wave_sum(s) * (1.f / 512.f) + EPS);
            const float gv[8] = {g0.x, g0.y, g0.z, g0.w, g1.x, g1.y, g1.z, g1.w};
            float y[8];
#pragma unroll
            for (int j = 0; j < 8; ++j) y[j] = o[j] * rstd * gv[j] * (r[j] * fast_sigmoid(r[j]));
            u32x4 w; w.x = pk2(y[0], y[1]); w.y = pk2(y[2], y[3]); w.z = pk2(y[4], y[5]); w.w = pk2(y[6], y[7]);
            rrow[h * 64 + lane] = w;
        }
    }
}

struct MgSched {
    const char *a0, *a1, *a2, *wbr, *vwt; int G, c;
    __device__ __forceinline__ bool next(int i, gg::Unit& u) const {
        const int ti = i / 3, br = i - 3 * ti; int pm, pn;
        if (!gg::tile_order((long)ti * G + c, 64, 16, pm, pn)) return false;
        u.kind = br; u.pm = pm; u.pn = pn; u.aux = br == 2 ? 16 : 32;
        const char* ab = br == 0 ? a0 : (br == 1 ? a1 : a2);
        u.A = ab + (size_t)pm * 256 * 2048 * 2;
        u.B = br == 2 ? vwt + ((size_t)((pm >> 4) * 4096 + pn * 256) * 2048) * 2 : wbr + (size_t)br * 16 * MiB + (size_t)pn * 256 * 2048 * 2; return true;
    }
};
struct MgEpi {
    const bf16_t* gt; bf16_t* merged;
    __device__ __forceinline__ int nst(const gg::Unit& u) const { return u.kind == 2 ? 16 : 0; }
    __device__ __forceinline__ bool operator()(gg::Acc& acc, const gg::Unit& u, int wr, int wc, int fr, int fq, int wid, int lane) const {
        const int br = u.kind;
#pragma unroll
        for (int ai = 0; ai < 2; ++ai) {
            u32x4 ga[4][2], gb[4][2];
#pragma unroll
            for (int m = 0; m < 4; ++m) { const size_t row = (size_t)(u.pm * 256 + ai * 128 + wr * 64 + m * 16 + fr);
#pragma unroll
                for (int bj = 0; bj < 2; ++bj) { const int col = u.pn * 256 + bj * 128 + wc * 32 + 8 * fq;
                    ga[m][bj] = *(const u32x4*)(gt + row * 12288 + br * 4096 + col);
                    gb[m][bj] = (br < 2) ? *(const u32x4*)(gt + row * 12288 + (br + 1) * 4096 + col) : (u32x4){0x3f803f80u, 0x3f803f80u, 0x3f803f80u, 0x3f803f80u}; } }
#pragma unroll
            for (int m = 0; m < 4; ++m) { const size_t row = (size_t)(u.pm * 256 + ai * 128 + wr * 64 + m * 16 + fr);
#pragma unroll
                for (int bj = 0; bj < 2; ++bj) { const int col = u.pn * 256 + bj * 128 + wc * 32 + 8 * fq;
                    const u32x4 a4 = ga[m][bj], b4 = gb[m][bj];
                    float g[8] = {bflo(a4.x), bfhi(a4.x), bflo(a4.y), bfhi(a4.y), bflo(a4.z), bfhi(a4.z), bflo(a4.w), bfhi(a4.w)};
                    if (br < 2) { const float d[8] = {bflo(b4.x), bfhi(b4.x), bflo(b4.y), bfhi(b4.y), bflo(b4.z), bfhi(b4.z), bflo(b4.w), bfhi(b4.w)};
#pragma unroll
                        for (int j = 0; j < 8; ++j) g[j] = d[j] * __builtin_amdgcn_rcpf(g[j]); }
                    else {
#pragma unroll
                        for (int j = 0; j < 8; ++j) g[j] = __builtin_amdgcn_rcpf(g[j]); }
                    f32x4 v0 = acc[ai][bj][m][0], v1 = acc[ai][bj][m][1];
                    v0[0] *= g[0]; v0[1] *= g[1]; v0[2] *= g[2]; v0[3] *= g[3]; v1[0] *= g[4]; v1[1] *= g[5]; v1[2] *= g[6]; v1[3] *= g[7];
                    if (br < 2) { acc[ai][bj][m][0] = v0; acc[ai][bj][m][1] = v1; }
                    else { u32x4 w; w.x = pk2(v0[0], v0[1]); w.y = pk2(v0[2], v0[3]); w.z = pk2(v1[0], v1[1]); w.w = pk2(v1[2], v1[3]);
                        *(u32x4*)(merged + row * D + col) = w; } } }
        }
        return br == 2;
    }
};

struct GridSched {
    const char *A, *B; int nM, nN, lda2, ldb2, G, c;
    __device__ __forceinline__ bool next(int i, gg::Unit& u) const {
        int pm, pn; if (!gg::tile_order((long)i * G + c, nM, nN, pm, pn)) return false;
        u.kind = 0; u.pm = pm; u.pn = pn; u.aux = 0; u.A = A + (size_t)pm * 256 * lda2; u.B = B + (size_t)pn * 256 * ldb2; return true;
    }
};
struct ResEpi {
    const float* x; float* out;
    __device__ __forceinline__ int nst(const gg::Unit& u) const { return 16; }
    __device__ __forceinline__ bool operator()(gg::Acc& acc, const gg::Unit& u, int wr, int wc, int fr, int fq, int wid, int lane) const {
#pragma unroll
        for (int ai = 0; ai < 2; ++ai) {
            f32x4 xv[4][2][2];
#pragma unroll
            for (int m = 0; m < 4; ++m) { const size_t off = (size_t)(u.pm * 256 + ai * 128 + wr * 64 + m * 16 + fr) * D + u.pn * 256 + wc * 32 + 8 * fq;
#pragma unroll
                for (int bj = 0; bj < 2; ++bj) { xv[m][bj][0] = *(const f32x4*)(x + off + bj * 128); xv[m][bj][1] = *(const f32x4*)(x + off + bj * 128 + 4); } }
#pragma unroll
            for (int m = 0; m < 4; ++m) { const size_t off = (size_t)(u.pm * 256 + ai * 128 + wr * 64 + m * 16 + fr) * D + u.pn * 256 + wc * 32 + 8 * fq;
#pragma unroll
                for (int bj = 0; bj < 2; ++bj) { *(f32x4*)(out + off + bj * 128) = xv[m][bj][0] + acc[ai][bj][m][0]; *(f32x4*)(out + off + bj * 128 + 4) = xv[m][bj][1] + acc[ai][bj][m][1]; } }
        }
        return true;
    }
};
struct PqEpi {
    bf16_t* o; const float* rs; const float* cs;
    __device__ __forceinline__ int nst(const gg::Unit& u) const { return 16; }
    __device__ __forceinline__ bool operator()(gg::Acc& acc, const gg::Unit& u, int wr, int wc, int fr, int fq, int wid, int lane) const {
        const int row0 = u.pm * 256, col0 = u.pn * 256;
        float rvv[2][4]; f32x4 cv[2][2];
#pragma unroll
        for (int ai = 0; ai < 2; ++ai)
#pragma unroll
            for (int m = 0; m < 4; ++m) rvv[ai][m] = rs[row0 + ai * 128 + wr * 64 + m * 16 + fr];
#pragma unroll
        for (int bj = 0; bj < 2; ++bj) { const float* cp = cs + col0 + bj * 128 + wc * 32 + 8 * fq; cv[bj][0] = *(const f32x4*)cp; cv[bj][1] = *(const f32x4*)(cp + 4); }
#pragma unroll
        for (int bj = 0; bj < 2; ++bj) { const f32x4 c0v = cv[bj][0], c1v = cv[bj][1];
#pragma unroll
            for (int ai = 0; ai < 2; ++ai)
#pragma unroll
                for (int m = 0; m < 4; ++m) { const int r = row0 + ai * 128 + wr * 64 + m * 16 + fr; const float rv = rvv[ai][m];
                    const i32x4 i0 = __builtin_bit_cast(i32x4, acc[ai][bj][m][0]), i1 = __builtin_bit_cast(i32x4, acc[ai][bj][m][1]);
                    const f32x4 v0 = (f32x4){(float)i0[0], (float)i0[1], (float)i0[2], (float)i0[3]} * (c0v * rv), v1 = (f32x4){(float)i1[0], (float)i1[1], (float)i1[2], (float)i1[3]} * (c1v * rv);
                    u32x4 w; w.x = pk2(v0[0], v0[1]); w.y = pk2(v0[2], v0[3]); w.z = pk2(v1[0], v1[1]); w.w = pk2(v1[2], v1[3]);
                    *(u32x4*)(o + (size_t)r * 2048 + col0 + bj * 128 + wc * 32 + 8 * fq) = w; } }
        return true;
    }
};
struct Bf16Epi {
    bf16_t* o; int ldc;
    __device__ __forceinline__ int nst(const gg::Unit& u) const { return 16; }
    __device__ __forceinline__ bool operator()(gg::Acc& acc, const gg::Unit& u, int wr, int wc, int fr, int fq, int wid, int lane) const {
        gg::store_bf16_tile(acc, o, ldc, u.pm * 256, u.pn * 256, wr, wc, fr, fq); return true;
    }
};

__device__ __forceinline__ int f2ord(float f) { const int b = __float_as_int(f); return b ^ ((b >> 31) & 0x7fffffff); }
__device__ __forceinline__ float ord2f(int o) { return __int_as_float(o ^ ((o >> 31) & 0x7fffffff)); }
__device__ __forceinline__ void cex_desc(int& hi, int& lo) { const int a = hi, b = lo; hi = a > b ? a : b; lo = a > b ? b : a; }
__device__ __forceinline__ void bsort16_desc(int (&a)[16]) {
#pragma unroll
    for (int k = 2; k <= 16; k <<= 1)
#pragma unroll
        for (int j = k >> 1; j > 0; j >>= 1)
#pragma unroll
            for (int i = 0; i < 16; ++i) { const int l = i ^ j; if (l > i) { if ((i & k) == 0) cex_desc(a[i], a[l]); else cex_desc(a[l], a[i]); } }
}
__device__ __forceinline__ void bmerge16_desc(int (&a)[16]) {
#pragma unroll
    for (int j = 8; j > 0; j >>= 1)
#pragma unroll
        for (int i = 0; i < 16; ++i) { const int l = i ^ j; if (l > i) cex_desc(a[i], a[l]); }
}
__device__ __forceinline__ void top16_merge(int (&a)[16], const int (&b)[16]) {
#pragma unroll
    for (int i = 0; i < 16; ++i) a[i] = a[i] > b[15 - i] ? a[i] : b[15 - i];
    bmerge16_desc(a);
}
constexpr int RT_SKROW = 272;
constexpr int RT_SK = 2 * 128 * RT_SKROW;
__device__ __forceinline__ void route_topk16(const f32x4 (&acc)[8], int fq, int (&res)[16]) {
    int a[16], b[16];
#pragma unroll
    for (int mb = 0; mb < 4; ++mb)
#pragma unroll
        for (int j = 0; j < 4; ++j) { a[mb * 4 + j] = (f2ord(acc[mb][j]) & ~127) | (127 - (16 * mb + 4 * fq + j)); b[mb * 4 + j] = (f2ord(acc[mb + 4][j]) & ~127) | (127 - (16 * (mb + 4) + 4 * fq + j)); }
    bsort16_desc(a); bsort16_desc(b); top16_merge(a, b);
#pragma unroll
    for (int x = 16; x <= 32; x <<= 1) {
#pragma unroll
        for (int i = 0; i < 16; ++i) b[i] = __shfl_xor(a[i], x);
        top16_merge(a, b);
    }
#pragma unroll
    for (int i = 0; i < 16; ++i) res[i] = a[i];
}
__device__ __forceinline__ void route_job(Frame& F, const Args& a, int job) {
    unsigned char* ws = F.ws;
    const int tid = F.tid, lane = F.lane, wid = F.wave, fr = lane & 15, fq = lane >> 4;
    const int h = job & 7, chunk = job >> 3;
    const bf16_t* pq = (const bf16_t*)(ws + WS_PQ); const bf16_t* sk = (const bf16_t*)(ws + WS_SUBK) + (size_t)h * 2 * 128 * 128;
    for (int p = tid; p < 4096; p += 512) { const int row = p >> 4, pc = p & 15; *(LAS u32x4*)(F.lds + row * RT_SKROW + pc * 16) = ((const u32x4*)sk)[p]; }
    __syncthreads();
    LAS int* IX = (LAS int*)(F.lds + RT_SK) + wid * 512;
#pragma unroll 1
    for (int it = 0; it < 4; ++it) {
        const int tok0 = (chunk * 32 + wid * 4 + it) * 16;
        int top[2][16];
#pragma unroll
        for (int c = 0; c < 2; ++c) {
            f32x4 acc[8];
#pragma unroll
            for (int mb = 0; mb < 8; ++mb) acc[mb] = (f32x4){0.f, 0.f, 0.f, 0.f};
            bf16x8 bfr[4];
#pragma unroll
            for (int kk = 0; kk < 4; ++kk) bfr[kk] = *(const bf16x8*)(pq + (size_t)(tok0 + fr) * 2048 + h * 256 + c * 128 + 32 * kk + 8 * fq);
#pragma unroll
            for (int kk = 0; kk < 4; ++kk)
#pragma unroll
                for (int mb = 0; mb < 8; ++mb) { const bf16x8 af = *(const LAS bf16x8*)(F.lds + (c * 128 + 16 * mb + fr) * RT_SKROW + (32 * kk + 8 * fq) * 2);
                    acc[mb] = __builtin_amdgcn_mfma_f32_16x16x32_bf16(af, bfr[kk], acc[mb], 0, 0, 0); }
            route_topk16(acc, fq, top[c]);
        }
        float f0[16], f1[16];
#pragma unroll
        for (int i = 0; i < 16; ++i) { f0[i] = ord2f(top[0][i] & ~127); f1[i] = ord2f(top[1][i] & ~127); }
        int g[4][16];
#pragma unroll
        for (int q = 0; q < 4; ++q)
#pragma unroll
            for (int i = 0; i < 16; ++i) g[q][i] = (int)0x80000000;
        {
            int nc = 0;
#pragma unroll
            for (int i = 0; i < 16; ++i)
#pragma unroll
                for (int j = 0; j < 16; ++j) if ((i + 1) * (j + 1) <= 16) { g[nc >> 4][nc & 15] = (f2ord(f0[i] + f1[j]) & ~255) | (255 - (i * 16 + j)); ++nc; }
        }
        bsort16_desc(g[0]); bsort16_desc(g[1]); bsort16_desc(g[2]); bsort16_desc(g[3]);
        top16_merge(g[0], g[1]); top16_merge(g[2], g[3]); top16_merge(g[0], g[2]);
        if (fq == 0) {
#pragma unroll
            for (int i = 0; i < 16; ++i) { IX[fr * 32 + i] = 127 - (top[0][i] & 127); IX[fr * 32 + 16 + i] = 127 - (top[1][i] & 127); }
        }
        LDS_WAIT(); asm volatile("" ::: "memory");
        if (fq == 0) {
            const float vmax = ord2f(g[0][0] & ~255); float e[16]; float s = 0.f; int ex[16];
#pragma unroll
            for (int r = 0; r < 16; ++r) { e[r] = __expf(ord2f(g[0][r] & ~255) - vmax); s += e[r]; const int ij = 255 - (g[0][r] & 255); ex[r] = IX[fr * 32 + (ij >> 4)] * 128 + IX[fr * 32 + 16 + (ij & 15)]; }
            const float inv = 1.0f / s;
            int* eidx = (int*)(ws + WS_EIDX) + (size_t)(tok0 + fr) * 128 + h * 16; float* gw = (float*)(ws + WS_GW) + (size_t)(tok0 + fr) * 128 + h * 16;
#pragma unroll
            for (int q = 0; q < 4; ++q) { *(u32x4*)(eidx + 4 * q) = (u32x4){(unsigned)ex[4 * q], (unsigned)ex[4 * q + 1], (unsigned)ex[4 * q + 2], (unsigned)ex[4 * q + 3]};
                *(f32x4*)(gw + 4 * q) = (f32x4){e[4 * q] * inv, e[4 * q + 1] * inv, e[4 * q + 2] * inv, e[4 * q + 3] * inv}; }
        }
        LDS_WAIT(); asm volatile("" ::: "memory");
    }
    __syncthreads();
}

__device__ __forceinline__ float ub0(unsigned w) { return (float)(w & 255u); }
__device__ __forceinline__ float ub1(unsigned w) { return (float)((w >> 8) & 255u); }
__device__ __forceinline__ float ub2(unsigned w) { return (float)((w >> 16) & 255u); }
__device__ __forceinline__ float ub3(unsigned w) { return (float)(w >> 24); }
#define P10_LOADU(buf, kbase) do { _Pragma("unroll") for (int r = 0; r < 4; ++r) { const int k_ = (kbase) + r; const int e_ = __builtin_amdgcn_readlane(k_ < 64 ? ev0 : ev1, k_ & 63); \
        const u32x4* rp_ = (const u32x4*)(ub + (size_t)e_ * 2048); buf[r][0] = rp_[lane]; buf[r][1] = rp_[64 + lane]; } } while (0)
#define P10_COMPU(buf, kbase) do { _Pragma("unroll") for (int r = 0; r < 4; ++r) { int s_ = 0; \
        _Pragma("unroll") for (int p = 0; p < 2; ++p) { const unsigned x0 = buf[r][p].x, x1 = buf[r][p].y, x2 = buf[r][p].z, x3 = buf[r][p].w; \
            s_ = __builtin_amdgcn_sdot4((int)(x0 & 0x0F0F0F0Fu), (int)hv[p][0].x, s_, false); s_ = __builtin_amdgcn_sdot4((int)((x0 >> 4) & 0x0F0F0F0Fu), (int)hv[p][0].y, s_, false); \
            s_ = __builtin_amdgcn_sdot4((int)(x1 & 0x0F0F0F0Fu), (int)hv[p][0].z, s_, false); s_ = __builtin_amdgcn_sdot4((int)((x1 >> 4) & 0x0F0F0F0Fu), (int)hv[p][0].w, s_, false); \
            s_ = __builtin_amdgcn_sdot4((int)(x2 & 0x0F0F0F0Fu), (int)hv[p][1].x, s_, false); s_ = __builtin_amdgcn_sdot4((int)((x2 >> 4) & 0x0F0F0F0Fu), (int)hv[p][1].y, s_, false); \
            s_ = __builtin_amdgcn_sdot4((int)(x3 & 0x0F0F0F0Fu), (int)hv[p][1].z, s_, false); s_ = __builtin_amdgcn_sdot4((int)((x3 >> 4) & 0x0F0F0F0Fu), (int)hv[p][1].w, s_, false); } \
        _Pragma("unroll") for (int o_ = 1; o_ < 64; o_ <<= 1) s_ += __shfl_xor(s_, o_); \
        const int k_ = (kbase) + r; const float av_ = (float)s_; if (k_ < 64) { if (lane == k_) a0 = av_; } else { if (lane == k_ - 64) a1 = av_; } } } while (0)
#define P10_LOADV(buf, kbase) do { _Pragma("unroll") for (int r = 0; r < 4; ++r) { const int k_ = (kbase) + r; const int e_ = __builtin_amdgcn_readlane(k_ < 64 ? ev0 : ev1, k_ & 63); \
        const u32x4* rp_ = (const u32x4*)(vb + (size_t)e_ * 2048); buf[r][0] = rp_[lane]; buf[r][1] = rp_[64 + lane]; } } while (0)
#define P10_COMPV(buf, grp) do { const int wq_ = __builtin_amdgcn_readlane(wqv, (grp)); \
        _Pragma("unroll") for (int p = 0; p < 2; ++p) { const unsigned xr_[4][4] = {{buf[0][p].x, buf[0][p].y, buf[0][p].z, buf[0][p].w}, {buf[1][p].x, buf[1][p].y, buf[1][p].z, buf[1][p].w}, {buf[2][p].x, buf[2][p].y, buf[2][p].z, buf[2][p].w}, {buf[3][p].x, buf[3][p].y, buf[3][p].z, buf[3][p].w}}; \
            _Pragma("unroll") for (int d = 0; d < 4; ++d) { int* oo = o + 32 * p + 8 * d; \
                _Pragma("unroll") for (int h = 0; h < 2; ++h) { \
                    const unsigned b0 = (xr_[0][d] >> (4 * h)) & 0x0F0F0F0Fu, b1 = (xr_[1][d] >> (4 * h)) & 0x0F0F0F0Fu, b2 = (xr_[2][d] >> (4 * h)) & 0x0F0F0F0Fu, b3 = (xr_[3][d] >> (4 * h)) & 0x0F0F0F0Fu; \
                    const unsigned a01 = __builtin_amdgcn_perm(b1, b0, 0x05010400u), c01 = __builtin_amdgcn_perm(b1, b0, 0x07030602u), a23 = __builtin_amdgcn_perm(b3, b2, 0x05010400u), c23 = __builtin_amdgcn_perm(b3, b2, 0x07030602u); \
                    const unsigned t0 = __builtin_amdgcn_perm(a23, a01, 0x05040100u), t1 = __builtin_amdgcn_perm(a23, a01, 0x07060302u), t2 = __builtin_amdgcn_perm(c23, c01, 0x05040100u), t3 = __builtin_amdgcn_perm(c23, c01, 0x07060302u); \
                    oo[0 + h] = __builtin_amdgcn_sdot4((int)t0, wq_, oo[0 + h], false); oo[2 + h] = __builtin_amdgcn_sdot4((int)t1, wq_, oo[2 + h], false); \
                    oo[4 + h] = __builtin_amdgcn_sdot4((int)t2, wq_, oo[4 + h], false); oo[6 + h] = __builtin_amdgcn_sdot4((int)t3, wq_, oo[6 + h], false); } } } } while (0)
__device__ __forceinline__ void peer_token_wave(const Args& a, unsigned char* ws, int tok, int lane) {
    const int* eidx = (const int*)(ws + WS_EIDX) + (size_t)tok * 128; const float* gw = (const float*)(ws + WS_GW) + (size_t)tok * 128;
    const int ev0 = eidx[lane], ev1 = eidx[64 + lane];
    u32x4 hv[2][2];
    const u32x4* hrow = (const u32x4*)(ws + WS_H8 + (size_t)tok * D);
#pragma unroll
    for (int p = 0; p < 2; ++p) { hv[p][0] = hrow[128 * p + 2 * lane]; hv[p][1] = hrow[128 * p + 2 * lane + 1]; }
    const float sh = ((const float*)(ws + WS_SH))[tok], shs = ((const float*)(ws + WS_SHS))[tok];
    const unsigned char* ub = ws + WS_UB; const float* su = (const float*)(ws + WS_SU); const float* sv = (const float*)(ws + WS_SV);
    float a0 = 0.f, a1 = 0.f;
    {
        u32x4 ua[4][2], uc[4][2];
        P10_LOADU(ua, 0);
#pragma unroll 1
        for (int kb = 0; kb < 128; kb += 8) {
            P10_LOADU(uc, kb + 4);
            P10_COMPU(ua, kb);
            P10_LOADU(ua, (kb + 8) & 127);
            P10_COMPU(uc, kb + 4);
        }
    }
    float w0, w1;
    { const float x0 = (a0 - 8.0f * shs) * su[ev0] * sh, x1 = (a1 - 8.0f * shs) * su[ev1] * sh;
      w0 = gw[lane] * 0.5f * x0 * (1.0f + erff(x0 * 0.70710678118f)) * sv[ev0]; w1 = gw[64 + lane] * 0.5f * x1 * (1.0f + erff(x1 * 0.70710678118f)) * sv[ev1]; }
    const float wmax = fmaxf(wave_max(fmaxf(fabsf(w0), fabsf(w1))), 1e-30f), sw = wmax * (1.0f / 127.0f), winv = 127.0f / wmax;
    const int q0 = (int)rintf(w0 * winv), q1 = (int)rintf(w1 * winv);
    int qsum = q0 + q1;
#pragma unroll
    for (int o_ = 1; o_ < 64; o_ <<= 1) qsum += __shfl_xor(qsum, o_);
    int wqv;
    { const int base = (lane & 15) * 4;
      const int s0 = __shfl(lane < 16 ? q0 : q1, base + 0), s1 = __shfl(lane < 16 ? q0 : q1, base + 1), s2 = __shfl(lane < 16 ? q0 : q1, base + 2), s3 = __shfl(lane < 16 ? q0 : q1, base + 3);
      const int a0_ = __shfl(q0, base + 0), a1_ = __shfl(q0, base + 1), a2_ = __shfl(q0, base + 2), a3_ = __shfl(q0, base + 3);
      const int b0_ = __shfl(q1, base + 0), b1_ = __shfl(q1, base + 1), b2_ = __shfl(q1, base + 2), b3_ = __shfl(q1, base + 3);
      (void)s0; (void)s1; (void)s2; (void)s3;
      const bool lowhalf = (lane & 31) < 16;
      const int c0 = lowhalf ? a0_ : b0_, c1 = lowhalf ? a1_ : b1_, c2 = lowhalf ? a2_ : b2_, c3 = lowhalf ? a3_ : b3_;
      wqv = (c0 & 255) | ((c1 & 255) << 8) | ((c2 & 255) << 16) | ((c3 & 255) << 24); }
    int o[64];
#pragma unroll
    for (int j = 0; j < 64; ++j) o[j] = 0;
    const unsigned char* vb = ws + WS_VB;
    {
        u32x4 va[4][2], vc[4][2];
        P10_LOADV(va, 0);
#pragma unroll 1
        for (int kb = 0; kb < 128; kb += 8) {
            P10_LOADV(vc, kb + 4);
            P10_COMPV(va, kb >> 2);
            P10_LOADV(va, (kb + 8) & 127);
            P10_COMPV(vc, (kb >> 2) + 1);
        }
    }
    float* orow = a.out + (size_t)tok * D; float s = 0.f; const int corr = 8 * qsum; float y[64];
#pragma unroll
    for (int p = 0; p < 2; ++p)
#pragma unroll
        for (int q = 0; q < 8; ++q) { const f32x4 x = *(const f32x4*)(orow + 2048 * p + 32 * lane + 4 * q); const int* oo = o + 32 * p + 4 * q; float* yy = y + 32 * p + 4 * q;
            yy[0] = x.x + sw * (float)(oo[0] - corr); yy[1] = x.y + sw * (float)(oo[1] - corr); yy[2] = x.z + sw * (float)(oo[2] - corr); yy[3] = x.w + sw * (float)(oo[3] - corr);
            s += (yy[0] * yy[0] + yy[1] * yy[1]) + (yy[2] * yy[2] + yy[3] * yy[3]); }
    const float rstd = rsqrtf(wave_sum(s) * (1.f / D) + EPS);
#pragma unroll
    for (int p = 0; p < 2; ++p)
#pragma unroll
        for (int q = 0; q < 8; ++q) { const f32x4 g = *(const f32x4*)(a.in[20] + 2048 * p + 32 * lane + 4 * q); const float* yy = y + 32 * p + 4 * q;
            *(f32x4*)(orow + 2048 * p + 32 * lane + 4 * q) = (f32x4){yy[0] * rstd * g.x, yy[1] * rstd * g.y, yy[2] * rstd * g.z, yy[3] * rstd * g.w}; }
}

__global__ void __launch_bounds__(512, 2) mega_fwd(Args args) {
    extern __shared__ __attribute__((aligned(16))) unsigned char lds_raw[];
    Frame F;
    F.lds = (LAS unsigned char*)lds_raw;
    F.tid = threadIdx.x; F.lane = F.tid & 63; F.wave = __builtin_amdgcn_readfirstlane(F.tid >> 6);
    F.G = gridDim.x; F.bid = blockIdx.x; F.ws = args.ws;
    unsigned char* ws = args.ws;
    if (F.tid < 64) ((LAS unsigned*)(F.lds + LDS_MISC))[F.tid] = 0u;
    __syncthreads();
    XcdBarrier bar = xcd_barrier_post((unsigned*)(ws + WS_CTL) + 4096, (volatile LAS unsigned*)(F.lds + LDS_MISC + 32));

    F.refresh();
    p0_weights8(F, args);
    F.refresh();
    p0_prologue_a(F, args);
    xcd_barrier(bar);
    {
        P1Sched S{(const char*)(ws + WS_HN), (const char*)(ws + WS_W8), (const char*)(ws + WS_WAL), (const char*)(ws + WS_MEMN), (const char*)(ws + WS_WKV), F.G, F.bid};
        P1Epi E{ws, args.in[12]};
        gg::gemm_phase<0>(F.lds, D * 2, D * 2, 64, S, E);
        I8Sched S8{(const char*)(ws + WS_HN8), (const char*)(ws + WS_W8), F.G, F.bid};
        I8Epi E8{ws, args.in[12]};
        gg::gemm_phase<2, true>(F.lds, D, D, 32, S8, E8);
        xcd_barrier(bar);
    }
    F.refresh();
    for (int u = F.bid; u < 512; u += F.G) gla_prep_unit(F, args, u);
    {
        WkSched Sk{(const char*)(ws + WS_KVM), (const char*)(ws + WS_WQX), F.G, F.bid};
        WkEpi Ek{(bf16_t*)(ws + WS_WKT)};
        gg::gemm_phase<0>(F.lds, 8192, 4096, 8, Sk, Ek);
        VwSched Sv{(const char*)(ws + WS_WBR + 32 * MiB), (const char*)(ws + WS_KVM), F.G, F.bid};
        VwEpi Ev{(bf16_t*)(ws + WS_VWT)};
        gg::gemm_phase<0>(F.lds, 4096, 8192, 8, Sv, Ev);
    }
    xcd_barrier(bar);
    F.refresh();
    {
        {
            XsSched S{(const char*)(ws + WS_HN), (const char*)(ws + WS_WKT), F.G, F.bid};
            XsEpi E{(bf16_t*)(ws + WS_PROB), F.lds + LDS_EX};
            gg::gemm_phase<0>(F.lds, D * 2, D * 2, 64, S, E);
        }
        const int nscan = F.G >= 128 ? 64 : 0;
        if (nscan) { if (F.bid < 64) gla_scan_unit(F, args, F.bid); }
        else for (int u = F.bid; u < 64; u += F.G) gla_scan_unit(F, args, u);
        { const int nq = nscan ? F.G - 64 : F.G, cq = nscan ? F.bid - 64 : F.bid;
          if (cq >= 0) for (int e = cq * 8 + F.wave; e < 16384; e += nq * 8) {
              quant_row_i4(args.in[18] + (size_t)e * D, ws + WS_UB + (size_t)e * 2048, (float*)(ws + WS_SU) + e, F.lane);
              quant_row_i4(args.in[19] + (size_t)e * D, ws + WS_VB + (size_t)e * 2048, (float*)(ws + WS_SV) + e, F.lane); }
          if (cq >= 0) conv_phase(F, args, cq, nq); }
    }
    xcd_barrier(bar);
    F.refresh();
    gla_post_phase(F, args);
    F.refresh();
    peer_wq_convert(F, args);
    xcd_barrier(bar);
    {
        MgSched S{(const char*)(ws + WS_RG), (const char*)(ws + WS_CB), (const char*)(ws + WS_PROB), (const char*)(ws + WS_WBR), (const char*)(ws + WS_VWT), F.G, F.bid};
        MgEpi E{(const bf16_t*)(ws + WS_GT), (bf16_t*)(ws + WS_MERGED)};
        gg::gemm_phase<0, true>(F.lds, 4096, 4096, 32, S, E);
    }
    xcd_barrier(bar);
    {
        GridSched S{(const char*)(ws + WS_MERGED), (const char*)(ws + WS_WO), 64, 16, D * 2, D * 2, F.G, F.bid};
        ResEpi E{args.in[0], args.out};
        gg::gemm_phase<0, true>(F.lds, D * 2, D * 2, 64, S, E);
    }
    xcd_barrier(bar);
    F.refresh();
    {
        const int gw = F.bid * 8 + F.wave, NGW = F.G * 8;
        for (int m = gw; m < T; m += NGW) rms_row_i8(args.out + (size_t)m * D, args.in[15], ws + WS_H8 + (size_t)m * D, (float*)(ws + WS_SH) + m, (float*)(ws + WS_SHS) + m, F.lane);
    }
    xcd_barrier(bar);
    {
        GridSched S{(const char*)(ws + WS_H8), (const char*)(ws + WS_WPQ), 64, 8, D, D, F.G, F.bid};
        PqEpi E{(bf16_t*)(ws + WS_PQ), (const float*)(ws + WS_SH), (const float*)(ws + WS_SWPQ)};
        gg::gemm_phase<2, true>(F.lds, D, D, 32, S, E);
    }
    xcd_barrier(bar);
    F.refresh();
    for (int u = F.bid; u < 256; u += F.G) route_job(F, args, u);
    xcd_barrier(bar);
    F.refresh();
    for (int tok = F.bid * 8 + F.wave; tok < T; tok += F.G * 8) peer_token_wave(args, ws, tok, F.lane);
}


extern "C" void kernel_launch(void* const* d_in, const int* in_sizes, int n_in, void* d_out, int out_size, void* d_ws, size_t ws_size, hipStream_t stream) {
    static int grid = 0;
    if (grid == 0) {
        if (n_in != 21 || ws_size < WS_END) { fprintf(stderr, "kernel_launch: unexpected inputs (n_in %d, ws %zu < %zu)\n", n_in, ws_size, (size_t)WS_END); grid = -1; return; }
        int dev = 0, cus = 0, per_cu = 0;
        if (hipGetDevice(&dev) != hipSuccess || hipDeviceGetAttribute(&cus, hipDeviceAttributeMultiprocessorCount, dev) != hipSuccess) { grid = -1; return; }
        if (hipFuncSetAttribute((const void*)mega_fwd, hipFuncAttributeMaxDynamicSharedMemorySize, LDS_BYTES) != hipSuccess) { fprintf(stderr, "kernel_launch: hipFuncSetAttribute failed\n"); grid = -1; return; }
        if (hipOccupancyMaxActiveBlocksPerMultiprocessor(&per_cu, (const void*)mega_fwd, 512, LDS_BYTES) != hipSuccess || per_cu < 1)
            fprintf(stderr, "kernel_launch: occupancy query says %d\n", per_cu);
        (void)hipGetLastError();
        grid = cus;
    }
    if (grid < 0) return;
    Args a{};
    for (int i = 0; i < 21; ++i) a.in[i] = (const float*)d_in[i];
    a.out = (float*)d_out; a.ws = (unsigned char*)d_ws;
    hipMemsetAsync((char*)d_ws + WS_CTL, 0, CTL_BYTES, stream);
    hipLaunchKernelGGL(mega_fwd, dim3(grid), dim3(512), LDS_BYTES, stream, a);
}
```

```cpp
#include <hip/hip_runtime.h>
#include <cstdio>
#include <cstdint>

#define LAS __attribute__((address_space(3)))
typedef unsigned short bf16_t;
typedef short bf16x8 __attribute__((ext_vector_type(8)));
typedef float f32x4 __attribute__((ext_vector_type(4)));
typedef float f32x2 __attribute__((ext_vector_type(2)));
typedef unsigned u32x4 __attribute__((ext_vector_type(4)));
typedef unsigned u32x2 __attribute__((ext_vector_type(2)));
typedef __bf16 bf16x2v __attribute__((ext_vector_type(2)));
typedef int i32x8 __attribute__((ext_vector_type(8)));
typedef int i32x4 __attribute__((ext_vector_type(4)));
typedef unsigned u32x8 __attribute__((ext_vector_type(8)));

constexpr int T = 16384, D = 4096, SEQ = 4096, NBATCH = 4, MEMT = 1024;
constexpr int NPAD = 26880;
constexpr int O_QG = 0, O_KG = 1024, O_VG = 2048, O_RG = 4096, O_CB = 6144, O_CC = 8192, O_CH = 10240, O_QX = 12288, O_GT = 14336, O_AL = 26624;
constexpr float EPS = 1e-6f;
constexpr int GLA_BLK = 74752;

#ifndef I8_MASK
#define I8_MASK 0x7f
#endif
constexpr int SEG_START[9] = {0, 2048, 4096, 6144, 8192, 10240, 12288, 14336, 26624};
constexpr int SEG_BIT[8] = {0, 1, 2, 3, 4, 5, -1, 6};
constexpr bool seg_i8(int s) { return SEG_BIT[s] >= 0 && ((I8_MASK >> SEG_BIT[s]) & 1); }
constexpr size_t seg_pitch(int s) { return SEG_BIT[s] < 0 ? 0 : (seg_i8(s) ? 4096 : 8192); }
constexpr size_t seg_off(int s) { size_t o = 0; for (int t = 0; t < s; ++t) o += (size_t)(SEG_START[t + 1] - SEG_START[t]) * seg_pitch(t); return o; }
constexpr bool V_I8 = seg_i8(1);
constexpr int count_tiles(bool want8) { int n = 0; for (int s = 0; s < 8; ++s) if (s != 1 && SEG_BIT[s] >= 0 && seg_i8(s) == want8) n += (SEG_START[s + 1] - SEG_START[s]) / 256; return n; }
constexpr int NT8 = count_tiles(true), NTB = count_tiles(false);
constexpr int NU_B = 64 * NTB + 64 + (V_I8 ? 0 : 512) + 64, NU_8 = 64 * NT8 + (V_I8 ? 512 : 0);
__device__ __forceinline__ size_t w_row_off(int n) {
    size_t o = 0;
#pragma unroll
    for (int s = 0; s < 8; ++s) if (n >= SEG_START[s] && n < SEG_START[s + 1]) o = seg_off(s) + (size_t)(n - SEG_START[s]) * seg_pitch(s);
    return o;
}
__device__ __forceinline__ bool w_row_is8(int n) {
    bool r = false;
#pragma unroll
    for (int s = 0; s < 8; ++s) if (n >= SEG_START[s] && n < SEG_START[s + 1]) r = seg_i8(s);
    return r;
}
__device__ __forceinline__ int map_tile(int idx, bool want8) {
    int t = 104;
#pragma unroll
    for (int s = 7; s >= 0; --s) { }
    int rem = idx; bool found = false;
#pragma unroll
    for (int s = 0; s < 8; ++s) { if (s == 1 || SEG_BIT[s] < 0 || seg_i8(s) != want8) continue; const int len = (SEG_START[s + 1] - SEG_START[s]) / 256;
        if (!found && rem < len) { t = SEG_START[s] / 256 + rem; found = true; } rem -= len; }
    return t;
}
constexpr size_t MiB = 1u << 20;
constexpr size_t WS_CTL = 0, CTL_BYTES = 1 * MiB;
constexpr size_t WS_MEMN = 1 * MiB, WS_KVM = 9 * MiB  , WS_ALR = 17 * MiB, WS_SUBK = 18 * MiB, WS_EIDX = 19 * MiB, WS_GW = 27 * MiB;
constexpr size_t WS_WBR = 64 * MiB  , WS_WO = 112 * MiB, WS_WPQ = 144 * MiB, WS_WKV = 160 * MiB;
constexpr size_t WS_UB = 192 * MiB, WS_VB = 224 * MiB;
constexpr size_t WS_HN8 = 320 * MiB;
constexpr size_t WS_W8 = 448 * MiB;
constexpr size_t WS_WAL = 56 * MiB;
constexpr size_t WS_SHN = 35 * MiB + 512 * 1024, WS_SW = 35 * MiB + 768 * 1024;
constexpr size_t WS_SWPQ = 35 * MiB + 896 * 1024;
constexpr size_t CTL_CMAXPQ = 384 * 1024;
constexpr size_t CTL_CMAX = 256 * 1024;
constexpr size_t WS_SU = 35 * MiB, WS_SV = WS_SU + 65536, WS_SH = WS_SV + 65536, WS_SHS = WS_SH + 65536;
constexpr size_t WS_H8 = 914 * MiB;
constexpr size_t WS_WTIN = 448 * MiB;
constexpr size_t WS_GLAB = 448 * MiB, WS_PROB = 521 * MiB  , WS_OG = 585 * MiB;
constexpr size_t WS_WQX = 40 * MiB;
constexpr size_t WS_WKT = 384 * MiB;
constexpr size_t WS_VWT = 320 * MiB;
constexpr size_t WS_HN = 658 * MiB;
constexpr size_t WS_MERGED = 658 * MiB;
constexpr size_t WS_QG = 786 * MiB, WS_KG = 818 * MiB, WS_VT = 850 * MiB, WS_RG = 914 * MiB, WS_CB = 978 * MiB, WS_CC = 1042 * MiB, WS_CH = 1106 * MiB, WS_QX = 1170 * MiB;
constexpr size_t WS_GT = 1234 * MiB;
constexpr size_t WS_HQ = 1234 * MiB, WS_PQ = 1362 * MiB;
constexpr size_t WS_END = 1618 * MiB;
static_assert(WS_GLAB + (size_t)16 * 64 * GLA_BLK <= WS_PROB, "gla blocks");

constexpr int LDS_BYTES = 163840;
constexpr int LDS_EX = 131072;
constexpr int LDS_MISC = LDS_BYTES - 256;

__device__ __forceinline__ float bf2f(unsigned b) { return __uint_as_float(b << 16); }
__device__ __forceinline__ float bflo(unsigned w) { return __uint_as_float(w << 16); }
__device__ __forceinline__ float bfhi(unsigned w) { return __uint_as_float(w & 0xffff0000u); }
__device__ __forceinline__ unsigned f2bf(float f) { unsigned u = __float_as_uint(f); return (u + 0x7fffu + ((u >> 16) & 1u)) >> 16; }
__device__ __forceinline__ unsigned pk2(float lo, float hi) { const f32x2 v = {lo, hi}; const bf16x2v b = __builtin_convertvector(v, bf16x2v); return __builtin_bit_cast(unsigned, b); }
__device__ __forceinline__ float dot2bf(unsigned a, unsigned b, float c) { return __builtin_amdgcn_fdot2_f32_bf16(__builtin_bit_cast(bf16x2v, a), __builtin_bit_cast(bf16x2v, b), c, false); }
__device__ __forceinline__ float wave_sum(float v) {
#pragma unroll
    for (int o = 1; o < 64; o <<= 1) v += __shfl_xor(v, o);
    return v;
}
__device__ __forceinline__ float wave_max(float v) {
#pragma unroll
    for (int o = 1; o < 64; o <<= 1) v = fmaxf(v, __shfl_xor(v, o));
    return v;
}
__device__ __forceinline__ float fast_sigmoid(float x) { return __builtin_amdgcn_rcpf(1.0f + __expf(-x)); }
__device__ __forceinline__ float inv_sigmoid(float x) { return 1.0f + __expf(fminf(-x, 69.0f)); }
#define LDS_WAIT() asm volatile("s_waitcnt lgkmcnt(0)" ::: "memory")
#define VM_WAIT() asm volatile("s_waitcnt vmcnt(0)" ::: "memory")

#define XB_TMO      128
#define XB_XCNT(j)  (256  + 64 * (j))
#define XB_XSUB(j)  (1280 + 64 * (j))
#define XB_XGEN(j)  (2304 + 64 * (j))
#define XB_TOP      3328
#define XB_TOPGEN   3392
#define XCD_BAR_WORDS 3456
#define XB_SPIN_CAP (1u << 24)
__device__ __forceinline__ unsigned xb_ld(unsigned* p)              { return __hip_atomic_load(p, __ATOMIC_RELAXED, __HIP_MEMORY_SCOPE_AGENT); }
__device__ __forceinline__ unsigned xb_add(unsigned* p, unsigned v) { return __hip_atomic_fetch_add(p, v, __ATOMIC_RELAXED, __HIP_MEMORY_SCOPE_AGENT); }
__device__ __forceinline__ unsigned xb_xcc_id() { return (unsigned)__builtin_amdgcn_s_getreg((3 << 11) | 20) & 0xFu; }
#define XB_SPIN(cond, bar) do { unsigned _sp = 0; while (cond) { __builtin_amdgcn_s_sleep(1); \
    if ((++_sp & 255u) == 0u) { if (xb_ld(&(bar)[XB_TMO])) break; if (_sp > XB_SPIN_CAP) { atomicAdd(&(bar)[XB_TMO], 1u); break; } } } } while (0)
struct XcdBarrier { unsigned* bar; unsigned x; volatile LAS unsigned* st; };
__device__ __forceinline__ XcdBarrier xcd_barrier_post(unsigned* bar, volatile LAS unsigned* st) {
    XcdBarrier b; b.bar = bar; b.x = xb_xcc_id(); b.st = st;
    if (threadIdx.x == 0) (void)xb_add(&bar[XB_XCNT(b.x)], 1u);
    return b;
}
__device__ __forceinline__ void xcd_barrier_complete(unsigned* bar, unsigned x, unsigned& nloc, unsigned& nx) {
    const unsigned G = gridDim.x * gridDim.y * gridDim.z;
    unsigned sum, cnt, mine, sp = 0u;
    for (;;) {
        sum = 0u; cnt = 0u; mine = 0u;
#pragma unroll
        for (unsigned j = 0; j < 16; ++j) { const unsigned c = xb_ld(&bar[XB_XCNT(j)]); sum += c; cnt += (c > 0u) ? 1u : 0u; mine = (j == x) ? c : mine; }
        if (sum == G) break;
        __builtin_amdgcn_s_sleep(1);
        if ((++sp & 255u) == 0u) { if (xb_ld(&bar[XB_TMO])) break; if (sp > XB_SPIN_CAP) { atomicAdd(&bar[XB_TMO], 1u); break; } }
    }
    nloc = mine > 0u ? mine : 1u; nx = cnt > 0u ? cnt : 1u;
}
__device__ __forceinline__ void xcd_barrier(const XcdBarrier& b) {
    asm volatile("s_waitcnt vmcnt(0)" ::: "memory");
    __syncthreads();
    if (threadIdx.x == 0) {
        unsigned* bar = b.bar;
        __builtin_amdgcn_s_waitcnt(0);
        unsigned nloc = b.st[0], nx = b.st[1];
        if (nloc == 0u) { xcd_barrier_complete(bar, b.x, nloc, nx); b.st[0] = nloc; b.st[1] = nx; }
        const unsigned old = xb_add(&bar[XB_XSUB(b.x)], 1u);
        const unsigned gen = old / nloc;
        if (old + 1u == (gen + 1u) * nloc) {
            __builtin_amdgcn_fence(__ATOMIC_RELEASE, "agent");
            asm volatile("s_waitcnt vmcnt(0)" ::: "memory");
            const unsigned og = xb_add(&bar[XB_TOP], 1u);
            const unsigned tg = og / nx;
            if (og + 1u == (tg + 1u) * nx) xb_add(&bar[XB_TOPGEN], 1u);
            else XB_SPIN(xb_ld(&bar[XB_TOPGEN]) == tg, bar);
            __builtin_amdgcn_fence(__ATOMIC_ACQUIRE, "agent");
            xb_add(&bar[XB_XGEN(b.x)], 1u);
            asm volatile("s_waitcnt vmcnt(0)" ::: "memory");
        } else {
            XB_SPIN(xb_ld(&bar[XB_XGEN(b.x)]) == gen, bar);
            __builtin_amdgcn_fence(__ATOMIC_ACQUIRE, "agent");
            asm volatile("s_waitcnt vmcnt(0)" ::: "memory");
        }
    }
    __syncthreads();
}

namespace gg {
constexpr int BM = 256, BK = 64, HALF = 128, HTB = HALF * BK * 2, STAGE_BYTES = 8 * HTB;
__device__ __forceinline__ int lds_byte(int r, int c) { const int st = (r >> 4) * 2 + (c >> 5), rr = r & 15, cc = c & 31, ob = rr * 64 + cc * 2; return st * 1024 + (ob ^ (((ob >> 9) & 1) << 5)); }
__device__ __forceinline__ void stage_rc(int b, int& R, int& C) { const int st = b / 1024, sb = b % 1024, swz = sb ^ (((sb >> 9) & 1) << 5); R = (st >> 1) * 16 + swz / 64; C = (st & 1) * 32 + (swz % 64) / 2; }
__device__ __forceinline__ int perm32(int rho) { const int n = rho >> 4, i = rho & 15; return 8 * (i >> 2) + 4 * n + (i & 3); }
struct Unit { const char* A; const char* B; int kind, pm, pn, aux; };
typedef f32x4 Acc[2][2][4][2];

template <int MODE, bool RX = false, class Epi, class Sched>
__device__ __forceinline__ void gemm_phase(LAS unsigned char* lds, const int ldaB, const int ldbB, const int nt, const Sched& S, const Epi& E) {
    int tid = threadIdx.x; asm volatile("" : "+v"(tid));
    const int wid = __builtin_amdgcn_readfirstlane(tid >> 6), lane = tid & 63, wr = wid >> 2, wc = wid & 3, fr = lane & 15, fq = lane >> 4;
    unsigned voffA[2], voffB[2];
#pragma unroll
    for (int i = 0; i < 2; ++i) { int R, C; stage_rc(tid * 16 + i * 8192, R, C); const int Rb = (R & ~31) + perm32(R & 31);
        voffA[i] = (unsigned)(R * ldaB + C * 2); voffB[i] = (unsigned)(Rb * ldbB + C * 2); }
    const size_t kstep = (size_t)(BK * 2);
    const size_t hstepA = (size_t)HALF * ldaB, hstepB = (size_t)HALF * ldbB;
    const unsigned ldsw = (unsigned)wid * 1024u;
    const int aoff = lds_byte(wr * 64 + fr, fq * 8), boff = lds_byte(wc * 32 + fr, fq * 8);
#define PG8_SA(b, h) (((b) * 2 + (h)) * HTB)
#define PG8_SB(b, h) ((4 + (b) * 2 + (h)) * HTB)
#define PG8_STAGE(bufoff, gbase, voff) do { _Pragma("unroll") for (int _i = 0; _i < 2; ++_i) \
        __builtin_amdgcn_global_load_lds((const unsigned*)((const char*)(gbase) + (voff)[_i]), (LAS unsigned*)(lds + (bufoff) + ldsw + _i * 8192), 16, 0, 0); } while (0)
#define PG8_LDA(dst, b, h) do { _Pragma("unroll") for (int m = 0; m < 4; ++m) { if constexpr (MODE == 1) { const u32x4 p0_ = *(const LAS u32x4*)(lds + PG8_SA(b, h) + aoff + m * 2048), p1_ = *(const LAS u32x4*)(lds + PG8_SA(b, h) + aoff + m * 2048 + 1024); \
        dst##8[m] = __builtin_shufflevector(p0_, p1_, 0, 1, 2, 3, 4, 5, 6, 7); } else { _Pragma("unroll") for (int k = 0; k < 2; ++k) dst[m][k] = *(const LAS bf16x8*)(lds + PG8_SA(b, h) + aoff + m * 2048 + k * 1024); } } } while (0)
#define PG8_LDB(dst, b, h) do { _Pragma("unroll") for (int n = 0; n < 2; ++n) { if constexpr (MODE == 1) { const u32x4 p0_ = *(const LAS u32x4*)(lds + PG8_SB(b, h) + boff + n * 2048), p1_ = *(const LAS u32x4*)(lds + PG8_SB(b, h) + boff + n * 2048 + 1024); \
        dst##8[n] = __builtin_shufflevector(p0_, p1_, 0, 1, 2, 3, 4, 5, 6, 7); } else { _Pragma("unroll") for (int k = 0; k < 2; ++k) dst[n][k] = *(const LAS bf16x8*)(lds + PG8_SB(b, h) + boff + n * 2048 + k * 1024); } } } while (0)
#define PG8_MMA(ai, bj, At, Bt) do { __builtin_amdgcn_s_setprio(1); _Pragma("unroll") for (int m = 0; m < 4; ++m) _Pragma("unroll") for (int n = 0; n < 2; ++n) { \
        if constexpr (MODE == 1) { asm volatile("v_mfma_scale_f32_16x16x128_f8f6f4 %0, %1, %2, %0, %3, %3 op_sel_hi:[0,0,0]" : "+v"(acc[ai][bj][m][n]) : "v"(Bt##8[n]), "v"(At##8[m]), "v"(sc127)); } \
        else if constexpr (MODE == 2) { _Pragma("unroll") for (int k = 0; k < 2; ++k) acc[ai][bj][m][n] = __builtin_bit_cast(f32x4, __builtin_amdgcn_mfma_i32_16x16x64_i8(__builtin_bit_cast(i32x4, Bt[n][k]), __builtin_bit_cast(i32x4, At[m][k]), __builtin_bit_cast(i32x4, acc[ai][bj][m][n]), 0, 0, 0)); } \
        else { _Pragma("unroll") for (int k = 0; k < 2; ++k) acc[ai][bj][m][n] = __builtin_amdgcn_mfma_f32_16x16x32_bf16(Bt[n][k], At[m][k], acc[ai][bj][m][n], 0, 0, 0); } } \
        __builtin_amdgcn_s_setprio(0); } while (0)
#define PG8_WAIT_V(n) asm volatile("s_waitcnt vmcnt(" #n ")" ::: "memory")
#define PG8_WAIT_V2(flag) asm volatile("s_cmp_lg_u32 %0, 0\n\ts_cbranch_scc1 1f\n\ts_waitcnt vmcnt(8)\n\ts_branch 2f\n1:\n\ts_waitcnt vmcnt(24)\n2:" :: "s"(flag) : "scc", "memory")
#define PG8_WAIT_L(n) asm volatile("s_waitcnt lgkmcnt(" #n ")" ::: "memory")
#define PG8_BAR __builtin_amdgcn_s_barrier()
#define PG8_SCHED __builtin_amdgcn_sched_barrier(0)
    Unit cur, nxt; int ui = 0;
    if (!S.next(0, cur)) return;
    Acc acc;
#pragma unroll
    for (int a = 0; a < 2; ++a)
#pragma unroll
        for (int b = 0; b < 2; ++b)
#pragma unroll
            for (int m = 0; m < 4; ++m)
#pragma unroll
                for (int n = 0; n < 2; ++n) acc[a][b][m][n] = (f32x4){0.f, 0.f, 0.f, 0.f};
    bf16x8 At[4][2], B0[2][2], B1[2][2]; u32x8 At8[4], B08[2], B18[2]; const int sc127 = 127;
    const char* cA = cur.A; const char* cB = cur.B;
    PG8_STAGE(PG8_SB(0, 0), cB, voffB); PG8_STAGE(PG8_SB(0, 1), cB + hstepB, voffB); PG8_STAGE(PG8_SA(0, 0), cA, voffA); PG8_STAGE(PG8_SA(0, 1), cA + hstepA, voffA);
    if (wr == 1) PG8_BAR;
    PG8_WAIT_V(2); PG8_BAR;
    PG8_STAGE(PG8_SB(1, 0), cB + kstep, voffB); PG8_STAGE(PG8_SA(1, 0), cA + kstep, voffA); PG8_STAGE(PG8_SB(1, 1), cB + hstepB + kstep, voffB);
    PG8_WAIT_V(6); PG8_BAR;
    bool relax = false;
    for (;;) {
        const bool has_next = S.next(ui + 1, nxt);
        const char* nA = has_next ? nxt.A : cA; const char* nB = has_next ? nxt.B : cB;
        const int unt = cur.aux ? cur.aux : nt;
#define PG8_PAIR(W0) { \
            const bool last = (t == unt - 2); const int rxf = __builtin_amdgcn_readfirstlane((relax && t == 0) ? 1 : 0); \
            const char* a1 = cA + (size_t)(t + 1) * kstep; \
            const char* a2 = last ? nA : cA + (size_t)(t + 2) * kstep; const char* b2 = last ? nB : cB + (size_t)(t + 2) * kstep; \
            const char* a3 = a2 + kstep; const char* b3 = b2 + kstep; \
              \
            PG8_LDB(B0, 0, 0); PG8_LDB(B1, 0, 1); PG8_SCHED; PG8_LDA(At, 0, 0); PG8_STAGE(PG8_SA(1, 1), a1 + hstepA, voffA); \
            if constexpr (RX) PG8_WAIT_V2(rxf); else PG8_WAIT_V(8); PG8_WAIT_L(0); PG8_BAR; PG8_MMA(0, 0, At, B0); PG8_MMA(0, 1, At, B1); PG8_BAR; PG8_SCHED; \
              \
            PG8_LDA(At, 0, 1); PG8_STAGE(PG8_SB(0, 0), b2, voffB); PG8_STAGE(PG8_SB(0, 1), b2 + hstepB, voffB); PG8_STAGE(PG8_SA(0, 0), a2, voffA); \
            if constexpr (RX) PG8_WAIT_V2(rxf); else PG8_WAIT_V(8); PG8_WAIT_L(0); PG8_BAR; PG8_MMA(1, 0, At, B0); PG8_MMA(1, 1, At, B1); PG8_BAR; PG8_SCHED; \
              \
            PG8_LDB(B0, 1, 0); PG8_LDB(B1, 1, 1); PG8_SCHED; PG8_LDA(At, 1, 0); PG8_STAGE(PG8_SA(0, 1), a2 + hstepA, voffA); \
            PG8_WAIT_V(8); PG8_WAIT_L(0); PG8_BAR; PG8_MMA(0, 0, At, B0); PG8_MMA(0, 1, At, B1); PG8_BAR; PG8_SCHED; \
              \
            PG8_LDA(At, 1, 1); PG8_STAGE(PG8_SB(1, 0), b3, voffB); PG8_STAGE(PG8_SB(1, 1), b3 + hstepB, voffB); PG8_STAGE(PG8_SA(1, 0), a3, voffA); \
            PG8_WAIT_V(8); PG8_WAIT_L(0); PG8_BAR; PG8_MMA(1, 0, At, B0); PG8_MMA(1, 1, At, B1); PG8_BAR; PG8_SCHED; }
        for (int t = 0; t < unt; t += 2) PG8_PAIR(8)
#undef PG8_PAIR
        if constexpr (MODE == 1) asm volatile("s_nop 15\n\ts_nop 15" ::: "memory");
        if (wr == 0) PG8_BAR;
        const bool reset = E(acc, cur, wr, wc, fr, fq, wid, lane);
        if constexpr (RX) relax = (E.nst(cur) >= 16);
        asm volatile("" ::: "memory");
        if (!has_next) break;
        if (reset) {
#pragma unroll
            for (int a = 0; a < 2; ++a)
#pragma unroll
                for (int b = 0; b < 2; ++b)
#pragma unroll
                    for (int m = 0; m < 4; ++m)
#pragma unroll
                        for (int n = 0; n < 2; ++n) acc[a][b][m][n] = (f32x4){0.f, 0.f, 0.f, 0.f};
        }
        cur = nxt; cA = nA; cB = nB; ++ui;
        if (wr == 1) PG8_BAR;
    }
    PG8_WAIT_V(0);
    PG8_BAR;
#undef PG8_SA
#undef PG8_SB
#undef PG8_STAGE
#undef PG8_LDA
#undef PG8_LDB
#undef PG8_MMA
#undef PG8_WAIT_V
#undef PG8_WAIT_L
#undef PG8_BAR
#undef PG8_SCHED
}

__device__ __forceinline__ bool tile_order(long L, int nM, int nN, int& pm, int& pn) {
    const int nwg = nM * nN; if (L >= nwg) return false;
    const int q = nwg / 8, xcd = (int)(L % 8), off = (int)(L / 8); const int wgid = xcd * q + off;
    const int nig = 8 * nN, gid = wgid / nig, fm = gid * 8;
    pm = fm + ((wgid % nig) % 8); pn = (wgid % nig) / 8; return true;
}
__device__ __forceinline__ void store_bf16_tile(const Acc& acc, bf16_t* base, int ldc, int row0, int col0, int wr, int wc, int fr, int fq) {
#pragma unroll
    for (int ai = 0; ai < 2; ++ai)
#pragma unroll
        for (int m = 0; m < 4; ++m) { bf16_t* rowp = base + (size_t)(row0 + ai * HALF + wr * 64 + m * 16 + fr) * ldc + col0 + wc * 32 + 8 * fq;
#pragma unroll
            for (int bj = 0; bj < 2; ++bj) { const f32x4 v0 = acc[ai][bj][m][0], v1 = acc[ai][bj][m][1];
                u32x4 w; w.x = pk2(v0[0], v0[1]); w.y = pk2(v0[2], v0[3]); w.z = pk2(v1[0], v1[1]); w.w = pk2(v1[2], v1[3]);
                *(u32x4*)(rowp + bj * HALF) = w; } }
}
}

struct Args { const float* in[21]; float* out; unsigned char* ws; };
struct Frame {
    LAS unsigned char* lds;
    int tid, lane, wave, G, bid;
    unsigned char* ws;
    __device__ __forceinline__ void refresh() { int t = threadIdx.x; asm volatile("" : "+v"(t)); tid = t; lane = t & 63; wave = __builtin_amdgcn_readfirstlane(t >> 6); }
};

__device__ __forceinline__ int src_col(int n) { return n < 6144 ? n : (n < O_AL ? n + 16 : (n < O_AL + 16 ? n - O_AL + 6144 : -1)); }
__device__ __forceinline__ void transpose_item(const float* W, int K, int N, int NT, bf16_t* WT, LAS float* scr, int item, int lane, bool remap, unsigned char* W8 = nullptr, bf16_t* WQ = nullptr, const unsigned* cmax = nullptr, float* sw = nullptr, bool i8perm = false) {
    const int nblk = NT / 32, kb = item / nblk, nb = item % nblk, k0 = 64 * kb, n0 = 32 * nb;
    const int q = lane & 7, r8 = lane >> 3;
    const int n = n0 + 4 * q; const int src = remap ? src_col(n) : n;
    f32x4 v[8];
#pragma unroll
    for (int i = 0; i < 8; ++i) v[i] = (src >= 0) ? *(const f32x4*)(W + (size_t)(k0 + 8 * i + r8) * N + src) : (f32x4){0.f, 0.f, 0.f, 0.f};
    if (remap && n0 >= O_QX && n0 < O_GT) {
#pragma unroll
        for (int i = 0; i < 8; ++i) *(u32x2*)(WQ + (size_t)(k0 + 8 * i + r8) * 2048 + (n0 - O_QX) + 4 * q) = (u32x2){pk2(v[i].x, v[i].y), pk2(v[i].z, v[i].w)};
        return;
    }
#pragma unroll
    for (int i = 0; i < 8; ++i) { LAS float* d = scr + (8 * i + r8) * 33 + 4 * q; d[0] = v[i].x; d[1] = v[i].y; d[2] = v[i].z; d[3] = v[i].w; }
    LDS_WAIT(); asm volatile("" ::: "memory");
    const int c = lane & 7;
    if (i8perm) {
#pragma unroll
        for (int j = 0; j < 4; ++j) { const int nn = (lane >> 3) + 8 * j; const LAS float* s = scr + (8 * c) * 33 + nn;
            const float mx = fmaxf(__uint_as_float(xb_ld((unsigned*)cmax + n0 + nn)), 1e-30f), inv = 127.0f / mx;
            int qv[8];
#pragma unroll
            for (int e = 0; e < 8; ++e) qv[e] = (int)rintf(s[e * 33] * inv) & 255;
            *(u32x2*)(W8 + (size_t)(n0 + nn) * K + k0 + 8 * c) = (u32x2){(unsigned)(qv[0] | (qv[2] << 8) | (qv[4] << 16) | (qv[6] << 24)), (unsigned)(qv[1] | (qv[3] << 8) | (qv[5] << 16) | (qv[7] << 24))};
            if (kb == 0 && c == 0) sw[n0 + nn] = mx * (1.0f / 127.0f); }
    } else if (remap && n0 < O_AL && w_row_is8(n0)) {
#pragma unroll
        for (int j = 0; j < 4; ++j) { const int nn = (lane >> 3) + 8 * j; const LAS float* s = scr + (8 * c) * 33 + nn;
            const float mx = fmaxf(__uint_as_float(xb_ld((unsigned*)cmax + src_col(n0 + nn))), 1e-30f), inv = 127.0f / mx;
            int qv[8];
#pragma unroll
            for (int e = 0; e < 8; ++e) qv[e] = (int)rintf(s[e * 33] * inv) & 255;
            *(u32x2*)(W8 + w_row_off(n0 + nn) + k0 + 8 * c) = (u32x2){(unsigned)(qv[0] | (qv[1] << 8) | (qv[2] << 16) | (qv[3] << 24)), (unsigned)(qv[4] | (qv[5] << 8) | (qv[6] << 16) | (qv[7] << 24))};
            if (kb == 0 && c == 0) sw[n0 + nn] = mx * (1.0f / 127.0f); }
    } else if (remap && n0 < O_AL) {
#pragma unroll
        for (int j = 0; j < 4; ++j) { const int nn = (lane >> 3) + 8 * j; const LAS float* s = scr + (8 * c) * 33 + nn;
            u32x4 o; o.x = pk2(s[0 * 33], s[1 * 33]); o.y = pk2(s[2 * 33], s[3 * 33]); o.z = pk2(s[4 * 33], s[5 * 33]); o.w = pk2(s[6 * 33], s[7 * 33]);
            *(u32x4*)(W8 + w_row_off(n0 + nn) + (size_t)(k0 + 8 * c) * 2) = o; }
    } else {
        const int rowoff = remap ? O_AL : 0;
#pragma unroll
        for (int j = 0; j < 4; ++j) { const int nn = (lane >> 3) + 8 * j; const LAS float* s = scr + (8 * c) * 33 + nn;
            u32x4 o; o.x = pk2(s[0 * 33], s[1 * 33]); o.y = pk2(s[2 * 33], s[3 * 33]); o.z = pk2(s[4 * 33], s[5 * 33]); o.w = pk2(s[6 * 33], s[7 * 33]);
            *(u32x4*)(WT + (size_t)(n0 - rowoff + nn) * K + k0 + 8 * c) = o; }
    }
    LDS_WAIT(); asm volatile("" ::: "memory");
}
__device__ __forceinline__ void rms_row_bf16(const float* xrow, const float* gain, bf16_t* orow, int lane) {
    const f32x4* xr = (const f32x4*)xrow + lane;
    f32x4 v[16]; float s = 0.f;
#pragma unroll
    for (int j = 0; j < 16; ++j) { v[j] = xr[64 * j]; s += (v[j].x * v[j].x + v[j].y * v[j].y) + (v[j].z * v[j].z + v[j].w * v[j].w); }
    const float rstd = rsqrtf(wave_sum(s) * (1.f / D) + EPS);
    u32x2* o8 = (u32x2*)orow + lane; const f32x4* gr = (const f32x4*)gain + lane;
#pragma unroll
    for (int j = 0; j < 16; ++j) { const f32x4 g = gr[64 * j]; u32x2 w; w.x = pk2(v[j].x * rstd * g.x, v[j].y * rstd * g.y); w.y = pk2(v[j].z * rstd * g.z, v[j].w * rstd * g.w); o8[64 * j] = w; }
}
__device__ __forceinline__ void rms_row_bf16_i8n(const float* xrow, const float* gain, bf16_t* orow, unsigned char* o8row, float* scale, int lane) {
    const f32x4* xr = (const f32x4*)xrow + lane;
    f32x4 v[16]; float s = 0.f;
#pragma unroll
    for (int j = 0; j < 16; ++j) { v[j] = xr[64 * j]; s += (v[j].x * v[j].x + v[j].y * v[j].y) + (v[j].z * v[j].z + v[j].w * v[j].w); }
    const float rstd = rsqrtf(wave_sum(s) * (1.f / D) + EPS);
    u32x2* o8 = (u32x2*)orow + lane; const f32x4* gr = (const f32x4*)gain + lane; float m = 0.f;
#pragma unroll
    for (int j = 0; j < 16; ++j) { const f32x4 g = gr[64 * j]; v[j].x *= rstd * g.x; v[j].y *= rstd * g.y; v[j].z *= rstd * g.z; v[j].w *= rstd * g.w;
        u32x2 w; w.x = pk2(v[j].x, v[j].y); w.y = pk2(v[j].z, v[j].w); o8[64 * j] = w;
        m = fmaxf(m, fmaxf(fmaxf(fabsf(v[j].x), fabsf(v[j].y)), fmaxf(fabsf(v[j].z), fabsf(v[j].w)))); }
    m = fmaxf(wave_max(m), 1e-30f); const float inv = 127.0f / m;
    if (lane == 0) *scale = m * (1.0f / 127.0f);
    unsigned* o4 = (unsigned*)o8row + lane;
#pragma unroll
    for (int j = 0; j < 16; ++j) { const int q0 = (int)rintf(v[j].x * inv), q1 = (int)rintf(v[j].y * inv), q2 = (int)rintf(v[j].z * inv), q3 = (int)rintf(v[j].w * inv);
        o4[64 * j] = (unsigned)(q0 & 255) | ((unsigned)(q1 & 255) << 8) | ((unsigned)(q2 & 255) << 16) | ((unsigned)(q3 & 255) << 24); }
}
__device__ __forceinline__ void rms_row_i8(const float* xrow, const float* gain, unsigned char* o8row, float* scale, float* hsum, int lane) {
    const f32x4* xr = (const f32x4*)xrow + 2 * lane;
    f32x4 v[16]; float s = 0.f;
#pragma unroll
    for (int j = 0; j < 8; ++j) { v[2 * j] = xr[128 * j]; v[2 * j + 1] = xr[128 * j + 1]; }
#pragma unroll
    for (int j = 0; j < 16; ++j) s += (v[j].x * v[j].x + v[j].y * v[j].y) + (v[j].z * v[j].z + v[j].w * v[j].w);
    const float rstd = rsqrtf(wave_sum(s) * (1.f / D) + EPS);
    const f32x4* gr = (const f32x4*)gain + 2 * lane; float m = 0.f;
#pragma unroll
    for (int j = 0; j < 8; ++j) {
#pragma unroll
        for (int q = 0; q < 2; ++q) { const f32x4 g = gr[128 * j + q]; f32x4& x = v[2 * j + q]; x.x *= rstd * g.x; x.y *= rstd * g.y; x.z *= rstd * g.z; x.w *= rstd * g.w;
            m = fmaxf(m, fmaxf(fmaxf(fabsf(x.x), fabsf(x.y)), fmaxf(fabsf(x.z), fabsf(x.w)))); }
        }
    m = fmaxf(wave_max(m), 1e-30f); const float inv = 127.0f / m;
    int isum = 0;
#pragma unroll
    for (int j = 0; j < 8; ++j) { const f32x4 a = v[2 * j], b = v[2 * j + 1];
        const int q0 = (int)rintf(a.x * inv), q1 = (int)rintf(a.y * inv), q2 = (int)rintf(a.z * inv), q3 = (int)rintf(a.w * inv), q4 = (int)rintf(b.x * inv), q5 = (int)rintf(b.y * inv), q6 = (int)rintf(b.z * inv), q7 = (int)rintf(b.w * inv);
        isum += (q0 + q1) + (q2 + q3) + (q4 + q5) + (q6 + q7);
        u32x2 w; w.x = (unsigned)(q0 & 255) | ((unsigned)(q2 & 255) << 8) | ((unsigned)(q4 & 255) << 16) | ((unsigned)(q6 & 255) << 24);
        w.y = (unsigned)(q1 & 255) | ((unsigned)(q3 & 255) << 8) | ((unsigned)(q5 & 255) << 16) | ((unsigned)(q7 & 255) << 24);
        ((u32x2*)o8row)[lane + 64 * j] = w; }
#pragma unroll
    for (int o = 1; o < 64; o <<= 1) isum += __shfl_xor(isum, o);
    if (lane == 0) { *scale = m * (1.0f / 127.0f); *hsum = (float)isum; }
}
__device__ __forceinline__ void cvt_table(const float* src, bf16_t* dst, size_t n8, size_t gt, size_t ngt) {
    for (size_t i = gt; i < n8; i += ngt) { const f32x4 a = ((const f32x4*)src)[2 * i], b = ((const f32x4*)src)[2 * i + 1];
        u32x4 w; w.x = pk2(a.x, a.y); w.y = pk2(a.z, a.w); w.z = pk2(b.x, b.y); w.w = pk2(b.z, b.w); ((u32x4*)dst)[i] = w; }
}
__device__ __forceinline__ void quant_row_i4(const float* xrow, unsigned char* orow, float* scale, int lane) {
    const f32x4* xr = (const f32x4*)xrow + 2 * lane;
    f32x4 v[16]; float s = 0.f;
#pragma unroll
    for (int j = 0; j < 8; ++j) { v[2 * j] = xr[128 * j]; v[2 * j + 1] = xr[128 * j + 1]; }
#pragma unroll
    for (int j = 0; j < 16; ++j) s += (v[j].x * v[j].x + v[j].y * v[j].y) + (v[j].z * v[j].z + v[j].w * v[j].w);
    const float sc = fmaxf(2.5f * sqrtf(wave_sum(s) * (1.f / D)) * (1.f / 7.f), 1e-30f), inv = 1.0f / sc;
    if (lane == 0) *scale = sc;
    unsigned* o4 = (unsigned*)orow + lane;
#pragma unroll
    for (int j = 0; j < 8; ++j) { const f32x4 a = v[2 * j], b = v[2 * j + 1]; const float e[8] = {a.x, a.y, a.z, a.w, b.x, b.y, b.z, b.w}; unsigned w = 0u;
#pragma unroll
        for (int i = 0; i < 8; ++i) { const int q = (int)fminf(fmaxf(rintf(e[i] * inv), -7.f), 7.f) + 8; w |= (unsigned)q << (4 * i); }
        o4[64 * j] = w; }
}
__device__ __forceinline__ int nth_block(int j, bool want8) {
    int nb = -1;
#pragma unroll
    for (int s = 0; s < 9; ++s) { const int b0 = (s < 8 ? SEG_START[s] : O_AL) / 32, b1 = (s < 8 ? SEG_START[s + 1] : NPAD) / 32; const bool is8 = s < 8 && seg_i8(s);
        if (is8 == want8) { if (nb < 0 && j >= 0 && j < b1 - b0) nb = b0 + j; j -= (b1 - b0); } }
    return nb;
}
constexpr int count_blocks8() { int n = 0; for (int s = 0; s < 8; ++s) if (seg_i8(s)) n += (SEG_START[s + 1] - SEG_START[s]) / 32; return n; }
constexpr int NB8 = count_blocks8(), NBX = NPAD / 32 - NB8;
__device__ __forceinline__ void p0_prologue_a(Frame& F, const Args& a) {
    LAS float* scr = (LAS float*)(F.lds + F.wave * 16384);
    const int gw = F.bid * 8 + F.wave, NGW = F.G * 8;
    unsigned char* ws = F.ws;
    constexpr int I_BR = 32 * 128, I_O = 64 * 128, I_KV = 64 * 128;
    constexpr int I_X = 64 * NBX;
    constexpr int NITEMS = 3 * I_BR + I_O + I_KV + I_X;
    for (int it = gw; it < NITEMS; it += NGW) {
        int r = it;
        if (r < I_X) { const int nb = nth_block(r >> 6, false); transpose_item(a.in[3], D, 26640, NPAD, (bf16_t*)(ws + WS_WAL), scr, (r & 63) * (NPAD / 32) + nb, F.lane, true, ws + WS_W8, (bf16_t*)(ws + WS_WQX), (const unsigned*)(ws + WS_CTL + CTL_CMAX), (float*)(ws + WS_SW)); continue; } r -= I_X;
        if (r < I_BR) { transpose_item(a.in[8], 2048, D, D, (bf16_t*)(ws + WS_WBR), scr, r, F.lane, false); continue; } r -= I_BR;
        if (r < I_BR) { transpose_item(a.in[9], 2048, D, D, (bf16_t*)(ws + WS_WBR + 16 * MiB), scr, r, F.lane, false); continue; } r -= I_BR;
        if (r < I_BR) { transpose_item(a.in[11], 2048, D, D, (bf16_t*)(ws + WS_WBR + 32 * MiB), scr, r, F.lane, false); continue; } r -= I_BR;
        if (r < I_O) { transpose_item(a.in[13], D, D, D, (bf16_t*)(ws + WS_WO), scr, r, F.lane, false); continue; } r -= I_O;
        transpose_item(a.in[10], D, D, D, (bf16_t*)(ws + WS_WKV), scr, r, F.lane, false);
    }
    for (int m = gw; m < T; m += NGW) rms_row_bf16_i8n(a.in[0] + (size_t)m * D, a.in[2], (bf16_t*)(ws + WS_HN) + (size_t)m * D, ws + WS_HN8 + (size_t)m * D, (float*)(ws + WS_SHN) + m, F.lane);
    for (int m = gw; m < MEMT; m += NGW) rms_row_bf16(a.in[1] + (size_t)m * D, a.in[14], (bf16_t*)(ws + WS_MEMN) + (size_t)m * D, F.lane);
    const size_t gt = (size_t)F.bid * 512 + F.tid, ngt = (size_t)F.G * 512;
    cvt_table(a.in[17], (bf16_t*)(ws + WS_SUBK), (size_t)8 * 2 * 128 * 128 / 8, gt, ngt);
    { unsigned* cmq = (unsigned*)(ws + WS_CTL + CTL_CMAXPQ);
      for (int u = F.bid; u < 256; u += F.G) { const float* wp = a.in[16] + (size_t)(16 * u) * 2048 + 4 * F.tid; f32x4 m = (f32x4){0.f, 0.f, 0.f, 0.f};
#pragma unroll
          for (int r = 0; r < 16; ++r) { const f32x4 v = *(const f32x4*)(wp + (size_t)r * 2048); m.x = fmaxf(m.x, fabsf(v.x)); m.y = fmaxf(m.y, fabsf(v.y)); m.z = fmaxf(m.z, fabsf(v.z)); m.w = fmaxf(m.w, fabsf(v.w)); }
          atomicMax(cmq + 4 * F.tid + 0, __float_as_uint(m.x)); atomicMax(cmq + 4 * F.tid + 1, __float_as_uint(m.y)); atomicMax(cmq + 4 * F.tid + 2, __float_as_uint(m.z)); atomicMax(cmq + 4 * F.tid + 3, __float_as_uint(m.w)); } }
}
__device__ __forceinline__ void p0_weights8(Frame& F, const Args& a) {
    LAS float* scr = (LAS float*)(F.lds + F.wave * 16384); LAS float* smax = (LAS float*)(F.lds + 131072); LAS float* bmax = smax + 768;
    unsigned char* ws = F.ws; const int lane = F.lane, q = lane & 7, r8 = lane >> 3, c = lane & 7;
    const float* W = a.in[3]; float* sw = (float*)(ws + WS_SW);
    for (int g3 = F.bid; 3 * g3 < NB8; g3 += F.G) {
        int nbk[3];
#pragma unroll
        for (int k = 0; k < 3; ++k) { const int nb_ = nth_block(3 * g3 + k, true); nbk[k] = nb_ >= 0 ? nb_ : nth_block(3 * g3, true); }
        {
            const float* wa = W + (size_t)(8 * F.wave + r8) * 26640; const int s0 = src_col(32 * nbk[0] + 4 * q), s1 = src_col(32 * nbk[1] + 4 * q), s2 = src_col(32 * nbk[2] + 4 * q);
            f32x4 m0 = (f32x4){0.f, 0.f, 0.f, 0.f}, m1 = m0, m2 = m0;
#pragma unroll 1
            for (int g = 0; g < 8; ++g) { f32x4 v[24];
#pragma unroll
                for (int i = 0; i < 8; ++i) { const float* rp = wa + (size_t)(64 * (8 * g + i)) * 26640; v[3 * i] = *(const f32x4*)(rp + s0); v[3 * i + 1] = *(const f32x4*)(rp + s1); v[3 * i + 2] = *(const f32x4*)(rp + s2); }
#pragma unroll
                for (int i = 0; i < 8; ++i) {
                    m0.x = fmaxf(m0.x, fabsf(v[3 * i].x)); m0.y = fmaxf(m0.y, fabsf(v[3 * i].y)); m0.z = fmaxf(m0.z, fabsf(v[3 * i].z)); m0.w = fmaxf(m0.w, fabsf(v[3 * i].w));
                    m1.x = fmaxf(m1.x, fabsf(v[3 * i + 1].x)); m1.y = fmaxf(m1.y, fabsf(v[3 * i + 1].y)); m1.z = fmaxf(m1.z, fabsf(v[3 * i + 1].z)); m1.w = fmaxf(m1.w, fabsf(v[3 * i + 1].w));
                    m2.x = fmaxf(m2.x, fabsf(v[3 * i + 2].x)); m2.y = fmaxf(m2.y, fabsf(v[3 * i + 2].y)); m2.z = fmaxf(m2.z, fabsf(v[3 * i + 2].z)); m2.w = fmaxf(m2.w, fabsf(v[3 * i + 2].w)); } }
            f32x4 mm[3] = {m0, m1, m2};
#pragma unroll
            for (int k = 0; k < 3; ++k) {
#pragma unroll
                for (int o_ = 8; o_ < 64; o_ <<= 1) { mm[k].x = fmaxf(mm[k].x, __shfl_xor(mm[k].x, o_)); mm[k].y = fmaxf(mm[k].y, __shfl_xor(mm[k].y, o_)); mm[k].z = fmaxf(mm[k].z, __shfl_xor(mm[k].z, o_)); mm[k].w = fmaxf(mm[k].w, __shfl_xor(mm[k].w, o_)); }
                if (lane < 8) { LAS float* d = smax + k * 256 + F.wave * 32 + 4 * q; d[0] = mm[k].x; d[1] = mm[k].y; d[2] = mm[k].z; d[3] = mm[k].w; } }
        }
        __syncthreads();
        if (F.tid < 96) { const int k = F.tid >> 5, cc = F.tid & 31; float m = 0.f;
#pragma unroll
            for (int w = 0; w < 8; ++w) m = fmaxf(m, smax[k * 256 + w * 32 + cc]);
            m = fmaxf(m, 1e-30f); bmax[F.tid] = m; sw[32 * nbk[k] + cc] = m * (1.0f / 127.0f); }
        __syncthreads();
        {
            const float* wp = W + (size_t)(512 * F.wave + r8) * 26640;
            const int s0 = src_col(32 * nbk[0] + 4 * q), s1 = src_col(32 * nbk[1] + 4 * q), s2 = src_col(32 * nbk[2] + 4 * q);
            float inv[3][4]; unsigned roff[3][4];
#pragma unroll
            for (int k = 0; k < 3; ++k)
#pragma unroll
                for (int j = 0; j < 4; ++j) { const int nn = r8 + 8 * j; inv[k][j] = 127.0f / bmax[32 * k + nn]; roff[k][j] = (unsigned)w_row_off(32 * nbk[k] + nn); }
            f32x4 v0[8], v1[8], v2[8];
#pragma unroll
            for (int i = 0; i < 8; ++i) { const float* rp = wp + (size_t)(8 * i) * 26640; v0[i] = *(const f32x4*)(rp + s0); v1[i] = *(const f32x4*)(rp + s1); v2[i] = *(const f32x4*)(rp + s2); }
#define P0W_BLOCK(V, SX, KB) do { \
                _Pragma("unroll") for (int i = 0; i < 8; ++i) { LAS float* d = scr + (8 * i + r8) * 33 + 4 * q; d[0] = V[i].x; d[1] = V[i].y; d[2] = V[i].z; d[3] = V[i].w; } \
                LDS_WAIT(); asm volatile("" ::: "memory"); \
                if (ck < 7) { _Pragma("unroll") for (int i = 0; i < 8; ++i) V[i] = *(const f32x4*)(wp + (size_t)(64 * (ck + 1) + 8 * i) * 26640 + (SX)); } \
                _Pragma("unroll") for (int j = 0; j < 4; ++j) { const int nn = r8 + 8 * j; const LAS float* s_ = scr + (8 * c) * 33 + nn; int qv[8]; \
                    _Pragma("unroll") for (int e_ = 0; e_ < 8; ++e_) qv[e_] = (int)rintf(s_[e_ * 33] * inv[KB][j]) & 255; \
                    *(u32x2*)(ws + WS_W8 + roff[KB][j] + k0 + 8 * c) = (u32x2){(unsigned)(qv[0] | (qv[1] << 8) | (qv[2] << 16) | (qv[3] << 24)), (unsigned)(qv[4] | (qv[5] << 8) | (qv[6] << 16) | (qv[7] << 24))}; } \
                LDS_WAIT(); asm volatile("" ::: "memory"); } while (0)
#pragma unroll 1
            for (int ck = 0; ck < 8; ++ck) { const int k0 = 512 * F.wave + 64 * ck;
                P0W_BLOCK(v0, s0, 0); P0W_BLOCK(v1, s1, 1); P0W_BLOCK(v2, s2, 2); }
#undef P0W_BLOCK
        }
        __syncthreads();
    }
}
__device__ __forceinline__ void peer_wq_convert(Frame& F, const Args& a) {
    LAS float* scr = (LAS float*)(F.lds + F.wave * 16384);
    const int gw = F.bid * 8 + F.wave, NGW = F.G * 8; unsigned char* ws = F.ws;
    for (int it = gw; it < 64 * 64; it += NGW)
        transpose_item(a.in[16], D, 2048, 2048, nullptr, scr, it, F.lane, false, ws + WS_WPQ, nullptr, (const unsigned*)(ws + WS_CTL + CTL_CMAXPQ), (float*)(ws + WS_SWPQ), true);
}

struct P1Sched {
    const char *hn, *wreg, *wal, *memn, *wkv; int G, c;
    __device__ __forceinline__ bool next(int i, gg::Unit& u) const {
        long L = (long)i * G + c; u.aux = 0;
        if (L < 64 * NTB) { int pm, pn; gg::tile_order(L, 64, NTB > 0 ? NTB : 1, pm, pn); pn = map_tile(pn, false);
            u.kind = 0; u.pm = pm; u.pn = pn; u.A = hn + (size_t)pm * 256 * D * 2; u.B = wreg + w_row_off(256 * pn); return true; }
        L -= 64 * NTB;
        if (L < 64) { u.kind = 0; u.pm = (int)L; u.pn = 104; u.A = hn + (size_t)L * 256 * D * 2; u.B = wal; return true; }
        L -= 64;
        if (!V_I8) { if (L < 512) { u.kind = 1; u.pm = (int)(L % 8); u.pn = (int)(L / 8); u.A = wreg + w_row_off(O_VG + 256 * u.pm); u.B = hn + (size_t)u.pn * 256 * D * 2; return true; } L -= 512; }
        if (L < 64) { u.kind = 2; u.pm = (int)(L % 4); u.pn = (int)(L / 4); u.A = memn + (size_t)u.pm * 256 * D * 2; u.B = wkv + (size_t)u.pn * 256 * D * 2; return true; }
        return false;
    }
};
struct I8Sched {
    const char *hn8, *wreg; int G, c;
    __device__ __forceinline__ bool next(int i, gg::Unit& u) const {
        const int rb = NU_B % G, ext = (rb > 0 && NU_8 >= 2 * (G - rb)) ? 2 * (G - rb) : 0, x = (NU_8 - ext) / G, rem = (NU_8 - ext) % G;
        const int cnt1 = x + (c < rem ? 1 : 0);
        long L; u.aux = 0;
        if (i < cnt1) L = (long)i * G + c; else if (ext > 0 && c >= rb && i - cnt1 < 2) L = (long)x * G + rem + 2 * (c - rb) + (i - cnt1); else return false;
        if (L < 64 * NT8) { int pm, pn; gg::tile_order(L, 64, NT8 > 0 ? NT8 : 1, pm, pn); pn = map_tile(pn, true);
            u.kind = 0; u.pm = pm; u.pn = pn; u.A = hn8 + (size_t)pm * 256 * D; u.B = wreg + w_row_off(256 * pn); return true; }
        L -= 64 * NT8;
        if (V_I8 && L < 512) { u.kind = 1; u.pm = (int)(L % 8); u.pn = (int)(L / 8); u.A = wreg + w_row_off(O_VG + 256 * u.pm); u.B = hn8 + (size_t)u.pn * 256 * D; return true; }
        return false;
    }
};
struct I8Epi {
    unsigned char* ws; const float* bgate;
    __device__ __forceinline__ int nst(const gg::Unit& u) const { return 16; }
    __device__ __forceinline__ bool operator()(gg::Acc& acc, const gg::Unit& u, int wr, int wc, int fr, int fq, int wid, int lane) const {
        bf16_t* base; int ldc, col0, mode = 0; const int row0 = u.pm * 256; const float *rs, *cs;
        const float* shn = (const float*)(ws + WS_SHN); const float* sw = (const float*)(ws + WS_SW);
        if (u.kind == 0) { const int c0 = u.pn * 256; rs = shn + row0; cs = sw + c0;
            if (c0 < O_KG) { base = (bf16_t*)(ws + WS_QG); ldc = 1024; col0 = c0; }
            else if (c0 < O_VG) { base = (bf16_t*)(ws + WS_KG); ldc = 1024; col0 = c0 - O_KG; }
            else if (c0 < O_CB) { base = (bf16_t*)(ws + WS_RG); ldc = 2048; col0 = c0 - O_RG; }
            else if (c0 < O_CC) { base = (bf16_t*)(ws + WS_CB); ldc = 2048; col0 = c0 - O_CB; }
            else if (c0 < O_CH) { base = (bf16_t*)(ws + WS_CC); ldc = 2048; col0 = c0 - O_CC; }
            else if (c0 < O_QX) { base = (bf16_t*)(ws + WS_CH); ldc = 2048; col0 = c0 - O_CH; }
            else { base = (bf16_t*)(ws + WS_GT); ldc = 12288; col0 = c0 - O_GT; mode = 1; }
        } else { base = (bf16_t*)(ws + WS_VT); ldc = T; col0 = u.pn * 256; rs = sw + O_VG + row0; cs = shn + col0; }
        float rvv[2][4]; f32x4 cv[2][2], bv[2][2];
#pragma unroll
        for (int ai = 0; ai < 2; ++ai)
#pragma unroll
            for (int m = 0; m < 4; ++m) rvv[ai][m] = rs[ai * 128 + wr * 64 + m * 16 + fr];
#pragma unroll
        for (int bj = 0; bj < 2; ++bj) { const float* cp = cs + bj * 128 + wc * 32 + 8 * fq; cv[bj][0] = *(const f32x4*)cp; cv[bj][1] = *(const f32x4*)(cp + 4);
            bv[bj][0] = (f32x4){0.f, 0.f, 0.f, 0.f}; bv[bj][1] = bv[bj][0];
            if (mode == 1) { const float* bp = bgate + col0 + bj * 128 + wc * 32 + 8 * fq; bv[bj][0] = *(const f32x4*)bp; bv[bj][1] = *(const f32x4*)(bp + 4); } }
#pragma unroll
        for (int bj = 0; bj < 2; ++bj) { const f32x4 c0v = cv[bj][0], c1v = cv[bj][1], b0 = bv[bj][0], b1 = bv[bj][1];
#pragma unroll
            for (int ai = 0; ai < 2; ++ai)
#pragma unroll
                for (int m = 0; m < 4; ++m) { const int r = ai * 128 + wr * 64 + m * 16 + fr; const float rv = rvv[ai][m];
                    const i32x4 i0 = __builtin_bit_cast(i32x4, acc[ai][bj][m][0]), i1 = __builtin_bit_cast(i32x4, acc[ai][bj][m][1]);
                    f32x4 v0 = (f32x4){(float)i0[0], (float)i0[1], (float)i0[2], (float)i0[3]} * (c0v * rv) + b0, v1 = (f32x4){(float)i1[0], (float)i1[1], (float)i1[2], (float)i1[3]} * (c1v * rv) + b1;
                    if (mode == 1) {
#pragma unroll
                        for (int j = 0; j < 4; ++j) { v0[j] = inv_sigmoid(v0[j]); v1[j] = inv_sigmoid(v1[j]); } }
                    u32x4 w; w.x = pk2(v0[0], v0[1]); w.y = pk2(v0[2], v0[3]); w.z = pk2(v1[0], v1[1]); w.w = pk2(v1[2], v1[3]);
                    *(u32x4*)(base + (size_t)(row0 + r) * ldc + col0 + bj * 128 + wc * 32 + 8 * fq) = w; } }
        return true;
    }
};
struct P1Epi {
    unsigned char* ws; const float* bgate;
    __device__ __forceinline__ int nst(const gg::Unit& u) const { return 0; }
    __device__ __forceinline__ bool operator()(gg::Acc& acc, const gg::Unit& u, int wr, int wc, int fr, int fq, int wid, int lane) const {
        bf16_t* base; int ldc, col0, mode = 0; const int row0 = u.pm * 256;
        if (u.kind == 0) { const int c0 = u.pn * 256;
            if (c0 < O_KG) { base = (bf16_t*)(ws + WS_QG); ldc = 1024; col0 = c0; }
            else if (c0 < O_VG) { base = (bf16_t*)(ws + WS_KG); ldc = 1024; col0 = c0 - O_KG; }
            else if (c0 < O_CB) { base = (bf16_t*)(ws + WS_RG); ldc = 2048; col0 = c0 - O_RG; }
            else if (c0 < O_CC) { base = (bf16_t*)(ws + WS_CB); ldc = 2048; col0 = c0 - O_CB; }
            else if (c0 < O_CH) { base = (bf16_t*)(ws + WS_CC); ldc = 2048; col0 = c0 - O_CC; }
            else if (c0 < O_QX) { base = (bf16_t*)(ws + WS_CH); ldc = 2048; col0 = c0 - O_CH; }
            else if (c0 < O_GT) { base = (bf16_t*)(ws + WS_QX); ldc = 2048; col0 = c0 - O_QX; }
            else if (c0 < O_AL) { base = (bf16_t*)(ws + WS_GT); ldc = 12288; col0 = c0 - O_GT; mode = 1; }
            else { base = nullptr; ldc = 0; col0 = 0; mode = 2; }
        } else if (u.kind == 1) { base = (bf16_t*)(ws + WS_VT); ldc = T; col0 = u.pn * 256; }
        else { base = (bf16_t*)(ws + WS_KVM); ldc = 4096; col0 = u.pn * 256; }
        if (mode == 0) { gg::store_bf16_tile(acc, base, ldc, row0, col0, wr, wc, fr, fq); }
        else if (mode == 1) {
#pragma unroll
            for (int bj = 0; bj < 2; ++bj) { const float* bp = bgate + col0 + bj * 128 + wc * 32 + 8 * fq; const f32x4 b0 = *(const f32x4*)bp, b1 = *(const f32x4*)(bp + 4);
#pragma unroll
                for (int ai = 0; ai < 2; ++ai)
#pragma unroll
                    for (int m = 0; m < 4; ++m) { f32x4 v0 = acc[ai][bj][m][0] + b0, v1 = acc[ai][bj][m][1] + b1;
#pragma unroll
                        for (int j = 0; j < 4; ++j) { v0[j] = inv_sigmoid(v0[j]); v1[j] = inv_sigmoid(v1[j]); }
                        u32x4 w; w.x = pk2(v0[0], v0[1]); w.y = pk2(v0[2], v0[3]); w.z = pk2(v1[0], v1[1]); w.w = pk2(v1[2], v1[3]);
                        *(u32x4*)(base + (size_t)(row0 + ai * 128 + wr * 64 + m * 16 + fr) * ldc + col0 + bj * 128 + wc * 32 + 8 * fq) = w; } }
        } else {
            if (wc == 0 && fq < 2) { float* alr = (float*)(ws + WS_ALR);
#pragma unroll
                for (int ai = 0; ai < 2; ++ai)
#pragma unroll
                    for (int m = 0; m < 4; ++m) { float* p = alr + (size_t)(row0 + ai * 128 + wr * 64 + m * 16 + fr) * 16 + 8 * fq;
                        *(f32x4*)p = acc[ai][0][m][0]; *(f32x4*)(p + 4) = acc[ai][0][m][1]; } }
        }
        return true;
    }
};

constexpr int PREP_ROWB = 528;
constexpr int PREP_QT = 0, PREP_KI = 2 * 64 * PREP_ROWB, PREP_ALR = 4 * 64 * PREP_ROWB;
constexpr int PREP_KOT_ROWB = 144;
__device__ __forceinline__ void gla_prep_unit(Frame& F, const Args& a, int unit) {
    const int hp = unit & 1, n = (unit >> 1) & 63, b = unit >> 7;
    const int tid = F.tid, hh = tid >> 8, c = tid & 255, h = 2 * hp + hh, lane = F.lane, wid = F.wave;
    const int tok0 = b * SEQ + n * 64;
    unsigned char* ws = F.ws;
    LAS float* alr_s = (LAS float*)(F.lds + PREP_ALR);
    LAS unsigned char* qt_s = F.lds + PREP_QT + hh * 64 * PREP_ROWB;
    LAS unsigned char* ki_s = F.lds + PREP_KI + hh * 64 * PREP_ROWB;
    if (tid < 256) ((LAS f32x4*)alr_s)[tid] = ((const f32x4*)((const float*)(ws + WS_ALR) + (size_t)tok0 * 16))[tid];
    float w[16];
#pragma unroll
    for (int r = 0; r < 16; ++r) w[r] = a.in[4][r * 1024 + h * 256 + c];
    const float ba = a.in[5][h * 256 + c];
    __syncthreads();
    float bt[64]; float cum = 0.f;
#pragma unroll
    for (int t = 0; t < 64; ++t) {
        float z = ba;
#pragma unroll
        for (int r = 0; r < 16; ++r) z += alr_s[t * 16 + r] * w[r];
        const float ls = fminf(z, 0.f) - __logf(1.0f + __expf(-fabsf(z)));
        cum += ls * (1.0f / 16.0f); bt[t] = cum;
    }
    const bf16_t* qg = (const bf16_t*)(ws + WS_QG) + (size_t)tok0 * 1024 + h * 256 + c;
    const bf16_t* kg = (const bf16_t*)(ws + WS_KG) + (size_t)tok0 * 1024 + h * 256 + c;
#pragma unroll
    for (int t = 0; t < 64; ++t) {
        const float q = bf2f(qg[(size_t)t * 1024]), k = bf2f(kg[(size_t)t * 1024]);
        const float eb = __expf(bt[t]);
        *(LAS bf16_t*)(qt_s + t * PREP_ROWB + c * 2) = (bf16_t)f2bf(q * eb * 0.0625f);
        *(LAS bf16_t*)(ki_s + t * PREP_ROWB + c * 2) = (bf16_t)f2bf(k * __expf(-bt[t]));
    }
    unsigned char* blk = ws + WS_GLAB + (size_t)((b * 4 + h) * 64 + n) * GLA_BLK;
    ((float*)(blk + 73728))[c] = __expf(cum);
    __syncthreads();
    {
        const int whh = wid >> 2, mb = wid & 3, fr = lane & 15, fq = lane >> 4;
        LAS unsigned char* qs = F.lds + PREP_QT + whh * 64 * PREP_ROWB; LAS unsigned char* ks = F.lds + PREP_KI + whh * 64 * PREP_ROWB;
        unsigned char* wblk = ws + WS_GLAB + (size_t)((b * 4 + 2 * hp + whh) * 64 + n) * GLA_BLK;
        bf16_t* attf = (bf16_t*)(wblk + 65536);
#pragma unroll
        for (int nb = 0; nb < 4; ++nb) {
            f32x4 acc = (f32x4){0.f, 0.f, 0.f, 0.f};
            if (nb <= mb) {
#pragma unroll
                for (int kk = 0; kk < 8; ++kk) {
                    const bf16x8 av = *(const LAS bf16x8*)(qs + (16 * mb + fr) * PREP_ROWB + (32 * kk + 8 * fq) * 2);
                    const bf16x8 bv = *(const LAS bf16x8*)(ks + (16 * nb + fr) * PREP_ROWB + (32 * kk + 8 * fq) * 2);
                    acc = __builtin_amdgcn_mfma_f32_16x16x32_bf16(av, bv, acc, 0, 0, 0);
                }
            }
            const int s = 16 * nb + fr;
#pragma unroll
            for (int j = 0; j < 4; ++j) { const int t = 16 * mb + 4 * fq + j; const float v = (s <= t) ? acc[j] : 0.f;
                attf[((mb * 2 + (s >> 5)) * 64 + (t & 15) + 16 * ((s & 31) >> 3)) * 8 + (s & 7)] = (bf16_t)f2bf(v); }
        }
        u32x4* qtf = (u32x4*)wblk;
#pragma unroll
        for (int i = 0; i < 8; ++i) { const int f = (wid & 3) * 8 + i, mb2 = f >> 3, kk = f & 7;
            const LAS unsigned char* rowp = qs + (16 * mb2 + fr) * PREP_ROWB + (32 * kk + 4 * fq) * 2;
            const u32x2 lo = *(const LAS u32x2*)rowp, hi = *(const LAS u32x2*)(rowp + 32);
            u32x4 o; o.x = lo.x; o.y = lo.y; o.z = hi.x; o.w = hi.y; qtf[f * 64 + lane] = o; }
    }
    __syncthreads();
    {
        LAS unsigned char* kot = F.lds + hh * 256 * PREP_KOT_ROWB + c * PREP_KOT_ROWB;
#pragma unroll
        for (int t8 = 0; t8 < 8; ++t8) { float v[8];
#pragma unroll
            for (int j = 0; j < 8; ++j) { const int t = t8 * 8 + j; v[j] = bf2f(kg[(size_t)t * 1024]) * __expf(cum - bt[t]); }
            u32x4 o; o.x = pk2(v[0], v[1]); o.y = pk2(v[2], v[3]); o.z = pk2(v[4], v[5]); o.w = pk2(v[6], v[7]);
            *(LAS u32x4*)(kot + t8 * 16) = o; }
    }
    __syncthreads();
    {
        const int whh = wid >> 2, fr = lane & 15, fq = lane >> 4;
        unsigned char* wblk = ws + WS_GLAB + (size_t)((b * 4 + 2 * hp + whh) * 64 + n) * GLA_BLK;
        u32x4* kof = (u32x4*)(wblk + 32768);
        const LAS unsigned char* kb = F.lds + whh * 256 * PREP_KOT_ROWB;
#pragma unroll
        for (int i = 0; i < 8; ++i) { const int f = (wid & 3) * 8 + i, mbc = f >> 1, kk2 = f & 1;
            kof[f * 64 + lane] = *(const LAS u32x4*)(kb + (16 * mbc + fr) * PREP_KOT_ROWB + (32 * kk2 + 8 * fq) * 2); }
    }
    __syncthreads();
}

__device__ __forceinline__ void conv_phase(Frame& F, const Args& a, int wg, int nwg) {
    unsigned char* ws = F.ws;
    const size_t gt = (size_t)wg * 512 + F.tid, ngt = (size_t)nwg * 512;
    u32x4* cb = (u32x4*)(ws + WS_CB); const u32x4* cc = (const u32x4*)(ws + WS_CC); const u32x4* ch = (const u32x4*)(ws + WS_CH);
    const float* cw = a.in[7];
    for (size_t p = gt; p < (size_t)T * 256; p += ngt) {
        const int t = (int)(p >> 8), c8 = (int)(p & 255) * 8, pos = t & (SEQ - 1);
        float accv[8];
#pragma unroll
        for (int j = 0; j < 8; ++j) accv[j] = 0.f;
#pragma unroll
        for (int d = 0; d < 3; ++d) {
            if (pos >= d) { const u32x4 x = cc[p - (size_t)d * 256], y = ch[p - (size_t)d * 256];
                const f32x4 w0 = *(const f32x4*)(cw + d * 2048 + c8), w1 = *(const f32x4*)(cw + d * 2048 + c8 + 4);
                accv[0] += w0.x * (bflo(x.x) * bflo(y.x)); accv[1] += w0.y * (bfhi(x.x) * bfhi(y.x));
                accv[2] += w0.z * (bflo(x.y) * bflo(y.y)); accv[3] += w0.w * (bfhi(x.y) * bfhi(y.y));
                accv[4] += w1.x * (bflo(x.z) * bflo(y.z)); accv[5] += w1.y * (bfhi(x.z) * bfhi(y.z));
                accv[6] += w1.z * (bflo(x.w) * bflo(y.w)); accv[7] += w1.w * (bfhi(x.w) * bfhi(y.w)); }
        }
        const u32x4 bv = cb[p]; u32x4 o;
        o.x = pk2(bflo(bv.x) * accv[0], bfhi(bv.x) * accv[1]); o.y = pk2(bflo(bv.y) * accv[2], bfhi(bv.y) * accv[3]);
        o.z = pk2(bflo(bv.z) * accv[4], bfhi(bv.z) * accv[5]); o.w = pk2(bflo(bv.w) * accv[6], bfhi(bv.w) * accv[7]);
        cb[p] = o;
    }
}

struct XsSched {
    const char *hn, *wkt; int G, c;
    __device__ __forceinline__ bool next(int i, gg::Unit& u) const {
        const long L = (long)i * G + c; if (L >= 256) return false;
        const int xcd = (int)(L % 8), off = (int)(L / 8), w = xcd * 32 + off;
        const int pm = w >> 2, h = w & 3, b = pm >> 4;
        u.kind = 0; u.pm = pm; u.pn = h; u.aux = 0;
        u.A = hn + (size_t)pm * 256 * D * 2; u.B = wkt + ((size_t)(b * 1024 + h * 256) * D) * 2; return true;
    }
};
struct WkSched {
    const char *kvm, *wqx; int G, c;
    __device__ __forceinline__ bool next(int i, gg::Unit& u) const {
        const long L = (long)i * G + c; if (L >= 256) return false;
        const int bh = (int)(L >> 4), ntile = (int)(L & 15), b = bh >> 2, h = bh & 3;
        u.kind = 0; u.pm = b * 4 + h; u.pn = ntile; u.aux = 0;
        u.A = kvm + ((size_t)(b * 256) * 4096 + h * 512) * 2; u.B = wqx + ((size_t)(ntile * 256) * 2048 + h * 512) * 2; return true;
    }
};
struct WkEpi {
    bf16_t* wkt;
    __device__ __forceinline__ int nst(const gg::Unit& u) const { return 16; }
    __device__ __forceinline__ bool operator()(gg::Acc& acc, const gg::Unit& u, int wr, int wc, int fr, int fq, int wid, int lane) const {
        gg::store_bf16_tile(acc, wkt, D, u.pm * 256, u.pn * 256, wr, wc, fr, fq); return true;
    }
};
struct XsEpi {
    bf16_t* prob; LAS unsigned char* ex;
    __device__ __forceinline__ int nst(const gg::Unit& u) const { return 0; }
    __device__ __forceinline__ bool operator()(gg::Acc& acc, const gg::Unit& u, int wr, int wc, int fr, int fq, int wid, int lane) const {
        LAS float* MX = (LAS float*)ex; LAS float* SM = (LAS float*)(ex + 4096);
        const float sc = 0.04419417382f * 1.44269504089f;
#pragma unroll
        for (int ai = 0; ai < 2; ++ai)
#pragma unroll
            for (int m = 0; m < 4; ++m) { float v = -3.0e38f;
#pragma unroll
                for (int bj = 0; bj < 2; ++bj)
#pragma unroll
                    for (int n = 0; n < 2; ++n) { const f32x4 x = acc[ai][bj][m][n]; v = fmaxf(v, fmaxf(fmaxf(x[0], x[1]), fmaxf(x[2], x[3]))); }
                v = fmaxf(v, __shfl_xor(v, 16)); v = fmaxf(v, __shfl_xor(v, 32));
                if (fq == 0) MX[(ai * 128 + wr * 64 + m * 16 + fr) * 4 + wc] = v; }
        LDS_WAIT(); __builtin_amdgcn_s_barrier(); asm volatile("" ::: "memory");
#pragma unroll
        for (int ai = 0; ai < 2; ++ai)
#pragma unroll
            for (int m = 0; m < 4; ++m) { const f32x4 q = *(const LAS f32x4*)(MX + (ai * 128 + wr * 64 + m * 16 + fr) * 4);
                const float rm = fmaxf(fmaxf(q[0], q[1]), fmaxf(q[2], q[3])); float s = 0.f;
#pragma unroll
                for (int bj = 0; bj < 2; ++bj)
#pragma unroll
                    for (int n = 0; n < 2; ++n) {
#pragma unroll
                        for (int j = 0; j < 4; ++j) { const float e = __builtin_amdgcn_exp2f((acc[ai][bj][m][n][j] - rm) * sc); acc[ai][bj][m][n][j] = e; s += e; } }
                s += __shfl_xor(s, 16); s += __shfl_xor(s, 32);
                if (fq == 0) SM[(ai * 128 + wr * 64 + m * 16 + fr) * 4 + wc] = s; }
        LDS_WAIT(); __builtin_amdgcn_s_barrier(); asm volatile("" ::: "memory");
        const int b = u.pm >> 4, panel = u.pm & 15, h = u.pn;
#pragma unroll
        for (int ai = 0; ai < 2; ++ai)
#pragma unroll
            for (int m = 0; m < 4; ++m) { const f32x4 q = *(const LAS f32x4*)(SM + (ai * 128 + wr * 64 + m * 16 + fr) * 4);
                const float inv = 1.0f / ((q[0] + q[1]) + (q[2] + q[3]));
                bf16_t* rowp = prob + (size_t)(b * SEQ + panel * 256 + ai * 128 + wr * 64 + m * 16 + fr) * 2048 + h * 256 + wc * 32 + 8 * fq;
#pragma unroll
                for (int bj = 0; bj < 2; ++bj) { const f32x4 v0 = acc[ai][bj][m][0] * inv, v1 = acc[ai][bj][m][1] * inv;
                    u32x4 w; w.x = pk2(v0[0], v0[1]); w.y = pk2(v0[2], v0[3]); w.z = pk2(v1[0], v1[1]); w.w = pk2(v1[2], v1[3]);
                    *(u32x4*)(rowp + bj * 128) = w; } }
        return true;
    }
};

__device__ __forceinline__ void gla_scan_unit(Frame& F, const Args& a, int unit) {
    const int dvq = unit & 3, h = (unit >> 2) & 3, b = unit >> 4;
    const int lane = F.lane, wid = F.wave, fr = lane & 15, fq = lane >> 4;
    unsigned char* ws = F.ws;
    const unsigned char* blk0 = ws + WS_GLAB + (size_t)((b * 4 + h) * 64) * GLA_BLK;
    const int dvcol = 16 * (8 * dvq + wid);
    const bf16_t* vt = (const bf16_t*)(ws + WS_VT) + (size_t)(h * 512 + dvcol + fr) * T + (size_t)b * SEQ + 8 * fq;
    bf16_t* og = (bf16_t*)(ws + WS_OG) + (size_t)(b * SEQ) * 2048 + h * 512 + dvcol + fr;
    f32x4 S[16];
#pragma unroll
    for (int i = 0; i < 16; ++i) S[i] = (f32x4){0.f, 0.f, 0.f, 0.f};
    for (int p = wid; p < 73; p += 8)
        __builtin_amdgcn_global_load_lds((const unsigned*)(blk0 + (size_t)p * 1024 + lane * 16), (LAS unsigned*)(F.lds + p * 1024), 16, 0, 0);
    bf16x8 vf[2], vn[2];
    vf[0] = *(const bf16x8*)(vt); vf[1] = *(const bf16x8*)(vt + 32);
    vn[0] = vf[0]; vn[1] = vf[1];
    VM_WAIT(); __syncthreads();
    for (int n = 0; n < 64; ++n) {
        LAS unsigned char* buf = F.lds + (n & 1) * GLA_BLK;
        if (n < 63) {
            const unsigned char* nb = blk0 + (size_t)(n + 1) * GLA_BLK; LAS unsigned char* dst = F.lds + ((n + 1) & 1) * GLA_BLK;
            for (int p = wid; p < 73; p += 8)
                __builtin_amdgcn_global_load_lds((const unsigned*)(nb + (size_t)p * 1024 + lane * 16), (LAS unsigned*)(dst + p * 1024), 16, 0, 0);
            vn[0] = *(const bf16x8*)(vt + 64 * (n + 1)); vn[1] = *(const bf16x8*)(vt + 64 * (n + 1) + 32);
        }
        f32x4 o[4];
#pragma unroll
        for (int mb = 0; mb < 4; ++mb) o[mb] = (f32x4){0.f, 0.f, 0.f, 0.f};
#pragma unroll
        for (int kk = 0; kk < 8; ++kk) {
            u32x4 bw; bw.x = pk2(S[2 * kk][0], S[2 * kk][1]); bw.y = pk2(S[2 * kk][2], S[2 * kk][3]); bw.z = pk2(S[2 * kk + 1][0], S[2 * kk + 1][1]); bw.w = pk2(S[2 * kk + 1][2], S[2 * kk + 1][3]);
            const bf16x8 bfr = __builtin_bit_cast(bf16x8, bw);
#pragma unroll
            for (int mb = 0; mb < 4; ++mb) { const bf16x8 af = *(const LAS bf16x8*)(buf + ((mb * 8 + kk) * 64 + lane) * 16);
                o[mb] = __builtin_amdgcn_mfma_f32_16x16x32_bf16(af, bfr, o[mb], 0, 0, 0); }
        }
#pragma unroll
        for (int kk = 0; kk < 2; ++kk)
#pragma unroll
            for (int mb = 0; mb < 4; ++mb) { const bf16x8 af = *(const LAS bf16x8*)(buf + 65536 + ((mb * 2 + kk) * 64 + lane) * 16);
                o[mb] = __builtin_amdgcn_mfma_f32_16x16x32_bf16(af, vf[kk], o[mb], 0, 0, 0); }
        {
            bf16_t* op = og + (size_t)(64 * n) * 2048;
#pragma unroll
            for (int mb = 0; mb < 4; ++mb)
#pragma unroll
                for (int j = 0; j < 4; ++j) op[(size_t)(16 * mb + 4 * fq + j) * 2048] = (bf16_t)f2bf(o[mb][j]);
        }
#pragma unroll
        for (int mb = 0; mb < 16; ++mb) {
            const f32x4 dc = *(const LAS f32x4*)(buf + 73728 + (16 * mb + 4 * fq) * 4);
            S[mb] = S[mb] * dc;
#pragma unroll
            for (int kk = 0; kk < 2; ++kk) { const bf16x8 af = *(const LAS bf16x8*)(buf + 32768 + ((mb * 2 + kk) * 64 + lane) * 16);
                S[mb] = __builtin_amdgcn_mfma_f32_16x16x32_bf16(af, vf[kk], S[mb], 0, 0, 0); }
        }
        vf[0] = vn[0]; vf[1] = vn[1];
        VM_WAIT(); __syncthreads();
    }
}

struct VwSched {
    const char *wxa, *kvm; int G, c;
    __device__ __forceinline__ bool next(int i, gg::Unit& u) const {
        const long L = (long)i * G + c; if (L >= 256) return false;
        const int bh = (int)(L >> 4), pm = (int)(L & 15), b = bh >> 2, h = bh & 3;
        u.kind = 0; u.pm = b * 16 + pm; u.pn = h; u.aux = 0;
        u.A = wxa + ((size_t)(pm * 256) * 2048 + h * 512) * 2; u.B = kvm + ((size_t)(b * 256) * 4096 + 2048 + h * 512) * 2; return true;
    }
};
struct VwEpi {
    bf16_t* vwt;
    __device__ __forceinline__ int nst(const gg::Unit& u) const { return 16; }
    __device__ __forceinline__ bool operator()(gg::Acc& acc, const gg::Unit& u, int wr, int wc, int fr, int fq, int wid, int lane) const {
        gg::store_bf16_tile(acc, vwt, 2048, u.pm * 256, u.pn * 256, wr, wc, fr, fq); return true;
    }
};

__device__ __forceinline__ void gla_post_phase(Frame& F, const Args& a) {
    unsigned char* ws = F.ws;
    const int gw = F.bid * 8 + F.wave, NGW = F.G * 8, lane = F.lane;
    const float* gn = a.in[6];
    const f32x4 g0 = *(const f32x4*)(gn + lane * 8), g1 = *(const f32x4*)(gn + lane * 8 + 4);
    for (int t = gw; t < T; t += NGW) {
        const u32x4* orow = (const u32x4*)((const bf16_t*)(ws + WS_OG) + (size_t)t * 2048); u32x4* rrow = (u32x4*)((bf16_t*)(ws + WS_RG) + (size_t)t * 2048);
#pragma unroll
        for (int h = 0; h < 4; ++h) {
            const u32x4 ov = orow[h * 64 + lane], rv = rrow[h * 64 + lane];
            float o[8] = {bflo(ov.x), bfhi(ov.x), bflo(ov.y), bfhi(ov.y), bflo(ov.z), bfhi(ov.z), bflo(ov.w), bfhi(ov.w)};
            float r[8] = {bflo(rv.x), bfhi(rv.x), bflo(rv.y), bfhi(rv.y), bflo(rv.z), bfhi(rv.z), bflo(rv.w), bfhi(rv.w)};
            float s = 0.f;
#pragma unroll
            for (int j = 0; j < 8; ++j) s += o[j] * o[j];
            const float rstd = rsqrtf(wave_sum(s) * (1.f / 512.f) + EPS);
            const float gv[8] = {g0.x, g0.y, g0.z, g0.w, g1.x, g1.y, g1.z, g1.w};
            float y[8];
#pragma unroll
            for (int j = 0; j < 8; ++j) y[j] = o[j] * rstd * gv[j] * (r[j] * fast_sigmoid(r[j]));
            u32x4 w; w.x = pk2(y[0], y[1]); w.y = pk2(y[2], y[3]); w.z = pk2(y[4], y[5]); w.w = pk2(y[6], y[7]);
            rrow[h * 64 + lane] = w;
        }
    }
}

struct MgSched {
    const char *a0, *a1, *a2, *wbr, *vwt; int G, c;
    __device__ __forceinline__ bool next(int i, gg::Unit& u) const {
        const int ti = i / 3, br = i - 3 * ti; int pm, pn;
        if (!gg::tile_order((long)ti * G + c, 64, 16, pm, pn)) return false;
        u.kind = br; u.pm = pm; u.pn = pn; u.aux = br == 2 ? 16 : 32;
        const char* ab = br == 0 ? a0 : (br == 1 ? a1 : a2);
        u.A = ab + (size_t)pm * 256 * 2048 * 2;
        u.B = br == 2 ? vwt + ((size_t)((pm >> 4) * 4096 + pn * 256) * 2048) * 2 : wbr + (size_t)br * 16 * MiB + (size_t)pn * 256 * 2048 * 2; return true;
    }
};
struct MgEpi {
    const bf16_t* gt; bf16_t* merged;
    __device__ __forceinline__ int nst(const gg::Unit& u) const { return u.kind == 2 ? 16 : 0; }
    __device__ __forceinline__ bool operator()(gg::Acc& acc, const gg::Unit& u, int wr, int wc, int fr, int fq, int wid, int lane) const {
        const int br = u.kind;
#pragma unroll
        for (int ai = 0; ai < 2; ++ai) {
            u32x4 ga[4][2], gb[4][2];
#pragma unroll
            for (int m = 0; m < 4; ++m) { const size_t row = (size_t)(u.pm * 256 + ai * 128 + wr * 64 + m * 16 + fr);
#pragma unroll
                for (int bj = 0; bj < 2; ++bj) { const int col = u.pn * 256 + bj * 128 + wc * 32 + 8 * fq;
                    ga[m][bj] = *(const u32x4*)(gt + row * 12288 + br * 4096 + col);
                    gb[m][bj] = (br < 2) ? *(const u32x4*)(gt + row * 12288 + (br + 1) * 4096 + col) : (u32x4){0x3f803f80u, 0x3f803f80u, 0x3f803f80u, 0x3f803f80u}; } }
#pragma unroll
            for (int m = 0; m < 4; ++m) { const size_t row = (size_t)(u.pm * 256 + ai * 128 + wr * 64 + m * 16 + fr);
#pragma unroll
                for (int bj = 0; bj < 2; ++bj) { const int col = u.pn * 256 + bj * 128 + wc * 32 + 8 * fq;
                    const u32x4 a4 = ga[m][bj], b4 = gb[m][bj];
                    float g[8] = {bflo(a4.x), bfhi(a4.x), bflo(a4.y), bfhi(a4.y), bflo(a4.z), bfhi(a4.z), bflo(a4.w), bfhi(a4.w)};
                    if (br < 2) { const float d[8] = {bflo(b4.x), bfhi(b4.x), bflo(b4.y), bfhi(b4.y), bflo(b4.z), bfhi(b4.z), bflo(b4.w), bfhi(b4.w)};
#pragma unroll
                        for (int j = 0; j < 8; ++j) g[j] = d[j] * __builtin_amdgcn_rcpf(g[j]); }
                    else {
#pragma unroll
                        for (int j = 0; j < 8; ++j) g[j] = __builtin_amdgcn_rcpf(g[j]); }
                    f32x4 v0 = acc[ai][bj][m][0], v1 = acc[ai][bj][m][1];
                    v0[0] *= g[0]; v0[1] *= g[1]; v0[2] *= g[2]; v0[3] *= g[3]; v1[0] *= g[4]; v1[1] *= g[5]; v1[2] *= g[6]; v1[3] *= g[7];
                    if (br < 2) { acc[ai][bj][m][0] = v0; acc[ai][bj][m][1] = v1; }
                    else { u32x4 w; w.x = pk2(v0[0], v0[1]); w.y = pk2(v0[2], v0[3]); w.z = pk2(v1[0], v1[1]); w.w = pk2(v1[2], v1[3]);
                        *(u32x4*)(merged + row * D + col) = w; } } }
        }
        return br == 2;
    }
};

struct GridSched {
    const char *A, *B; int nM, nN, lda2, ldb2, G, c;
    __device__ __forceinline__ bool next(int i, gg::Unit& u) const {
        int pm, pn; if (!gg::tile_order((long)i * G + c, nM, nN, pm, pn)) return false;
        u.kind = 0; u.pm = pm; u.pn = pn; u.aux = 0; u.A = A + (size_t)pm * 256 * lda2; u.B = B + (size_t)pn * 256 * ldb2; return true;
    }
};
struct ResEpi {
    const float* x; float* out;
    __device__ __forceinline__ int nst(const gg::Unit& u) const { return 16; }
    __device__ __forceinline__ bool operator()(gg::Acc& acc, const gg::Unit& u, int wr, int wc, int fr, int fq, int wid, int lane) const {
#pragma unroll
        for (int ai = 0; ai < 2; ++ai) {
            f32x4 xv[4][2][2];
#pragma unroll
            for (int m = 0; m < 4; ++m) { const size_t off = (size_t)(u.pm * 256 + ai * 128 + wr * 64 + m * 16 + fr) * D + u.pn * 256 + wc * 32 + 8 * fq;
#pragma unroll
                for (int bj = 0; bj < 2; ++bj) { xv[m][bj][0] = *(const f32x4*)(x + off + bj * 128); xv[m][bj][1] = *(const f32x4*)(x + off + bj * 128 + 4); } }
#pragma unroll
            for (int m = 0; m < 4; ++m) { const size_t off = (size_t)(u.pm * 256 + ai * 128 + wr * 64 + m * 16 + fr) * D + u.pn * 256 + wc * 32 + 8 * fq;
#pragma unroll
                for (int bj = 0; bj < 2; ++bj) { *(f32x4*)(out + off + bj * 128) = xv[m][bj][0] + acc[ai][bj][m][0]; *(f32x4*)(out + off + bj * 128 + 4) = xv[m][bj][1] + acc[ai][bj][m][1]; } }
        }
        return true;
    }
};
struct PqEpi {
    bf16_t* o; const float* rs; const float* cs;
    __device__ __forceinline__ int nst(const gg::Unit& u) const { return 16; }
    __device__ __forceinline__ bool operator()(gg::Acc& acc, const gg::Unit& u, int wr, int wc, int fr, int fq, int wid, int lane) const {
        const int row0 = u.pm * 256, col0 = u.pn * 256;
        float rvv[2][4]; f32x4 cv[2][2];
#pragma unroll
        for (int ai = 0; ai < 2; ++ai)
#pragma unroll
            for (int m = 0; m < 4; ++m) rvv[ai][m] = rs[row0 + ai * 128 + wr * 64 + m * 16 + fr];
#pragma unroll
        for (int bj = 0; bj < 2; ++bj) { const float* cp = cs + col0 + bj * 128 + wc * 32 + 8 * fq; cv[bj][0] = *(const f32x4*)cp; cv[bj][1] = *(const f32x4*)(cp + 4); }
#pragma unroll
        for (int bj = 0; bj < 2; ++bj) { const f32x4 c0v = cv[bj][0], c1v = cv[bj][1];
#pragma unroll
            for (int ai = 0; ai < 2; ++ai)
#pragma unroll
                for (int m = 0; m < 4; ++m) { const int r = row0 + ai * 128 + wr * 64 + m * 16 + fr; const float rv = rvv[ai][m];
                    const i32x4 i0 = __builtin_bit_cast(i32x4, acc[ai][bj][m][0]), i1 = __builtin_bit_cast(i32x4, acc[ai][bj][m][1]);
                    const f32x4 v0 = (f32x4){(float)i0[0], (float)i0[1], (float)i0[2], (float)i0[3]} * (c0v * rv), v1 = (f32x4){(float)i1[0], (float)i1[1], (float)i1[2], (float)i1[3]} * (c1v * rv);
                    u32x4 w; w.x = pk2(v0[0], v0[1]); w.y = pk2(v0[2], v0[3]); w.z = pk2(v1[0], v1[1]); w.w = pk2(v1[2], v1[3]);
                    *(u32x4*)(o + (size_t)r * 2048 + col0 + bj * 128 + wc * 32 + 8 * fq) = w; } }
        return true;
    }
};
struct Bf16Epi {
    bf16_t* o; int ldc;
    __device__ __forceinline__ int nst(const gg::Unit& u) const { return 16; }
    __device__ __forceinline__ bool operator()(gg::Acc& acc, const gg::Unit& u, int wr, int wc, int fr, int fq, int wid, int lane) const {
        gg::store_bf16_tile(acc, o, ldc, u.pm * 256, u.pn * 256, wr, wc, fr, fq); return true;
    }
};

__device__ __forceinline__ int f2ord(float f) { const int b = __float_as_int(f); return b ^ ((b >> 31) & 0x7fffffff); }
__device__ __forceinline__ float ord2f(int o) { return __int_as_float(o ^ ((o >> 31) & 0x7fffffff)); }
__device__ __forceinline__ void cex_desc(int& hi, int& lo) { const int a = hi, b = lo; hi = a > b ? a : b; lo = a > b ? b : a; }
__device__ __forceinline__ void bsort16_desc(int (&a)[16]) {
#pragma unroll
    for (int k = 2; k <= 16; k <<= 1)
#pragma unroll
        for (int j = k >> 1; j > 0; j >>= 1)
#pragma unroll
            for (int i = 0; i < 16; ++i) { const int l = i ^ j; if (l > i) { if ((i & k) == 0) cex_desc(a[i], a[l]); else cex_desc(a[l], a[i]); } }
}
__device__ __forceinline__ void bmerge16_desc(int (&a)[16]) {
#pragma unroll
    for (int j = 8; j > 0; j >>= 1)
#pragma unroll
        for (int i = 0; i < 16; ++i) { const int l = i ^ j; if (l > i) cex_desc(a[i], a[l]); }
}
__device__ __forceinline__ void top16_merge(int (&a)[16], const int (&b)[16]) {
#pragma unroll
    for (int i = 0; i < 16; ++i) a[i] = a[i] > b[15 - i] ? a[i] : b[15 - i];
    bmerge16_desc(a);
}
constexpr int RT_SKROW = 272;
constexpr int RT_SK = 2 * 128 * RT_SKROW;
__device__ __forceinline__ void route_topk16(const f32x4 (&acc)[8], int fq, int (&res)[16]) {
    int a[16], b[16];
#pragma unroll
    for (int mb = 0; mb < 4; ++mb)
#pragma unroll
        for (int j = 0; j < 4; ++j) { a[mb * 4 + j] = (f2ord(acc[mb][j]) & ~127) | (127 - (16 * mb + 4 * fq + j)); b[mb * 4 + j] = (f2ord(acc[mb + 4][j]) & ~127) | (127 - (16 * (mb + 4) + 4 * fq + j)); }
    bsort16_desc(a); bsort16_desc(b); top16_merge(a, b);
#pragma unroll
    for (int x = 16; x <= 32; x <<= 1) {
#pragma unroll
        for (int i = 0; i < 16; ++i) b[i] = __shfl_xor(a[i], x);
        top16_merge(a, b);
    }
#pragma unroll
    for (int i = 0; i < 16; ++i) res[i] = a[i];
}
__device__ __forceinline__ void route_job(Frame& F, const Args& a, int job) {
    unsigned char* ws = F.ws;
    const int tid = F.tid, lane = F.lane, wid = F.wave, fr = lane & 15, fq = lane >> 4;
    const int h = job & 7, chunk = job >> 3;
    const bf16_t* pq = (const bf16_t*)(ws + WS_PQ); const bf16_t* sk = (const bf16_t*)(ws + WS_SUBK) + (size_t)h * 2 * 128 * 128;
    for (int p = tid; p < 4096; p += 512) { const int row = p >> 4, pc = p & 15; *(LAS u32x4*)(F.lds + row * RT_SKROW + pc * 16) = ((const u32x4*)sk)[p]; }
    __syncthreads();
    LAS int* IX = (LAS int*)(F.lds + RT_SK) + wid * 512;
#pragma unroll 1
    for (int it = 0; it < 4; ++it) {
        const int tok0 = (chunk * 32 + wid * 4 + it) * 16;
        int top[2][16];
#pragma unroll
        for (int c = 0; c < 2; ++c) {
            f32x4 acc[8];
#pragma unroll
            for (int mb = 0; mb < 8; ++mb) acc[mb] = (f32x4){0.f, 0.f, 0.f, 0.f};
            bf16x8 bfr[4];
#pragma unroll
            for (int kk = 0; kk < 4; ++kk) bfr[kk] = *(const bf16x8*)(pq + (size_t)(tok0 + fr) * 2048 + h * 256 + c * 128 + 32 * kk + 8 * fq);
#pragma unroll
            for (int kk = 0; kk < 4; ++kk)
#pragma unroll
                for (int mb = 0; mb < 8; ++mb) { const bf16x8 af = *(const LAS bf16x8*)(F.lds + (c * 128 + 16 * mb + fr) * RT_SKROW + (32 * kk + 8 * fq) * 2);
                    acc[mb] = __builtin_amdgcn_mfma_f32_16x16x32_bf16(af, bfr[kk], acc[mb], 0, 0, 0); }
            route_topk16(acc, fq, top[c]);
        }
        float f0[16], f1[16];
#pragma unroll
        for (int i = 0; i < 16; ++i) { f0[i] = ord2f(top[0][i] & ~127); f1[i] = ord2f(top[1][i] & ~127); }
        int g[4][16];
#pragma unroll
        for (int q = 0; q < 4; ++q)
#pragma unroll
            for (int i = 0; i < 16; ++i) g[q][i] = (int)0x80000000;
        {
            int nc = 0;
#pragma unroll
            for (int i = 0; i < 16; ++i)
#pragma unroll
                for (int j = 0; j < 16; ++j) if ((i + 1) * (j + 1) <= 16) { g[nc >> 4][nc & 15] = (f2ord(f0[i] + f1[j]) & ~255) | (255 - (i * 16 + j)); ++nc; }
        }
        bsort16_desc(g[0]); bsort16_desc(g[1]); bsort16_desc(g[2]); bsort16_desc(g[3]);
        top16_merge(g[0], g[1]); top16_merge(g[2], g[3]); top16_merge(g[0], g[2]);
        if (fq == 0) {
#pragma unroll
            for (int i = 0; i < 16; ++i) { IX[fr * 32 + i] = 127 - (top[0][i] & 127); IX[fr * 32 + 16 + i] = 127 - (top[1][i] & 127); }
        }
        LDS_WAIT(); asm volatile("" ::: "memory");
        if (fq == 0) {
            const float vmax = ord2f(g[0][0] & ~255); float e[16]; float s = 0.f; int ex[16];
#pragma unroll
            for (int r = 0; r < 16; ++r) { e[r] = __expf(ord2f(g[0][r] & ~255) - vmax); s += e[r]; const int ij = 255 - (g[0][r] & 255); ex[r] = IX[fr * 32 + (ij >> 4)] * 128 + IX[fr * 32 + 16 + (ij & 15)]; }
            const float inv = 1.0f / s;
            int* eidx = (int*)(ws + WS_EIDX) + (size_t)(tok0 + fr) * 128 + h * 16; float* gw = (float*)(ws + WS_GW) + (size_t)(tok0 + fr) * 128 + h * 16;
#pragma unroll
            for (int q = 0; q < 4; ++q) { *(u32x4*)(eidx + 4 * q) = (u32x4){(unsigned)ex[4 * q], (unsigned)ex[4 * q + 1], (unsigned)ex[4 * q + 2], (unsigned)ex[4 * q + 3]};
                *(f32x4*)(gw + 4 * q) = (f32x4){e[4 * q] * inv, e[4 * q + 1] * inv, e[4 * q + 2] * inv, e[4 * q + 3] * inv}; }
        }
        LDS_WAIT(); asm volatile("" ::: "memory");
    }
    __syncthreads();
}

__device__ __forceinline__ float ub0(unsigned w) { return (float)(w & 255u); }
__device__ __forceinline__ float ub1(unsigned w) { return (float)((w >> 8) & 255u); }
__device__ __forceinline__ float ub2(unsigned w) { return (float)((w >> 16) & 255u); }
__device__ __forceinline__ float ub3(unsigned w) { return (float)(w >> 24); }
#define P10_LOADU(buf, kbase) do { _Pragma("unroll") for (int r = 0; r < 4; ++r) { const int k_ = (kbase) + r; const int e_ = __builtin_amdgcn_readlane(k_ < 64 ? ev0 : ev1, k_ & 63); \
        const u32x4* rp_ = (const u32x4*)(ub + (size_t)e_ * 2048); buf[r][0] = rp_[lane]; buf[r][1] = rp_[64 + lane]; } } while (0)
#define P10_COMPU(buf, kbase) do { _Pragma("unroll") for (int r = 0; r < 4; ++r) { int s_ = 0; \
        _Pragma("unroll") for (int p = 0; p < 2; ++p) { const unsigned x0 = buf[r][p].x, x1 = buf[r][p].y, x2 = buf[r][p].z, x3 = buf[r][p].w; \
            s_ = __builtin_amdgcn_sdot4((int)(x0 & 0x0F0F0F0Fu), (int)hv[p][0].x, s_, false); s_ = __builtin_amdgcn_sdot4((int)((x0 >> 4) & 0x0F0F0F0Fu), (int)hv[p][0].y, s_, false); \
            s_ = __builtin_amdgcn_sdot4((int)(x1 & 0x0F0F0F0Fu), (int)hv[p][0].z, s_, false); s_ = __builtin_amdgcn_sdot4((int)((x1 >> 4) & 0x0F0F0F0Fu), (int)hv[p][0].w, s_, false); \
            s_ = __builtin_amdgcn_sdot4((int)(x2 & 0x0F0F0F0Fu), (int)hv[p][1].x, s_, false); s_ = __builtin_amdgcn_sdot4((int)((x2 >> 4) & 0x0F0F0F0Fu), (int)hv[p][1].y, s_, false); \
            s_ = __builtin_amdgcn_sdot4((int)(x3 & 0x0F0F0F0Fu), (int)hv[p][1].z, s_, false); s_ = __builtin_amdgcn_sdot4((int)((x3 >> 4) & 0x0F0F0F0Fu), (int)hv[p][1].w, s_, false); } \
        _Pragma("unroll") for (int o_ = 1; o_ < 64; o_ <<= 1) s_ += __shfl_xor(s_, o_); \
        const int k_ = (kbase) + r; const float av_ = (float)s_; if (k_ < 64) { if (lane == k_) a0 = av_; } else { if (lane == k_ - 64) a1 = av_; } } } while (0)
#define P10_LOADV(buf, kbase) do { _Pragma("unroll") for (int r = 0; r < 4; ++r) { const int k_ = (kbase) + r; const int e_ = __builtin_amdgcn_readlane(k_ < 64 ? ev0 : ev1, k_ & 63); \
        const u32x4* rp_ = (const u32x4*)(vb + (size_t)e_ * 2048); buf[r][0] = rp_[lane]; buf[r][1] = rp_[64 + lane]; } } while (0)
#define P10_COMPV(buf, grp) do { const int wq_ = __builtin_amdgcn_readlane(wqv, (grp)); \
        _Pragma("unroll") for (int p = 0; p < 2; ++p) { const unsigned xr_[4][4] = {{buf[0][p].x, buf[0][p].y, buf[0][p].z, buf[0][p].w}, {buf[1][p].x, buf[1][p].y, buf[1][p].z, buf[1][p].w}, {buf[2][p].x, buf[2][p].y, buf[2][p].z, buf[2][p].w}, {buf[3][p].x, buf[3][p].y, buf[3][p].z, buf[3][p].w}}; \
            _Pragma("unroll") for (int d = 0; d < 4; ++d) { int* oo = o + 32 * p + 8 * d; \
                _Pragma("unroll") for (int h = 0; h < 2; ++h) { \
                    const unsigned b0 = (xr_[0][d] >> (4 * h)) & 0x0F0F0F0Fu, b1 = (xr_[1][d] >> (4 * h)) & 0x0F0F0F0Fu, b2 = (xr_[2][d] >> (4 * h)) & 0x0F0F0F0Fu, b3 = (xr_[3][d] >> (4 * h)) & 0x0F0F0F0Fu; \
                    const unsigned a01 = __builtin_amdgcn_perm(b1, b0, 0x05010400u), c01 = __builtin_amdgcn_perm(b1, b0, 0x07030602u), a23 = __builtin_amdgcn_perm(b3, b2, 0x05010400u), c23 = __builtin_amdgcn_perm(b3, b2, 0x07030602u); \
                    const unsigned t0 = __builtin_amdgcn_perm(a23, a01, 0x05040100u), t1 = __builtin_amdgcn_perm(a23, a01, 0x07060302u), t2 = __builtin_amdgcn_perm(c23, c01, 0x05040100u), t3 = __builtin_amdgcn_perm(c23, c01, 0x07060302u); \
                    oo[0 + h] = __builtin_amdgcn_sdot4((int)t0, wq_, oo[0 + h], false); oo[2 + h] = __builtin_amdgcn_sdot4((int)t1, wq_, oo[2 + h], false); \
                    oo[4 + h] = __builtin_amdgcn_sdot4((int)t2, wq_, oo[4 + h], false); oo[6 + h] = __builtin_amdgcn_sdot4((int)t3, wq_, oo[6 + h], false); } } } } while (0)
__device__ __forceinline__ void peer_token_wave(const Args& a, unsigned char* ws, int tok, int lane) {
    const int* eidx = (const int*)(ws + WS_EIDX) + (size_t)tok * 128; const float* gw = (const float*)(ws + WS_GW) + (size_t)tok * 128;
    const int ev0 = eidx[lane], ev1 = eidx[64 + lane];
    u32x4 hv[2][2];
    const u32x4* hrow = (const u32x4*)(ws + WS_H8 + (size_t)tok * D);
#pragma unroll
    for (int p = 0; p < 2; ++p) { hv[p][0] = hrow[128 * p + 2 * lane]; hv[p][1] = hrow[128 * p + 2 * lane + 1]; }
    const float sh = ((const float*)(ws + WS_SH))[tok], shs = ((const float*)(ws + WS_SHS))[tok];
    const unsigned char* ub = ws + WS_UB; const float* su = (const float*)(ws + WS_SU); const float* sv = (const float*)(ws + WS_SV);
    float a0 = 0.f, a1 = 0.f;
    {
        u32x4 ua[4][2], uc[4][2];
        P10_LOADU(ua, 0);
#pragma unroll 1
        for (int kb = 0; kb < 128; kb += 8) {
            P10_LOADU(uc, kb + 4);
            P10_COMPU(ua, kb);
            P10_LOADU(ua, (kb + 8) & 127);
            P10_COMPU(uc, kb + 4);
        }
    }
    float w0, w1;
    { const float x0 = (a0 - 8.0f * shs) * su[ev0] * sh, x1 = (a1 - 8.0f * shs) * su[ev1] * sh;
      w0 = gw[lane] * 0.5f * x0 * (1.0f + erff(x0 * 0.70710678118f)) * sv[ev0]; w1 = gw[64 + lane] * 0.5f * x1 * (1.0f + erff(x1 * 0.70710678118f)) * sv[ev1]; }
    const float wmax = fmaxf(wave_max(fmaxf(fabsf(w0), fabsf(w1))), 1e-30f), sw = wmax * (1.0f / 127.0f), winv = 127.0f / wmax;
    const int q0 = (int)rintf(w0 * winv), q1 = (int)rintf(w1 * winv);
    int qsum = q0 + q1;
#pragma unroll
    for (int o_ = 1; o_ < 64; o_ <<= 1) qsum += __shfl_xor(qsum, o_);
    int wqv;
    { const int base = (lane & 15) * 4;
      const int s0 = __shfl(lane < 16 ? q0 : q1, base + 0), s1 = __shfl(lane < 16 ? q0 : q1, base + 1), s2 = __shfl(lane < 16 ? q0 : q1, base + 2), s3 = __shfl(lane < 16 ? q0 : q1, base + 3);
      const int a0_ = __shfl(q0, base + 0), a1_ = __shfl(q0, base + 1), a2_ = __shfl(q0, base + 2), a3_ = __shfl(q0, base + 3);
      const int b0_ = __shfl(q1, base + 0), b1_ = __shfl(q1, base + 1), b2_ = __shfl(q1, base + 2), b3_ = __shfl(q1, base + 3);
      (void)s0; (void)s1; (void)s2; (void)s3;
      const bool lowhalf = (lane & 31) < 16;
      const int c0 = lowhalf ? a0_ : b0_, c1 = lowhalf ? a1_ : b1_, c2 = lowhalf ? a2_ : b2_, c3 = lowhalf ? a3_ : b3_;
      wqv = (c0 & 255) | ((c1 & 255) << 8) | ((c2 & 255) << 16) | ((c3 & 255) << 24); }
    int o[64];
#pragma unroll
    for (int j = 0; j < 64; ++j) o[j] = 0;
    const unsigned char* vb = ws + WS_VB;
    {
        u32x4 va[4][2], vc[4][2];
        P10_LOADV(va, 0);
#pragma unroll 1
        for (int kb = 0; kb < 128; kb += 8) {
            P10_LOADV(vc, kb + 4);
            P10_COMPV(va, kb >> 2);
            P10_LOADV(va, (kb + 8) & 127);
            P10_COMPV(vc, (kb >> 2) + 1);
        }
    }
    float* orow = a.out + (size_t)tok * D; float s = 0.f; const int corr = 8 * qsum; float y[64];
#pragma unroll
    for (int p = 0; p < 2; ++p)
#pragma unroll
        for (int q = 0; q < 8; ++q) { const f32x4 x = *(const f32x4*)(orow + 2048 * p + 32 * lane + 4 * q); const int* oo = o + 32 * p + 4 * q; float* yy = y + 32 * p + 4 * q;
            yy[0] = x.x + sw * (float)(oo[0] - corr); yy[1] = x.y + sw * (float)(oo[1] - corr); yy[2] = x.z + sw * (float)(oo[2] - corr); yy[3] = x.w + sw * (float)(oo[3] - corr);
            s += (yy[0] * yy[0] + yy[1] * yy[1]) + (yy[2] * yy[2] + yy[3] * yy[3]); }
    const float rstd = rsqrtf(wave_sum(s) * (1.f / D) + EPS);
#pragma unroll
    for (int p = 0; p < 2; ++p)
#pragma unroll
        for (int q = 0; q < 8; ++q) { const f32x4 g = *(const f32x4*)(a.in[20] + 2048 * p + 32 * lane + 4 * q); const float* yy = y + 32 * p + 4 * q;
            *(f32x4*)(orow + 2048 * p + 32 * lane + 4 * q) = (f32x4){yy[0] * rstd * g.x, yy[1] * rstd * g.y, yy[2] * rstd * g.z, yy[3] * rstd * g.w}; }
}

__global__ void __launch_bounds__(512, 2) mega_fwd(Args args) {
    extern __shared__ __attribute__((aligned(16))) unsigned char lds_raw[];
    Frame F;
    F.lds = (LAS unsigned char*)lds_raw;
    F.tid = threadIdx.x; F.lane = F.tid & 63; F.wave = __builtin_amdgcn_readfirstlane(F.tid >> 6);
    F.G = gridDim.x; F.bid = blockIdx.x; F.ws = args.ws;
    unsigned char* ws = args.ws;
    if (F.tid < 64) ((LAS unsigned*)(F.lds + LDS_MISC))[F.tid] = 0u;
    __syncthreads();
    XcdBarrier bar = xcd_barrier_post((unsigned*)(ws + WS_CTL) + 4096, (volatile LAS unsigned*)(F.lds + LDS_MISC + 32));

    F.refresh();
    p0_weights8(F, args);
    F.refresh();
    p0_prologue_a(F, args);
    xcd_barrier(bar);
    {
        P1Sched S{(const char*)(ws + WS_HN), (const char*)(ws + WS_W8), (const char*)(ws + WS_WAL), (const char*)(ws + WS_MEMN), (const char*)(ws + WS_WKV), F.G, F.bid};
        P1Epi E{ws, args.in[12]};
        gg::gemm_phase<0>(F.lds, D * 2, D * 2, 64, S, E);
        I8Sched S8{(const char*)(ws + WS_HN8), (const char*)(ws + WS_W8), F.G, F.bid};
        I8Epi E8{ws, args.in[12]};
        gg::gemm_phase<2, true>(F.lds, D, D, 32, S8, E8);
        xcd_barrier(bar);
    }
    F.refresh();
    for (int u = F.bid; u < 512; u += F.G) gla_prep_unit(F, args, u);
    {
        WkSched Sk{(const char*)(ws + WS_KVM), (const char*)(ws + WS_WQX), F.G, F.bid};
        WkEpi Ek{(bf16_t*)(ws + WS_WKT)};
        gg::gemm_phase<0>(F.lds, 8192, 4096, 8, Sk, Ek);
        VwSched Sv{(const char*)(ws + WS_WBR + 32 * MiB), (const char*)(ws + WS_KVM), F.G, F.bid};
        VwEpi Ev{(bf16_t*)(ws + WS_VWT)};
        gg::gemm_phase<0>(F.lds, 4096, 8192, 8, Sv, Ev);
    }
    xcd_barrier(bar);
    F.refresh();
    {
        {
            XsSched S{(const char*)(ws + WS_HN), (const char*)(ws + WS_WKT), F.G, F.bid};
            XsEpi E{(bf16_t*)(ws + WS_PROB), F.lds + LDS_EX};
            gg::gemm_phase<0>(F.lds, D * 2, D * 2, 64, S, E);
        }
        const int nscan = F.G >= 128 ? 64 : 0;
        if (nscan) { if (F.bid < 64) gla_scan_unit(F, args, F.bid); }
        else for (int u = F.bid; u < 64; u += F.G) gla_scan_unit(F, args, u);
        { const int nq = nscan ? F.G - 64 : F.G, cq = nscan ? F.bid - 64 : F.bid;
          if (cq >= 0) for (int e = cq * 8 + F.wave; e < 16384; e += nq * 8) {
              quant_row_i4(args.in[18] + (size_t)e * D, ws + WS_UB + (size_t)e * 2048, (float*)(ws + WS_SU) + e, F.lane);
              quant_row_i4(args.in[19] + (size_t)e * D, ws + WS_VB + (size_t)e * 2048, (float*)(ws + WS_SV) + e, F.lane); }
          if (cq >= 0) conv_phase(F, args, cq, nq); }
    }
    xcd_barrier(bar);
    F.refresh();
    gla_post_phase(F, args);
    F.refresh();
    peer_wq_convert(F, args);
    xcd_barrier(bar);
    {
        MgSched S{(const char*)(ws + WS_RG), (const char*)(ws + WS_CB), (const char*)(ws + WS_PROB), (const char*)(ws + WS_WBR), (const char*)(ws + WS_VWT), F.G, F.bid};
        MgEpi E{(const bf16_t*)(ws + WS_GT), (bf16_t*)(ws + WS_MERGED)};
        gg::gemm_phase<0, true>(F.lds, 4096, 4096, 32, S, E);
    }
    xcd_barrier(bar);
    {
        GridSched S{(const char*)(ws + WS_MERGED), (const char*)(ws + WS_WO), 64, 16, D * 2, D * 2, F.G, F.bid};
        ResEpi E{args.in[0], args.out};
        gg::gemm_phase<0, true>(F.lds, D * 2, D * 2, 64, S, E);
    }
    xcd_barrier(bar);
    F.refresh();
    {
        const int gw = F.bid * 8 + F.wave, NGW = F.G * 8;
        for (int m = gw; m < T; m += NGW) rms_row_i8(args.out + (size_t)m * D, args.in[15], ws + WS_H8 + (size_t)m * D, (float*)(ws + WS_SH) + m, (float*)(ws + WS_SHS) + m, F.lane);
    }
    xcd_barrier(bar);
    {
        GridSched S{(const char*)(ws + WS_H8), (const char*)(ws + WS_WPQ), 64, 8, D, D, F.G, F.bid};
        PqEpi E{(bf16_t*)(ws + WS_PQ), (const float*)(ws + WS_SH), (const float*)(ws + WS_SWPQ)};
        gg::gemm_phase<2, true>(F.lds, D, D, 32, S, E);
    }
    xcd_barrier(bar);
    F.refresh();
    for (int u = F.bid; u < 256; u += F.G) route_job(F, args, u);
    xcd_barrier(bar);
    F.refresh();
    for (int tok = F.bid * 8 + F.wave; tok < T; tok += F.G * 8) peer_token_wave(args, ws, tok, F.lane);
}


extern "C" void kernel_launch(void* const* d_in, const int* in_sizes, int n_in, void* d_out, int out_size, void* d_ws, size_t ws_size, hipStream_t stream) {
    static int grid = 0;
    if (grid == 0) {
        if (n_in != 21 || ws_size < WS_END) { fprintf(stderr, "kernel_launch: unexpected inputs (n_in %d, ws %zu < %zu)\n", n_in, ws_size, (size_t)WS_END); grid = -1; return; }
        int dev = 0, cus = 0, per_cu = 0;
        if (hipGetDevice(&dev) != hipSuccess || hipDeviceGetAttribute(&cus, hipDeviceAttributeMultiprocessorCount, dev) != hipSuccess) { grid = -1; return; }
        if (hipFuncSetAttribute((const void*)mega_fwd, hipFuncAttributeMaxDynamicSharedMemorySize, LDS_BYTES) != hipSuccess) { fprintf(stderr, "kernel_launch: hipFuncSetAttribute failed\n"); grid = -1; return; }
        if (hipOccupancyMaxActiveBlocksPerMultiprocessor(&per_cu, (const void*)mega_fwd, 512, LDS_BYTES) != hipSuccess || per_cu < 1)
            fprintf(stderr, "kernel_launch: occupancy query says %d\n", per_cu);
        (void)hipGetLastError();
        grid = cus;
    }
    if (grid < 0) return;
    Args a{};
    for (int i = 0; i < 21; ++i) a.in[i] = (const float*)d_in[i];
    a.out = (float*)d_out; a.ws = (unsigned char*)d_ws;
    hipMemsetAsync((char*)d_ws + WS_CTL, 0, CTL_BYTES, stream);
    hipLaunchKernelGGL(mega_fwd, dim3(grid), dim3(512), LDS_BYTES, stream, a);
}
```

```cpp
#include <hip/hip_runtime.h>
#include <cstdio>
#include <cstdint>

#define LAS __attribute__((address_space(3)))
typedef unsigned short bf16_t;
typedef short bf16x8 __attribute__((ext_vector_type(8)));
typedef float f32x4 __attribute__((ext_vector_type(4)));
typedef float f32x2 __attribute__((ext_vector_type(2)));
typedef unsigned u32x4 __attribute__((ext_vector_type(4)));
typedef unsigned u32x2 __attribute__((ext_vector_type(2)));
typedef __bf16 bf16x2v __attribute__((ext_vector_type(2)));
typedef int i32x8 __attribute__((ext_vector_type(8)));
typedef int i32x4 __attribute__((ext_vector_type(4)));
typedef unsigned u32x8 __attribute__((ext_vector_type(8)));

constexpr int T = 16384, D = 4096, SEQ = 4096, NBATCH = 4, MEMT = 1024;
constexpr int NPAD = 26880;
constexpr int O_QG = 0, O_KG = 1024, O_VG = 2048, O_RG = 4096, O_CB = 6144, O_CC = 8192, O_CH = 10240, O_QX = 12288, O_GT = 14336, O_AL = 26624;
constexpr float EPS = 1e-6f;
constexpr int GLA_BLK = 74752;

#ifndef I8_MASK
#define I8_MASK 0x7f
#endif
constexpr int SEG_START[9] = {0, 2048, 4096, 6144, 8192, 10240, 12288, 14336, 26624};
constexpr int SEG_BIT[8] = {0, 1, 2, 3, 4, 5, -1, 6};
constexpr bool seg_i8(int s) { return SEG_BIT[s] >= 0 && ((I8_MASK >> SEG_BIT[s]) & 1); }
constexpr size_t seg_pitch(int s) { return SEG_BIT[s] < 0 ? 0 : (seg_i8(s) ? 4096 : 8192); }
constexpr size_t seg_off(int s) { size_t o = 0; for (int t = 0; t < s; ++t) o += (size_t)(SEG_START[t + 1] - SEG_START[t]) * seg_pitch(t); return o; }
constexpr bool V_I8 = seg_i8(1);
constexpr int count_tiles(bool want8) { int n = 0; for (int s = 0; s < 8; ++s) if (s != 1 && SEG_BIT[s] >= 0 && seg_i8(s) == want8) n += (SEG_START[s + 1] - SEG_START[s]) / 256; return n; }
constexpr int NT8 = count_tiles(true), NTB = count_tiles(false);
constexpr int NU_B = 64 * NTB + 64 + (V_I8 ? 0 : 512) + 64, NU_8 = 64 * NT8 + (V_I8 ? 512 : 0);
__device__ __forceinline__ size_t w_row_off(int n) {
    size_t o = 0;
#pragma unroll
    for (int s = 0; s < 8; ++s) if (n >= SEG_START[s] && n < SEG_START[s + 1]) o = seg_off(s) + (size_t)(n - SEG_START[s]) * seg_pitch(s);
    return o;
}
__device__ __forceinline__ bool w_row_is8(int n) {
    bool r = false;
#pragma unroll
    for (int s = 0; s < 8; ++s) if (n >= SEG_START[s] && n < SEG_START[s + 1]) r = seg_i8(s);
    return r;
}
__device__ __forceinline__ int map_tile(int idx, bool want8) {
    int t = 104;
#pragma unroll
    for (int s = 7; s >= 0; --s) { }
    int rem = idx; bool found = false;
#pragma unroll
    for (int s = 0; s < 8; ++s) { if (s == 1 || SEG_BIT[s] < 0 || seg_i8(s) != want8) continue; const int len = (SEG_START[s + 1] - SEG_START[s]) / 256;
        if (!found && rem < len) { t = SEG_START[s] / 256 + rem; found = true; } rem -= len; }
    return t;
}
constexpr size_t MiB = 1u << 20;
constexpr size_t WS_CTL = 0, CTL_BYTES = 1 * MiB;
constexpr size_t WS_MEMN = 1 * MiB, WS_KVM = 9 * MiB  , WS_ALR = 17 * MiB, WS_SUBK = 18 * MiB, WS_EIDX = 19 * MiB, WS_GW = 27 * MiB;
constexpr size_t WS_WBR = 64 * MiB  , WS_WO = 112 * MiB, WS_WPQ = 144 * MiB, WS_WKV = 160 * MiB;
constexpr size_t WS_UB = 192 * MiB, WS_VB = 224 * MiB;
constexpr size_t WS_HN8 = 320 * MiB;
constexpr size_t WS_W8 = 448 * MiB;
constexpr size_t WS_WAL = 56 * MiB;
constexpr size_t WS_SHN = 35 * MiB + 512 * 1024, WS_SW = 35 * MiB + 768 * 1024;
constexpr size_t WS_SWPQ = 35 * MiB + 896 * 1024;
constexpr size_t CTL_CMAXPQ = 384 * 1024;
constexpr size_t CTL_CMAX = 256 * 1024;
constexpr size_t WS_SU = 35 * MiB, WS_SV = WS_SU + 65536, WS_SH = WS_SV + 65536, WS_SHS = WS_SH + 65536;
constexpr size_t WS_H8 = 914 * MiB;
constexpr size_t WS_WTIN = 448 * MiB;
constexpr size_t WS_GLAB = 448 * MiB, WS_PROB = 521 * MiB  , WS_OG = 585 * MiB;
constexpr size_t WS_WQX = 40 * MiB;
constexpr size_t WS_WKT = 384 * MiB;
constexpr size_t WS_VWT = 320 * MiB;
constexpr size_t WS_HN = 658 * MiB;
constexpr size_t WS_MERGED = 658 * MiB;
constexpr size_t WS_X1B = 1042 * MiB;
constexpr size_t WS_QG = 786 * MiB, WS_KG = 818 * MiB, WS_VT = 850 * MiB, WS_RG = 914 * MiB, WS_CB = 978 * MiB, WS_CC = 1042 * MiB, WS_CH = 1106 * MiB, WS_QX = 1170 * MiB;
constexpr size_t WS_GT = 1234 * MiB;
constexpr size_t WS_HQ = 1234 * MiB, WS_PQ = 1362 * MiB;
constexpr size_t WS_END = 1618 * MiB;
static_assert(WS_GLAB + (size_t)16 * 64 * GLA_BLK <= WS_PROB, "gla blocks");

constexpr int LDS_BYTES = 163840;
constexpr int LDS_EX = 131072;
constexpr int LDS_MISC = LDS_BYTES - 256;

__device__ __forceinline__ float bf2f(unsigned b) { return __uint_as_float(b << 16); }
__device__ __forceinline__ float bflo(unsigned w) { return __uint_as_float(w << 16); }
__device__ __forceinline__ float bfhi(unsigned w) { return __uint_as_float(w & 0xffff0000u); }
__device__ __forceinline__ unsigned f2bf(float f) { unsigned u = __float_as_uint(f); return (u + 0x7fffu + ((u >> 16) & 1u)) >> 16; }
__device__ __forceinline__ unsigned pk2(float lo, float hi) { const f32x2 v = {lo, hi}; const bf16x2v b = __builtin_convertvector(v, bf16x2v); return __builtin_bit_cast(unsigned, b); }
__device__ __forceinline__ float dot2bf(unsigned a, unsigned b, float c) { return __builtin_amdgcn_fdot2_f32_bf16(__builtin_bit_cast(bf16x2v, a), __builtin_bit_cast(bf16x2v, b), c, false); }
__device__ __forceinline__ float wave_sum(float v) {
#pragma unroll
    for (int o = 1; o < 64; o <<= 1) v += __shfl_xor(v, o);
    return v;
}
__device__ __forceinline__ float wave_max(float v) {
#pragma unroll
    for (int o = 1; o < 64; o <<= 1) v = fmaxf(v, __shfl_xor(v, o));
    return v;
}
__device__ __forceinline__ float fast_sigmoid(float x) { return __builtin_amdgcn_rcpf(1.0f + __expf(-x)); }
__device__ __forceinline__ float inv_sigmoid(float x) { return 1.0f + __expf(fminf(-x, 69.0f)); }
#define LDS_WAIT() asm volatile("s_waitcnt lgkmcnt(0)" ::: "memory")
#define VM_WAIT() asm volatile("s_waitcnt vmcnt(0)" ::: "memory")

#define XB_TMO      128
#define XB_XCNT(j)  (256  + 64 * (j))
#define XB_XSUB(j)  (1280 + 64 * (j))
#define XB_XGEN(j)  (2304 + 64 * (j))
#define XB_TOP      3328
#define XB_TOPGEN   3392
#define XCD_BAR_WORDS 3456
#define XB_SPIN_CAP (1u << 24)
__device__ __forceinline__ unsigned xb_ld(unsigned* p)              { return __hip_atomic_load(p, __ATOMIC_RELAXED, __HIP_MEMORY_SCOPE_AGENT); }
__device__ __forceinline__ unsigned xb_add(unsigned* p, unsigned v) { return __hip_atomic_fetch_add(p, v, __ATOMIC_RELAXED, __HIP_MEMORY_SCOPE_AGENT); }
__device__ __forceinline__ unsigned xb_xcc_id() { return (unsigned)__builtin_amdgcn_s_getreg((3 << 11) | 20) & 0xFu; }
#define XB_SPIN(cond, bar) do { unsigned _sp = 0; while (cond) { __builtin_amdgcn_s_sleep(1); \
    if ((++_sp & 255u) == 0u) { if (xb_ld(&(bar)[XB_TMO])) break; if (_sp > XB_SPIN_CAP) { atomicAdd(&(bar)[XB_TMO], 1u); break; } } } } while (0)
struct XcdBarrier { unsigned* bar; unsigned x; volatile LAS unsigned* st; };
__device__ __forceinline__ XcdBarrier xcd_barrier_post(unsigned* bar, volatile LAS unsigned* st) {
    XcdBarrier b; b.bar = bar; b.x = xb_xcc_id(); b.st = st;
    if (threadIdx.x == 0) (void)xb_add(&bar[XB_XCNT(b.x)], 1u);
    return b;
}
__device__ __forceinline__ void xcd_barrier_complete(unsigned* bar, unsigned x, unsigned& nloc, unsigned& nx) {
    const unsigned G = gridDim.x * gridDim.y * gridDim.z;
    unsigned sum, cnt, mine, sp = 0u;
    for (;;) {
        sum = 0u; cnt = 0u; mine = 0u;
#pragma unroll
        for (unsigned j = 0; j < 16; ++j) { const unsigned c = xb_ld(&bar[XB_XCNT(j)]); sum += c; cnt += (c > 0u) ? 1u : 0u; mine = (j == x) ? c : mine; }
        if (sum == G) break;
        __builtin_amdgcn_s_sleep(1);
        if ((++sp & 255u) == 0u) { if (xb_ld(&bar[XB_TMO])) break; if (sp > XB_SPIN_CAP) { atomicAdd(&bar[XB_TMO], 1u); break; } }
    }
    nloc = mine > 0u ? mine : 1u; nx = cnt > 0u ? cnt : 1u;
}
__device__ __forceinline__ void xcd_barrier(const XcdBarrier& b) {
    asm volatile("s_waitcnt vmcnt(0)" ::: "memory");
    __syncthreads();
    if (threadIdx.x == 0) {
        unsigned* bar = b.bar;
        __builtin_amdgcn_s_waitcnt(0);
        unsigned nloc = b.st[0], nx = b.st[1];
        if (nloc == 0u) { xcd_barrier_complete(bar, b.x, nloc, nx); b.st[0] = nloc; b.st[1] = nx; }
        const unsigned old = xb_add(&bar[XB_XSUB(b.x)], 1u);
        const unsigned gen = old / nloc;
        if (old + 1u == (gen + 1u) * nloc) {
            __builtin_amdgcn_fence(__ATOMIC_RELEASE, "agent");
            asm volatile("s_waitcnt vmcnt(0)" ::: "memory");
            const unsigned og = xb_add(&bar[XB_TOP], 1u);
            const unsigned tg = og / nx;
            if (og + 1u == (tg + 1u) * nx) xb_add(&bar[XB_TOPGEN], 1u);
            else XB_SPIN(xb_ld(&bar[XB_TOPGEN]) == tg, bar);
            __builtin_amdgcn_fence(__ATOMIC_ACQUIRE, "agent");
            xb_add(&bar[XB_XGEN(b.x)], 1u);
            asm volatile("s_waitcnt vmcnt(0)" ::: "memory");
        } else {
            XB_SPIN(xb_ld(&bar[XB_XGEN(b.x)]) == gen, bar);
            __builtin_amdgcn_fence(__ATOMIC_ACQUIRE, "agent");
            asm volatile("s_waitcnt vmcnt(0)" ::: "memory");
        }
    }
    __syncthreads();
}

namespace gg {
constexpr int BM = 256, BK = 64, HALF = 128, HTB = HALF * BK * 2, STAGE_BYTES = 8 * HTB;
__device__ __forceinline__ int lds_byte(int r, int c) { const int st = (r >> 4) * 2 + (c >> 5), rr = r & 15, cc = c & 31, ob = rr * 64 + cc * 2; return st * 1024 + (ob ^ (((ob >> 9) & 1) << 5)); }
__device__ __forceinline__ void stage_rc(int b, int& R, int& C) { const int st = b / 1024, sb = b % 1024, swz = sb ^ (((sb >> 9) & 1) << 5); R = (st >> 1) * 16 + swz / 64; C = (st & 1) * 32 + (swz % 64) / 2; }
__device__ __forceinline__ int perm32(int rho) { const int n = rho >> 4, i = rho & 15; return 8 * (i >> 2) + 4 * n + (i & 3); }
struct Unit { const char* A; const char* B; int kind, pm, pn, aux; };
typedef f32x4 Acc[2][2][4][2];

template <int MODE, bool RX = false, class Epi, class Sched>
__device__ __forceinline__ void gemm_phase(LAS unsigned char* lds, const int ldaB, const int ldbB, const int nt, const Sched& S, const Epi& E) {
    int tid = threadIdx.x; asm volatile("" : "+v"(tid));
    const int wid = __builtin_amdgcn_readfirstlane(tid >> 6), lane = tid & 63, wr = wid >> 2, wc = wid & 3, fr = lane & 15, fq = lane >> 4;
    unsigned voffA[2], voffB[2];
#pragma unroll
    for (int i = 0; i < 2; ++i) { int R, C; stage_rc(tid * 16 + i * 8192, R, C); const int Rb = (R & ~31) + perm32(R & 31);
        voffA[i] = (unsigned)(R * ldaB + C * 2); voffB[i] = (unsigned)(Rb * ldbB + C * 2); }
    const size_t kstep = (size_t)(BK * 2);
    const size_t hstepA = (size_t)HALF * ldaB, hstepB = (size_t)HALF * ldbB;
    const unsigned ldsw = (unsigned)wid * 1024u;
    const int aoff = lds_byte(wr * 64 + fr, fq * 8), boff = lds_byte(wc * 32 + fr, fq * 8);
#define PG8_SA(b, h) (((b) * 2 + (h)) * HTB)
#define PG8_SB(b, h) ((4 + (b) * 2 + (h)) * HTB)
#define PG8_STAGE(bufoff, gbase, voff) do { _Pragma("unroll") for (int _i = 0; _i < 2; ++_i) \
        __builtin_amdgcn_global_load_lds((const unsigned*)((const char*)(gbase) + (voff)[_i]), (LAS unsigned*)(lds + (bufoff) + ldsw + _i * 8192), 16, 0, 0); } while (0)
#define PG8_LDA(dst, b, h) do { _Pragma("unroll") for (int m = 0; m < 4; ++m) { if constexpr (MODE == 1) { const u32x4 p0_ = *(const LAS u32x4*)(lds + PG8_SA(b, h) + aoff + m * 2048), p1_ = *(const LAS u32x4*)(lds + PG8_SA(b, h) + aoff + m * 2048 + 1024); \
        dst##8[m] = __builtin_shufflevector(p0_, p1_, 0, 1, 2, 3, 4, 5, 6, 7); } else { _Pragma("unroll") for (int k = 0; k < 2; ++k) dst[m][k] = *(const LAS bf16x8*)(lds + PG8_SA(b, h) + aoff + m * 2048 + k * 1024); } } } while (0)
#define PG8_LDB(dst, b, h) do { _Pragma("unroll") for (int n = 0; n < 2; ++n) { if constexpr (MODE == 1) { const u32x4 p0_ = *(const LAS u32x4*)(lds + PG8_SB(b, h) + boff + n * 2048), p1_ = *(const LAS u32x4*)(lds + PG8_SB(b, h) + boff + n * 2048 + 1024); \
        dst##8[n] = __builtin_shufflevector(p0_, p1_, 0, 1, 2, 3, 4, 5, 6, 7); } else { _Pragma("unroll") for (int k = 0; k < 2; ++k) dst[n][k] = *(const LAS bf16x8*)(lds + PG8_SB(b, h) + boff + n * 2048 + k * 1024); } } } while (0)
#define PG8_MMA(ai, bj, At, Bt) do { __builtin_amdgcn_s_setprio(1); _Pragma("unroll") for (int m = 0; m < 4; ++m) _Pragma("unroll") for (int n = 0; n < 2; ++n) { \
        if constexpr (MODE == 1) { asm volatile("v_mfma_scale_f32_16x16x128_f8f6f4 %0, %1, %2, %0, %3, %3 op_sel_hi:[0,0,0]" : "+v"(acc[ai][bj][m][n]) : "v"(Bt##8[n]), "v"(At##8[m]), "v"(sc127)); } \
        else if constexpr (MODE == 2) { _Pragma("unroll") for (int k = 0; k < 2; ++k) acc[ai][bj][m][n] = __builtin_bit_cast(f32x4, __builtin_amdgcn_mfma_i32_16x16x64_i8(__builtin_bit_cast(i32x4, Bt[n][k]), __builtin_bit_cast(i32x4, At[m][k]), __builtin_bit_cast(i32x4, acc[ai][bj][m][n]), 0, 0, 0)); } \
        else { _Pragma("unroll") for (int k = 0; k < 2; ++k) acc[ai][bj][m][n] = __builtin_amdgcn_mfma_f32_16x16x32_bf16(Bt[n][k], At[m][k], acc[ai][bj][m][n], 0, 0, 0); } } \
        __builtin_amdgcn_s_setprio(0); } while (0)
#define PG8_WAIT_V(n) asm volatile("s_waitcnt vmcnt(" #n ")" ::: "memory")
#define PG8_WAIT_V2(flag) asm volatile("s_cmp_lg_u32 %0, 0\n\ts_cbranch_scc1 1f\n\ts_waitcnt vmcnt(8)\n\ts_branch 2f\n1:\n\ts_waitcnt vmcnt(24)\n2:" :: "s"(flag) : "scc", "memory")
#define PG8_WAIT_L(n) asm volatile("s_waitcnt lgkmcnt(" #n ")" ::: "memory")
#define PG8_BAR __builtin_amdgcn_s_barrier()
#define PG8_SCHED __builtin_amdgcn_sched_barrier(0)
    Unit cur, nxt; int ui = 0;
    if (!S.next(0, cur)) return;
    Acc acc;
#pragma unroll
    for (int a = 0; a < 2; ++a)
#pragma unroll
        for (int b = 0; b < 2; ++b)
#pragma unroll
            for (int m = 0; m < 4; ++m)
#pragma unroll
                for (int n = 0; n < 2; ++n) acc[a][b][m][n] = (f32x4){0.f, 0.f, 0.f, 0.f};
    bf16x8 At[4][2], B0[2][2], B1[2][2]; u32x8 At8[4], B08[2], B18[2]; const int sc127 = 127;
    const char* cA = cur.A; const char* cB = cur.B;
    PG8_STAGE(PG8_SB(0, 0), cB, voffB); PG8_STAGE(PG8_SB(0, 1), cB + hstepB, voffB); PG8_STAGE(PG8_SA(0, 0), cA, voffA); PG8_STAGE(PG8_SA(0, 1), cA + hstepA, voffA);
    if (wr == 1) PG8_BAR;
    PG8_WAIT_V(2); PG8_BAR;
    PG8_STAGE(PG8_SB(1, 0), cB + kstep, voffB); PG8_STAGE(PG8_SA(1, 0), cA + kstep, voffA); PG8_STAGE(PG8_SB(1, 1), cB + hstepB + kstep, voffB);
    PG8_WAIT_V(6); PG8_BAR;
    bool relax = false;
    for (;;) {
        const bool has_next = S.next(ui + 1, nxt);
        const char* nA = has_next ? nxt.A : cA; const char* nB = has_next ? nxt.B : cB;
        const int unt = cur.aux ? cur.aux : nt;
#define PG8_PAIR(W0) { \
            const bool last = (t == unt - 2); const int rxf = __builtin_amdgcn_readfirstlane((relax && t == 0) ? 1 : 0); \
            const char* a1 = cA + (size_t)(t + 1) * kstep; \
            const char* a2 = last ? nA : cA + (size_t)(t + 2) * kstep; const char* b2 = last ? nB : cB + (size_t)(t + 2) * kstep; \
            const char* a3 = a2 + kstep; const char* b3 = b2 + kstep; \
              \
            PG8_LDB(B0, 0, 0); PG8_LDB(B1, 0, 1); PG8_SCHED; PG8_LDA(At, 0, 0); PG8_STAGE(PG8_SA(1, 1), a1 + hstepA, voffA); \
            if constexpr (RX) PG8_WAIT_V2(rxf); else PG8_WAIT_V(8); PG8_WAIT_L(0); PG8_BAR; PG8_MMA(0, 0, At, B0); PG8_MMA(0, 1, At, B1); PG8_BAR; PG8_SCHED; \
              \
            PG8_LDA(At, 0, 1); PG8_STAGE(PG8_SB(0, 0), b2, voffB); PG8_STAGE(PG8_SB(0, 1), b2 + hstepB, voffB); PG8_STAGE(PG8_SA(0, 0), a2, voffA); \
            if constexpr (RX) PG8_WAIT_V2(rxf); else PG8_WAIT_V(8); PG8_WAIT_L(0); PG8_BAR; PG8_MMA(1, 0, At, B0); PG8_MMA(1, 1, At, B1); PG8_BAR; PG8_SCHED; \
              \
            PG8_LDB(B0, 1, 0); PG8_LDB(B1, 1, 1); PG8_SCHED; PG8_LDA(At, 1, 0); PG8_STAGE(PG8_SA(0, 1), a2 + hstepA, voffA); \
            PG8_WAIT_V(8); PG8_WAIT_L(0); PG8_BAR; PG8_MMA(0, 0, At, B0); PG8_MMA(0, 1, At, B1); PG8_BAR; PG8_SCHED; \
              \
            PG8_LDA(At, 1, 1); PG8_STAGE(PG8_SB(1, 0), b3, voffB); PG8_STAGE(PG8_SB(1, 1), b3 + hstepB, voffB); PG8_STAGE(PG8_SA(1, 0), a3, voffA); \
            PG8_WAIT_V(8); PG8_WAIT_L(0); PG8_BAR; PG8_MMA(1, 0, At, B0); PG8_MMA(1, 1, At, B1); PG8_BAR; PG8_SCHED; }
        for (int t = 0; t < unt; t += 2) PG8_PAIR(8)
#undef PG8_PAIR
        if constexpr (MODE == 1) asm volatile("s_nop 15\n\ts_nop 15" ::: "memory");
        if (wr == 0) PG8_BAR;
        const bool reset = E(acc, cur, wr, wc, fr, fq, wid, lane);
        if constexpr (RX) relax = (E.nst(cur) >= 16);
        asm volatile("" ::: "memory");
        if (!has_next) break;
        if (reset) {
#pragma unroll
            for (int a = 0; a < 2; ++a)
#pragma unroll
                for (int b = 0; b < 2; ++b)
#pragma unroll
                    for (int m = 0; m < 4; ++m)
#pragma unroll
                        for (int n = 0; n < 2; ++n) acc[a][b][m][n] = (f32x4){0.f, 0.f, 0.f, 0.f};
        }
        cur = nxt; cA = nA; cB = nB; ++ui;
        if (wr == 1) PG8_BAR;
    }
    PG8_WAIT_V(0);
    PG8_BAR;
#undef PG8_SA
#undef PG8_SB
#undef PG8_STAGE
#undef PG8_LDA
#undef PG8_LDB
#undef PG8_MMA
#undef PG8_WAIT_V
#undef PG8_WAIT_L
#undef PG8_BAR
#undef PG8_SCHED
}

__device__ __forceinline__ bool tile_order(long L, int nM, int nN, int& pm, int& pn) {
    const int nwg = nM * nN; if (L >= nwg) return false;
    const int q = nwg / 8, xcd = (int)(L % 8), off = (int)(L / 8); const int wgid = xcd * q + off;
    const int nig = 8 * nN, gid = wgid / nig, fm = gid * 8;
    pm = fm + ((wgid % nig) % 8); pn = (wgid % nig) / 8; return true;
}
__device__ __forceinline__ void store_bf16_tile(const Acc& acc, bf16_t* base, int ldc, int row0, int col0, int wr, int wc, int fr, int fq) {
#pragma unroll
    for (int ai = 0; ai < 2; ++ai)
#pragma unroll
        for (int m = 0; m < 4; ++m) { bf16_t* rowp = base + (size_t)(row0 + ai * HALF + wr * 64 + m * 16 + fr) * ldc + col0 + wc * 32 + 8 * fq;
#pragma unroll
            for (int bj = 0; bj < 2; ++bj) { const f32x4 v0 = acc[ai][bj][m][0], v1 = acc[ai][bj][m][1];
                u32x4 w; w.x = pk2(v0[0], v0[1]); w.y = pk2(v0[2], v0[3]); w.z = pk2(v1[0], v1[1]); w.w = pk2(v1[2], v1[3]);
                *(u32x4*)(rowp + bj * HALF) = w; } }
}
}

struct Args { const float* in[21]; float* out; unsigned char* ws; };
struct Frame {
    LAS unsigned char* lds;
    int tid, lane, wave, G, bid;
    unsigned char* ws;
    __device__ __forceinline__ void refresh() { int t = threadIdx.x; asm volatile("" : "+v"(t)); tid = t; lane = t & 63; wave = __builtin_amdgcn_readfirstlane(t >> 6); }
};

__device__ __forceinline__ int src_col(int n) { return n < 6144 ? n : (n < O_AL ? n + 16 : (n < O_AL + 16 ? n - O_AL + 6144 : -1)); }
__device__ __forceinline__ void transpose_item(const float* W, int K, int N, int NT, bf16_t* WT, LAS float* scr, int item, int lane, bool remap, unsigned char* W8 = nullptr, bf16_t* WQ = nullptr, const unsigned* cmax = nullptr, float* sw = nullptr, bool i8perm = false) {
    const int nblk = NT / 32, kb = item / nblk, nb = item % nblk, k0 = 64 * kb, n0 = 32 * nb;
    const int q = lane & 7, r8 = lane >> 3;
    const int n = n0 + 4 * q; const int src = remap ? src_col(n) : n;
    f32x4 v[8];
#pragma unroll
    for (int i = 0; i < 8; ++i) v[i] = (src >= 0) ? *(const f32x4*)(W + (size_t)(k0 + 8 * i + r8) * N + src) : (f32x4){0.f, 0.f, 0.f, 0.f};
    if (remap && n0 >= O_QX && n0 < O_GT) {
#pragma unroll
        for (int i = 0; i < 8; ++i) *(u32x2*)(WQ + (size_t)(k0 + 8 * i + r8) * 2048 + (n0 - O_QX) + 4 * q) = (u32x2){pk2(v[i].x, v[i].y), pk2(v[i].z, v[i].w)};
        return;
    }
#pragma unroll
    for (int i = 0; i < 8; ++i) { LAS float* d = scr + (8 * i + r8) * 33 + 4 * q; d[0] = v[i].x; d[1] = v[i].y; d[2] = v[i].z; d[3] = v[i].w; }
    LDS_WAIT(); asm volatile("" ::: "memory");
    const int c = lane & 7;
    if (i8perm) {
#pragma unroll
        for (int j = 0; j < 4; ++j) { const int nn = (lane >> 3) + 8 * j; const LAS float* s = scr + (8 * c) * 33 + nn;
            const float mx = fmaxf(__uint_as_float(xb_ld((unsigned*)cmax + n0 + nn)), 1e-30f), inv = 127.0f / mx;
            int qv[8];
#pragma unroll
            for (int e = 0; e < 8; ++e) qv[e] = (int)rintf(s[e * 33] * inv) & 255;
            *(u32x2*)(W8 + (size_t)(n0 + nn) * K + k0 + 8 * c) = (u32x2){(unsigned)(qv[0] | (qv[2] << 8) | (qv[4] << 16) | (qv[6] << 24)), (unsigned)(qv[1] | (qv[3] << 8) | (qv[5] << 16) | (qv[7] << 24))};
            if (kb == 0 && c == 0) sw[n0 + nn] = mx * (1.0f / 127.0f); }
    } else if (remap && n0 < O_AL && w_row_is8(n0)) {
#pragma unroll
        for (int j = 0; j < 4; ++j) { const int nn = (lane >> 3) + 8 * j; const LAS float* s = scr + (8 * c) * 33 + nn;
            const float mx = fmaxf(__uint_as_float(xb_ld((unsigned*)cmax + src_col(n0 + nn))), 1e-30f), inv = 127.0f / mx;
            int qv[8];
#pragma unroll
            for (int e = 0; e < 8; ++e) qv[e] = (int)rintf(s[e * 33] * inv) & 255;
            *(u32x2*)(W8 + w_row_off(n0 + nn) + k0 + 8 * c) = (u32x2){(unsigned)(qv[0] | (qv[1] << 8) | (qv[2] << 16) | (qv[3] << 24)), (unsigned)(qv[4] | (qv[5] << 8) | (qv[6] << 16) | (qv[7] << 24))};
            if (kb == 0 && c == 0) sw[n0 + nn] = mx * (1.0f / 127.0f); }
    } else if (remap && n0 < O_AL) {
#pragma unroll
        for (int j = 0; j < 4; ++j) { const int nn = (lane >> 3) + 8 * j; const LAS float* s = scr + (8 * c) * 33 + nn;
            u32x4 o; o.x = pk2(s[0 * 33], s[1 * 33]); o.y = pk2(s[2 * 33], s[3 * 33]); o.z = pk2(s[4 * 33], s[5 * 33]); o.w = pk2(s[6 * 33], s[7 * 33]);
            *(u32x4*)(W8 + w_row_off(n0 + nn) + (size_t)(k0 + 8 * c) * 2) = o; }
    } else {
        const int rowoff = remap ? O_AL : 0;
#pragma unroll
        for (int j = 0; j < 4; ++j) { const int nn = (lane >> 3) + 8 * j; const LAS float* s = scr + (8 * c) * 33 + nn;
            u32x4 o; o.x = pk2(s[0 * 33], s[1 * 33]); o.y = pk2(s[2 * 33], s[3 * 33]); o.z = pk2(s[4 * 33], s[5 * 33]); o.w = pk2(s[6 * 33], s[7 * 33]);
            *(u32x4*)(WT + (size_t)(n0 - rowoff + nn) * K + k0 + 8 * c) = o; }
    }
    LDS_WAIT(); asm volatile("" ::: "memory");
}
__device__ __forceinline__ void rms_row_bf16(const float* xrow, const float* gain, bf16_t* orow, int lane) {
    const f32x4* xr = (const f32x4*)xrow + lane;
    f32x4 v[16]; float s = 0.f;
#pragma unroll
    for (int j = 0; j < 16; ++j) { v[j] = xr[64 * j]; s += (v[j].x * v[j].x + v[j].y * v[j].y) + (v[j].z * v[j].z + v[j].w * v[j].w); }
    const float rstd = rsqrtf(wave_sum(s) * (1.f / D) + EPS);
    u32x2* o8 = (u32x2*)orow + lane; const f32x4* gr = (const f32x4*)gain + lane;
#pragma unroll
    for (int j = 0; j < 16; ++j) { const f32x4 g = gr[64 * j]; u32x2 w; w.x = pk2(v[j].x * rstd * g.x, v[j].y * rstd * g.y); w.y = pk2(v[j].z * rstd * g.z, v[j].w * rstd * g.w); o8[64 * j] = w; }
}
__device__ __forceinline__ void rms_row_bf16_i8n(const float* xrow, const float* gain, bf16_t* orow, unsigned char* o8row, float* scale, int lane) {
    const f32x4* xr = (const f32x4*)xrow + lane;
    f32x4 v[16]; float s = 0.f;
#pragma unroll
    for (int j = 0; j < 16; ++j) { v[j] = xr[64 * j]; s += (v[j].x * v[j].x + v[j].y * v[j].y) + (v[j].z * v[j].z + v[j].w * v[j].w); }
    const float rstd = rsqrtf(wave_sum(s) * (1.f / D) + EPS);
    u32x2* o8 = (u32x2*)orow + lane; const f32x4* gr = (const f32x4*)gain + lane; float m = 0.f;
#pragma unroll
    for (int j = 0; j < 16; ++j) { const f32x4 g = gr[64 * j]; v[j].x *= rstd * g.x; v[j].y *= rstd * g.y; v[j].z *= rstd * g.z; v[j].w *= rstd * g.w;
        u32x2 w; w.x = pk2(v[j].x, v[j].y); w.y = pk2(v[j].z, v[j].w); o8[64 * j] = w;
        m = fmaxf(m, fmaxf(fmaxf(fabsf(v[j].x), fabsf(v[j].y)), fmaxf(fabsf(v[j].z), fabsf(v[j].w)))); }
    m = fmaxf(wave_max(m), 1e-30f); const float inv = 127.0f / m;
    if (lane == 0) *scale = m * (1.0f / 127.0f);
    unsigned* o4 = (unsigned*)o8row + lane;
#pragma unroll
    for (int j = 0; j < 16; ++j) { const int q0 = (int)rintf(v[j].x * inv), q1 = (int)rintf(v[j].y * inv), q2 = (int)rintf(v[j].z * inv), q3 = (int)rintf(v[j].w * inv);
        o4[64 * j] = (unsigned)(q0 & 255) | ((unsigned)(q1 & 255) << 8) | ((unsigned)(q2 & 255) << 16) | ((unsigned)(q3 & 255) << 24); }
}
__device__ __forceinline__ void rms_row_i8(const bf16_t* xrow, const float* gain, unsigned char* o8row, float* scale, float* hsum, int lane) {
    const u32x4* xr = (const u32x4*)xrow + lane;
    f32x4 v[16]; float s = 0.f;
#pragma unroll
    for (int j = 0; j < 8; ++j) { const u32x4 u = xr[64 * j]; v[2 * j] = (f32x4){bflo(u.x), bfhi(u.x), bflo(u.y), bfhi(u.y)}; v[2 * j + 1] = (f32x4){bflo(u.z), bfhi(u.z), bflo(u.w), bfhi(u.w)}; }
#pragma unroll
    for (int j = 0; j < 16; ++j) s += (v[j].x * v[j].x + v[j].y * v[j].y) + (v[j].z * v[j].z + v[j].w * v[j].w);
    const float rstd = rsqrtf(wave_sum(s) * (1.f / D) + EPS);
    const f32x4* gr = (const f32x4*)gain + 2 * lane; float m = 0.f;
#pragma unroll
    for (int j = 0; j < 8; ++j) {
#pragma unroll
        for (int q = 0; q < 2; ++q) { const f32x4 g = gr[128 * j + q]; f32x4& x = v[2 * j + q]; x.x *= rstd * g.x; x.y *= rstd * g.y; x.z *= rstd * g.z; x.w *= rstd * g.w;
            m = fmaxf(m, fmaxf(fmaxf(fabsf(x.x), fabsf(x.y)), fmaxf(fabsf(x.z), fabsf(x.w)))); }
        }
    m = fmaxf(wave_max(m), 1e-30f); const float inv = 127.0f / m;
    int isum = 0;
#pragma unroll
    for (int j = 0; j < 8; ++j) { const f32x4 a = v[2 * j], b = v[2 * j + 1];
        const int q0 = (int)rintf(a.x * inv), q1 = (int)rintf(a.y * inv), q2 = (int)rintf(a.z * inv), q3 = (int)rintf(a.w * inv), q4 = (int)rintf(b.x * inv), q5 = (int)rintf(b.y * inv), q6 = (int)rintf(b.z * inv), q7 = (int)rintf(b.w * inv);
        isum += (q0 + q1) + (q2 + q3) + (q4 + q5) + (q6 + q7);
        u32x2 w; w.x = (unsigned)(q0 & 255) | ((unsigned)(q2 & 255) << 8) | ((unsigned)(q4 & 255) << 16) | ((unsigned)(q6 & 255) << 24);
        w.y = (unsigned)(q1 & 255) | ((unsigned)(q3 & 255) << 8) | ((unsigned)(q5 & 255) << 16) | ((unsigned)(q7 & 255) << 24);
        ((u32x2*)o8row)[lane + 64 * j] = w; }
#pragma unroll
    for (int o = 1; o < 64; o <<= 1) isum += __shfl_xor(isum, o);
    if (lane == 0) { *scale = m * (1.0f / 127.0f); *hsum = (float)isum; }
}
__device__ __forceinline__ void cvt_table(const float* src, bf16_t* dst, size_t n8, size_t gt, size_t ngt) {
    for (size_t i = gt; i < n8; i += ngt) { const f32x4 a = ((const f32x4*)src)[2 * i], b = ((const f32x4*)src)[2 * i + 1];
        u32x4 w; w.x = pk2(a.x, a.y); w.y = pk2(a.z, a.w); w.z = pk2(b.x, b.y); w.w = pk2(b.z, b.w); ((u32x4*)dst)[i] = w; }
}
__device__ __forceinline__ void quant_row_i4(const float* xrow, unsigned char* orow, float* scale, int lane) {
    const f32x4* xr = (const f32x4*)xrow + 2 * lane;
    f32x4 v[16]; float s = 0.f;
#pragma unroll
    for (int j = 0; j < 8; ++j) { v[2 * j] = xr[128 * j]; v[2 * j + 1] = xr[128 * j + 1]; }
#pragma unroll
    for (int j = 0; j < 16; ++j) s += (v[j].x * v[j].x + v[j].y * v[j].y) + (v[j].z * v[j].z + v[j].w * v[j].w);
    const float sc = fmaxf(2.5f * sqrtf(wave_sum(s) * (1.f / D)) * (1.f / 7.f), 1e-30f), inv = 1.0f / sc;
    if (lane == 0) *scale = sc;
    unsigned* o4 = (unsigned*)orow + lane;
#pragma unroll
    for (int j = 0; j < 8; ++j) { const f32x4 a = v[2 * j], b = v[2 * j + 1]; const float e[8] = {a.x, a.y, a.z, a.w, b.x, b.y, b.z, b.w}; unsigned w = 0u;
#pragma unroll
        for (int i = 0; i < 8; ++i) { const int q = (int)fminf(fmaxf(rintf(e[i] * inv), -7.f), 7.f) + 8; w |= (unsigned)q << (4 * i); }
        o4[64 * j] = w; }
}
__device__ __forceinline__ int nth_block(int j, bool want8) {
    int nb = -1;
#pragma unroll
    for (int s = 0; s < 9; ++s) { const int b0 = (s < 8 ? SEG_START[s] : O_AL) / 32, b1 = (s < 8 ? SEG_START[s + 1] : NPAD) / 32; const bool is8 = s < 8 && seg_i8(s);
        if (is8 == want8) { if (nb < 0 && j >= 0 && j < b1 - b0) nb = b0 + j; j -= (b1 - b0); } }
    return nb;
}
constexpr int count_blocks8() { int n = 0; for (int s = 0; s < 8; ++s) if (seg_i8(s)) n += (SEG_START[s + 1] - SEG_START[s]) / 32; return n; }
constexpr int NB8 = count_blocks8(), NBX = NPAD / 32 - NB8;
__device__ __forceinline__ void p0_prologue_a(Frame& F, const Args& a) {
    LAS float* scr = (LAS float*)(F.lds + F.wave * 16384);
    const int gw = F.bid * 8 + F.wave, NGW = F.G * 8;
    unsigned char* ws = F.ws;
    constexpr int I_BR = 32 * 128, I_O = 64 * 128, I_KV = 64 * 128;
    constexpr int I_X = 64 * NBX;
    constexpr int NITEMS = 3 * I_BR + I_O + I_KV + I_X;
    for (int it = gw; it < NITEMS; it += NGW) {
        int r = it;
        if (r < I_X) { const int nb = nth_block(r >> 6, false); transpose_item(a.in[3], D, 26640, NPAD, (bf16_t*)(ws + WS_WAL), scr, (r & 63) * (NPAD / 32) + nb, F.lane, true, ws + WS_W8, (bf16_t*)(ws + WS_WQX), (const unsigned*)(ws + WS_CTL + CTL_CMAX), (float*)(ws + WS_SW)); continue; } r -= I_X;
        if (r < I_BR) { transpose_item(a.in[8], 2048, D, D, (bf16_t*)(ws + WS_WBR), scr, r, F.lane, false); continue; } r -= I_BR;
        if (r < I_BR) { transpose_item(a.in[9], 2048, D, D, (bf16_t*)(ws + WS_WBR + 16 * MiB), scr, r, F.lane, false); continue; } r -= I_BR;
        if (r < I_BR) { transpose_item(a.in[11], 2048, D, D, (bf16_t*)(ws + WS_WBR + 32 * MiB), scr, r, F.lane, false); continue; } r -= I_BR;
        if (r < I_O) { transpose_item(a.in[13], D, D, D, (bf16_t*)(ws + WS_WO), scr, r, F.lane, false); continue; } r -= I_O;
        transpose_item(a.in[10], D, D, D, (bf16_t*)(ws + WS_WKV), scr, r, F.lane, false);
    }
    for (int m = gw; m < T; m += NGW) rms_row_bf16_i8n(a.in[0] + (size_t)m * D, a.in[2], (bf16_t*)(ws + WS_HN) + (size_t)m * D, ws + WS_HN8 + (size_t)m * D, (float*)(ws + WS_SHN) + m, F.lane);
    for (int m = gw; m < MEMT; m += NGW) rms_row_bf16(a.in[1] + (size_t)m * D, a.in[14], (bf16_t*)(ws + WS_MEMN) + (size_t)m * D, F.lane);
    const size_t gt = (size_t)F.bid * 512 + F.tid, ngt = (size_t)F.G * 512;
    cvt_table(a.in[17], (bf16_t*)(ws + WS_SUBK), (size_t)8 * 2 * 128 * 128 / 8, gt, ngt);
    { unsigned* cmq = (unsigned*)(ws + WS_CTL + CTL_CMAXPQ);
      for (int u = F.bid; u < 256; u += F.G) { const float* wp = a.in[16] + (size_t)(16 * u) * 2048 + 4 * F.tid; f32x4 m = (f32x4){0.f, 0.f, 0.f, 0.f};
#pragma unroll
          for (int r = 0; r < 16; ++r) { const f32x4 v = *(const f32x4*)(wp + (size_t)r * 2048); m.x = fmaxf(m.x, fabsf(v.x)); m.y = fmaxf(m.y, fabsf(v.y)); m.z = fmaxf(m.z, fabsf(v.z)); m.w = fmaxf(m.w, fabsf(v.w)); }
          atomicMax(cmq + 4 * F.tid + 0, __float_as_uint(m.x)); atomicMax(cmq + 4 * F.tid + 1, __float_as_uint(m.y)); atomicMax(cmq + 4 * F.tid + 2, __float_as_uint(m.z)); atomicMax(cmq + 4 * F.tid + 3, __float_as_uint(m.w)); } }
}
__device__ __forceinline__ void p0_weights8(Frame& F, const Args& a) {
    LAS float* scr = (LAS float*)(F.lds + F.wave * 16384); LAS float* smax = (LAS float*)(F.lds + 131072); LAS float* bmax = smax + 256;
    unsigned char* ws = F.ws; const int lane = F.lane, q = lane & 7, r8 = lane >> 3, c = lane & 7;
    const float* W = a.in[3]; float* sw = (float*)(ws + WS_SW);
    for (int b = F.bid; b < NB8; b += F.G) {
        const int nb = nth_block(b, true), n0 = 32 * nb, src = src_col(n0 + 4 * q);
        const float* wp = W + (size_t)(512 * F.wave + r8) * 26640 + src;
        f32x4 mx = (f32x4){0.f, 0.f, 0.f, 0.f};
#pragma unroll 1
        for (int h = 0; h < 2; ++h) { f32x4 v[32];
#pragma unroll
            for (int i = 0; i < 32; ++i) v[i] = *(const f32x4*)(wp + (size_t)(256 * h + 8 * i) * 26640);
#pragma unroll
            for (int i = 0; i < 32; ++i) { mx.x = fmaxf(mx.x, fabsf(v[i].x)); mx.y = fmaxf(mx.y, fabsf(v[i].y)); mx.z = fmaxf(mx.z, fabsf(v[i].z)); mx.w = fmaxf(mx.w, fabsf(v[i].w)); } }
#pragma unroll
        for (int o_ = 8; o_ < 64; o_ <<= 1) { mx.x = fmaxf(mx.x, __shfl_xor(mx.x, o_)); mx.y = fmaxf(mx.y, __shfl_xor(mx.y, o_)); mx.z = fmaxf(mx.z, __shfl_xor(mx.z, o_)); mx.w = fmaxf(mx.w, __shfl_xor(mx.w, o_)); }
        if (lane < 8) { LAS float* d = smax + F.wave * 32 + 4 * q; d[0] = mx.x; d[1] = mx.y; d[2] = mx.z; d[3] = mx.w; }
        __syncthreads();
        if (F.tid < 32) { float m = 0.f;
#pragma unroll
            for (int w = 0; w < 8; ++w) m = fmaxf(m, smax[w * 32 + F.tid]);
            m = fmaxf(m, 1e-30f); bmax[F.tid] = m; sw[n0 + F.tid] = m * (1.0f / 127.0f); }
        __syncthreads();
        float inv[4]; size_t roff[4];
#pragma unroll
        for (int j = 0; j < 4; ++j) { const int nn = r8 + 8 * j; inv[j] = 127.0f / bmax[nn]; roff[j] = w_row_off(n0 + nn); }
        f32x4 v[8], vn[8];
#pragma unroll
        for (int i = 0; i < 8; ++i) v[i] = *(const f32x4*)(wp + (size_t)(8 * i) * 26640);
#pragma unroll 1
        for (int ck = 0; ck < 8; ++ck) {
            if (ck < 7) {
#pragma unroll
                for (int i = 0; i < 8; ++i) vn[i] = *(const f32x4*)(wp + (size_t)(64 * (ck + 1) + 8 * i) * 26640); }
#pragma unroll
            for (int i = 0; i < 8; ++i) { LAS float* d = scr + (8 * i + r8) * 33 + 4 * q; d[0] = v[i].x; d[1] = v[i].y; d[2] = v[i].z; d[3] = v[i].w; }
            LDS_WAIT(); asm volatile("" ::: "memory");
            const int k0 = 512 * F.wave + 64 * ck;
#pragma unroll
            for (int j = 0; j < 4; ++j) { const int nn = r8 + 8 * j; const LAS float* s_ = scr + (8 * c) * 33 + nn; int qv[8];
#pragma unroll
                for (int e_ = 0; e_ < 8; ++e_) qv[e_] = (int)rintf(s_[e_ * 33] * inv[j]) & 255;
                *(u32x2*)(ws + WS_W8 + roff[j] + k0 + 8 * c) = (u32x2){(unsigned)(qv[0] | (qv[1] << 8) | (qv[2] << 16) | (qv[3] << 24)), (unsigned)(qv[4] | (qv[5] << 8) | (qv[6] << 16) | (qv[7] << 24))}; }
            LDS_WAIT(); asm volatile("" ::: "memory");
#pragma unroll
            for (int i = 0; i < 8; ++i) v[i] = vn[i];
        }
        __syncthreads();
    }
}
__device__ __forceinline__ void peer_wq_convert(Frame& F, const Args& a) {
    LAS float* scr = (LAS float*)(F.lds + F.wave * 16384);
    const int gw = F.bid * 8 + F.wave, NGW = F.G * 8; unsigned char* ws = F.ws;
    for (int it = gw; it < 64 * 64; it += NGW)
        transpose_item(a.in[16], D, 2048, 2048, nullptr, scr, it, F.lane, false, ws + WS_WPQ, nullptr, (const unsigned*)(ws + WS_CTL + CTL_CMAXPQ), (float*)(ws + WS_SWPQ), true);
}

struct P1Sched {
    const char *hn, *wreg, *wal, *memn, *wkv; int G, c;
    __device__ __forceinline__ bool next(int i, gg::Unit& u) const {
        long L = (long)i * G + c; u.aux = 0;
        if (L < 64 * NTB) { int pm, pn; gg::tile_order(L, 64, NTB > 0 ? NTB : 1, pm, pn); pn = map_tile(pn, false);
            u.kind = 0; u.pm = pm; u.pn = pn; u.A = hn + (size_t)pm * 256 * D * 2; u.B = wreg + w_row_off(256 * pn); return true; }
        L -= 64 * NTB;
        if (L < 64) { u.kind = 0; u.pm = (int)L; u.pn = 104; u.A = hn + (size_t)L * 256 * D * 2; u.B = wal; return true; }
        L -= 64;
        if (!V_I8) { if (L < 512) { u.kind = 1; u.pm = (int)(L % 8); u.pn = (int)(L / 8); u.A = wreg + w_row_off(O_VG + 256 * u.pm); u.B = hn + (size_t)u.pn * 256 * D * 2; return true; } L -= 512; }
        if (L < 64) { u.kind = 2; u.pm = (int)(L % 4); u.pn = (int)(L / 4); u.A = memn + (size_t)u.pm * 256 * D * 2; u.B = wkv + (size_t)u.pn * 256 * D * 2; return true; }
        return false;
    }
};
struct I8Sched {
    const char *hn8, *wreg; int G, c;
    __device__ __forceinline__ bool next(int i, gg::Unit& u) const {
        const int rb = NU_B % G, ext = (rb > 0 && NU_8 >= 2 * (G - rb)) ? 2 * (G - rb) : 0, x = (NU_8 - ext) / G, rem = (NU_8 - ext) % G;
        const int cnt1 = x + (c < rem ? 1 : 0);
        long L; u.aux = 0;
        if (i < cnt1) L = (long)i * G + c; else if (ext > 0 && c >= rb && i - cnt1 < 2) L = (long)x * G + rem + 2 * (c - rb) + (i - cnt1); else return false;
        if (L < 64 * NT8) { int pm, pn; gg::tile_order(L, 64, NT8 > 0 ? NT8 : 1, pm, pn); pn = map_tile(pn, true);
            u.kind = 0; u.pm = pm; u.pn = pn; u.A = hn8 + (size_t)pm * 256 * D; u.B = wreg + w_row_off(256 * pn); return true; }
        L -= 64 * NT8;
        if (V_I8 && L < 512) { u.kind = 1; u.pm = (int)(L % 8); u.pn = (int)(L / 8); u.A = wreg + w_row_off(O_VG + 256 * u.pm); u.B = hn8 + (size_t)u.pn * 256 * D; return true; }
        return false;
    }
};
struct I8Epi {
    unsigned char* ws; const float* bgate;
    __device__ __forceinline__ int nst(const gg::Unit& u) const { return 16; }
    __device__ __forceinline__ bool operator()(gg::Acc& acc, const gg::Unit& u, int wr, int wc, int fr, int fq, int wid, int lane) const {
        bf16_t* base; int ldc, col0, mode = 0; const int row0 = u.pm * 256; const float *rs, *cs;
        const float* shn = (const float*)(ws + WS_SHN); const float* sw = (const float*)(ws + WS_SW);
        if (u.kind == 0) { const int c0 = u.pn * 256; rs = shn + row0; cs = sw + c0;
            if (c0 < O_KG) { base = (bf16_t*)(ws + WS_QG); ldc = 1024; col0 = c0; }
            else if (c0 < O_VG) { base = (bf16_t*)(ws + WS_KG); ldc = 1024; col0 = c0 - O_KG; }
            else if (c0 < O_CB) { base = (bf16_t*)(ws + WS_RG); ldc = 2048; col0 = c0 - O_RG; }
            else if (c0 < O_CC) { base = (bf16_t*)(ws + WS_CB); ldc = 2048; col0 = c0 - O_CB; }
            else if (c0 < O_CH) { base = (bf16_t*)(ws + WS_CC); ldc = 2048; col0 = c0 - O_CC; }
            else if (c0 < O_QX) { base = (bf16_t*)(ws + WS_CH); ldc = 2048; col0 = c0 - O_CH; }
            else { base = (bf16_t*)(ws + WS_GT); ldc = 12288; col0 = c0 - O_GT; mode = 1; }
        } else { base = (bf16_t*)(ws + WS_VT); ldc = T; col0 = u.pn * 256; rs = sw + O_VG + row0; cs = shn + col0; }
        float rvv[2][4]; f32x4 cv[2][2], bv[2][2];
#pragma unroll
        for (int ai = 0; ai < 2; ++ai)
#pragma unroll
            for (int m = 0; m < 4; ++m) rvv[ai][m] = rs[ai * 128 + wr * 64 + m * 16 + fr];
#pragma unroll
        for (int bj = 0; bj < 2; ++bj) { const float* cp = cs + bj * 128 + wc * 32 + 8 * fq; cv[bj][0] = *(const f32x4*)cp; cv[bj][1] = *(const f32x4*)(cp + 4);
            bv[bj][0] = (f32x4){0.f, 0.f, 0.f, 0.f}; bv[bj][1] = bv[bj][0];
            if (mode == 1) { const float* bp = bgate + col0 + bj * 128 + wc * 32 + 8 * fq; bv[bj][0] = *(const f32x4*)bp; bv[bj][1] = *(const f32x4*)(bp + 4); } }
#pragma unroll
        for (int bj = 0; bj < 2; ++bj) { const f32x4 c0v = cv[bj][0], c1v = cv[bj][1], b0 = bv[bj][0], b1 = bv[bj][1];
#pragma unroll
            for (int ai = 0; ai < 2; ++ai)
#pragma unroll
                for (int m = 0; m < 4; ++m) { const int r = ai * 128 + wr * 64 + m * 16 + fr; const float rv = rvv[ai][m];
                    const i32x4 i0 = __builtin_bit_cast(i32x4, acc[ai][bj][m][0]), i1 = __builtin_bit_cast(i32x4, acc[ai][bj][m][1]);
                    f32x4 v0 = (f32x4){(float)i0[0], (float)i0[1], (float)i0[2], (float)i0[3]} * (c0v * rv) + b0, v1 = (f32x4){(float)i1[0], (float)i1[1], (float)i1[2], (float)i1[3]} * (c1v * rv) + b1;
                    if (mode == 1) {
#pragma unroll
                        for (int j = 0; j < 4; ++j) { v0[j] = inv_sigmoid(v0[j]); v1[j] = inv_sigmoid(v1[j]); } }
                    u32x4 w; w.x = pk2(v0[0], v0[1]); w.y = pk2(v0[2], v0[3]); w.z = pk2(v1[0], v1[1]); w.w = pk2(v1[2], v1[3]);
                    *(u32x4*)(base + (size_t)(row0 + r) * ldc + col0 + bj * 128 + wc * 32 + 8 * fq) = w; } }
        return true;
    }
};
struct P1Epi {
    unsigned char* ws; const float* bgate;
    __device__ __forceinline__ int nst(const gg::Unit& u) const { return 0; }
    __device__ __forceinline__ bool operator()(gg::Acc& acc, const gg::Unit& u, int wr, int wc, int fr, int fq, int wid, int lane) const {
        bf16_t* base; int ldc, col0, mode = 0; const int row0 = u.pm * 256;
        if (u.kind == 0) { const int c0 = u.pn * 256;
            if (c0 < O_KG) { base = (bf16_t*)(ws + WS_QG); ldc = 1024; col0 = c0; }
            else if (c0 < O_VG) { base = (bf16_t*)(ws + WS_KG); ldc = 1024; col0 = c0 - O_KG; }
            else if (c0 < O_CB) { base = (bf16_t*)(ws + WS_RG); ldc = 2048; col0 = c0 - O_RG; }
            else if (c0 < O_CC) { base = (bf16_t*)(ws + WS_CB); ldc = 2048; col0 = c0 - O_CB; }
            else if (c0 < O_CH) { base = (bf16_t*)(ws + WS_CC); ldc = 2048; col0 = c0 - O_CC; }
            else if (c0 < O_QX) { base = (bf16_t*)(ws + WS_CH); ldc = 2048; col0 = c0 - O_CH; }
            else if (c0 < O_GT) { base = (bf16_t*)(ws + WS_QX); ldc = 2048; col0 = c0 - O_QX; }
            else if (c0 < O_AL) { base = (bf16_t*)(ws + WS_GT); ldc = 12288; col0 = c0 - O_GT; mode = 1; }
            else { base = nullptr; ldc = 0; col0 = 0; mode = 2; }
        } else if (u.kind == 1) { base = (bf16_t*)(ws + WS_VT); ldc = T; col0 = u.pn * 256; }
        else { base = (bf16_t*)(ws + WS_KVM); ldc = 4096; col0 = u.pn * 256; }
        if (mode == 0) { gg::store_bf16_tile(acc, base, ldc, row0, col0, wr, wc, fr, fq); }
        else if (mode == 1) {
#pragma unroll
            for (int bj = 0; bj < 2; ++bj) { const float* bp = bgate + col0 + bj * 128 + wc * 32 + 8 * fq; const f32x4 b0 = *(const f32x4*)bp, b1 = *(const f32x4*)(bp + 4);
#pragma unroll
                for (int ai = 0; ai < 2; ++ai)
#pragma unroll
                    for (int m = 0; m < 4; ++m) { f32x4 v0 = acc[ai][bj][m][0] + b0, v1 = acc[ai][bj][m][1] + b1;
#pragma unroll
                        for (int j = 0; j < 4; ++j) { v0[j] = inv_sigmoid(v0[j]); v1[j] = inv_sigmoid(v1[j]); }
                        u32x4 w; w.x = pk2(v0[0], v0[1]); w.y = pk2(v0[2], v0[3]); w.z = pk2(v1[0], v1[1]); w.w = pk2(v1[2], v1[3]);
                        *(u32x4*)(base + (size_t)(row0 + ai * 128 + wr * 64 + m * 16 + fr) * ldc + col0 + bj * 128 + wc * 32 + 8 * fq) = w; } }
        } else {
            if (wc == 0 && fq < 2) { float* alr = (float*)(ws + WS_ALR);
#pragma unroll
                for (int ai = 0; ai < 2; ++ai)
#pragma unroll
                    for (int m = 0; m < 4; ++m) { float* p = alr + (size_t)(row0 + ai * 128 + wr * 64 + m * 16 + fr) * 16 + 8 * fq;
                        *(f32x4*)p = acc[ai][0][m][0]; *(f32x4*)(p + 4) = acc[ai][0][m][1]; } }
        }
        return true;
    }
};

constexpr int PREP_ROWB = 528;
constexpr int PREP_QT = 0, PREP_KI = 2 * 64 * PREP_ROWB, PREP_ALR = 4 * 64 * PREP_ROWB;
constexpr int PREP_KOT_ROWB = 144;
__device__ __forceinline__ void gla_prep_unit(Frame& F, const Args& a, int unit) {
    const int hp = unit & 1, n = (unit >> 1) & 63, b = unit >> 7;
    const int tid = F.tid, hh = tid >> 8, c = tid & 255, h = 2 * hp + hh, lane = F.lane, wid = F.wave;
    const int tok0 = b * SEQ + n * 64;
    unsigned char* ws = F.ws;
    LAS float* alr_s = (LAS float*)(F.lds + PREP_ALR);
    LAS unsigned char* qt_s = F.lds + PREP_QT + hh * 64 * PREP_ROWB;
    LAS unsigned char* ki_s = F.lds + PREP_KI + hh * 64 * PREP_ROWB;
    if (tid < 256) ((LAS f32x4*)alr_s)[tid] = ((const f32x4*)((const float*)(ws + WS_ALR) + (size_t)tok0 * 16))[tid];
    float w[16];
#pragma unroll
    for (int r = 0; r < 16; ++r) w[r] = a.in[4][r * 1024 + h * 256 + c];
    const float ba = a.in[5][h * 256 + c];
    __syncthreads();
    float bt[64]; float cum = 0.f;
#pragma unroll
    for (int t = 0; t < 64; ++t) {
        float z = ba;
#pragma unroll
        for (int r = 0; r < 16; ++r) z += alr_s[t * 16 + r] * w[r];
        const float ls = fminf(z, 0.f) - __logf(1.0f + __expf(-fabsf(z)));
        cum += ls * (1.0f / 16.0f); bt[t] = cum;
    }
    const bf16_t* qg = (const bf16_t*)(ws + WS_QG) + (size_t)tok0 * 1024 + h * 256 + c;
    const bf16_t* kg = (const bf16_t*)(ws + WS_KG) + (size_t)tok0 * 1024 + h * 256 + c;
#pragma unroll
    for (int t = 0; t < 64; ++t) {
        const float q = bf2f(qg[(size_t)t * 1024]), k = bf2f(kg[(size_t)t * 1024]);
        const float eb = __expf(bt[t]);
        *(LAS bf16_t*)(qt_s + t * PREP_ROWB + c * 2) = (bf16_t)f2bf(q * eb * 0.0625f);
        *(LAS bf16_t*)(ki_s + t * PREP_ROWB + c * 2) = (bf16_t)f2bf(k * __expf(-bt[t]));
    }
    unsigned char* blk = ws + WS_GLAB + (size_t)((b * 4 + h) * 64 + n) * GLA_BLK;
    ((float*)(blk + 73728))[c] = __expf(cum);
    __syncthreads();
    {
        const int whh = wid >> 2, mb = wid & 3, fr = lane & 15, fq = lane >> 4;
        LAS unsigned char* qs = F.lds + PREP_QT + whh * 64 * PREP_ROWB; LAS unsigned char* ks = F.lds + PREP_KI + whh * 64 * PREP_ROWB;
        unsigned char* wblk = ws + WS_GLAB + (size_t)((b * 4 + 2 * hp + whh) * 64 + n) * GLA_BLK;
        bf16_t* attf = (bf16_t*)(wblk + 65536);
#pragma unroll
        for (int nb = 0; nb < 4; ++nb) {
            f32x4 acc = (f32x4){0.f, 0.f, 0.f, 0.f};
            if (nb <= mb) {
#pragma unroll
                for (int kk = 0; kk < 8; ++kk) {
                    const bf16x8 av = *(const LAS bf16x8*)(qs + (16 * mb + fr) * PREP_ROWB + (32 * kk + 8 * fq) * 2);
                    const bf16x8 bv = *(const LAS bf16x8*)(ks + (16 * nb + fr) * PREP_ROWB + (32 * kk + 8 * fq) * 2);
                    acc = __builtin_amdgcn_mfma_f32_16x16x32_bf16(av, bv, acc, 0, 0, 0);
                }
            }
            const int s = 16 * nb + fr;
#pragma unroll
            for (int j = 0; j < 4; ++j) { const int t = 16 * mb + 4 * fq + j; const float v = (s <= t) ? acc[j] : 0.f;
                attf[((mb * 2 + (s >> 5)) * 64 + (t & 15) + 16 * ((s & 31) >> 3)) * 8 + (s & 7)] = (bf16_t)f2bf(v); }
        }
        u32x4* qtf = (u32x4*)wblk;
#pragma unroll
        for (int i = 0; i < 8; ++i) { const int f = (wid & 3) * 8 + i, mb2 = f >> 3, kk = f & 7;
            const LAS unsigned char* rowp = qs + (16 * mb2 + fr) * PREP_ROWB + (32 * kk + 4 * fq) * 2;
            const u32x2 lo = *(const LAS u32x2*)rowp, hi = *(const LAS u32x2*)(rowp + 32);
            u32x4 o; o.x = lo.x; o.y = lo.y; o.z = hi.x; o.w = hi.y; qtf[f * 64 + lane] = o; }
    }
    __syncthreads();
    {
        LAS unsigned char* kot = F.lds + hh * 256 * PREP_KOT_ROWB + c * PREP_KOT_ROWB;
#pragma unroll
        for (int t8 = 0; t8 < 8; ++t8) { float v[8];
#pragma unroll
            for (int j = 0; j < 8; ++j) { const int t = t8 * 8 + j; v[j] = bf2f(kg[(size_t)t * 1024]) * __expf(cum - bt[t]); }
            u32x4 o; o.x = pk2(v[0], v[1]); o.y = pk2(v[2], v[3]); o.z = pk2(v[4], v[5]); o.w = pk2(v[6], v[7]);
            *(LAS u32x4*)(kot + t8 * 16) = o; }
    }
    __syncthreads();
    {
        const int whh = wid >> 2, fr = lane & 15, fq = lane >> 4;
        unsigned char* wblk = ws + WS_GLAB + (size_t)((b * 4 + 2 * hp + whh) * 64 + n) * GLA_BLK;
        u32x4* kof = (u32x4*)(wblk + 32768);
        const LAS unsigned char* kb = F.lds + whh * 256 * PREP_KOT_ROWB;
#pragma unroll
        for (int i = 0; i < 8; ++i) { const int f = (wid & 3) * 8 + i, mbc = f >> 1, kk2 = f & 1;
            kof[f * 64 + lane] = *(const LAS u32x4*)(kb + (16 * mbc + fr) * PREP_KOT_ROWB + (32 * kk2 + 8 * fq) * 2); }
    }
    __syncthreads();
}

__device__ __forceinline__ void conv_phase(Frame& F, const Args& a, int wg, int nwg) {
    unsigned char* ws = F.ws;
    const size_t gt = (size_t)wg * 512 + F.tid, ngt = (size_t)nwg * 512;
    u32x4* cb = (u32x4*)(ws + WS_CB); const u32x4* cc = (const u32x4*)(ws + WS_CC); const u32x4* ch = (const u32x4*)(ws + WS_CH);
    const float* cw = a.in[7];
    for (size_t p = gt; p < (size_t)T * 256; p += ngt) {
        const int t = (int)(p >> 8), c8 = (int)(p & 255) * 8, pos = t & (SEQ - 1);
        float accv[8];
#pragma unroll
        for (int j = 0; j < 8; ++j) accv[j] = 0.f;
#pragma unroll
        for (int d = 0; d < 3; ++d) {
            if (pos >= d) { const u32x4 x = cc[p - (size_t)d * 256], y = ch[p - (size_t)d * 256];
                const f32x4 w0 = *(const f32x4*)(cw + d * 2048 + c8), w1 = *(const f32x4*)(cw + d * 2048 + c8 + 4);
                accv[0] += w0.x * (bflo(x.x) * bflo(y.x)); accv[1] += w0.y * (bfhi(x.x) * bfhi(y.x));
                accv[2] += w0.z * (bflo(x.y) * bflo(y.y)); accv[3] += w0.w * (bfhi(x.y) * bfhi(y.y));
                accv[4] += w1.x * (bflo(x.z) * bflo(y.z)); accv[5] += w1.y * (bfhi(x.z) * bfhi(y.z));
                accv[6] += w1.z * (bflo(x.w) * bflo(y.w)); accv[7] += w1.w * (bfhi(x.w) * bfhi(y.w)); }
        }
        const u32x4 bv = cb[p]; u32x4 o;
        o.x = pk2(bflo(bv.x) * accv[0], bfhi(bv.x) * accv[1]); o.y = pk2(bflo(bv.y) * accv[2], bfhi(bv.y) * accv[3]);
        o.z = pk2(bflo(bv.z) * accv[4], bfhi(bv.z) * accv[5]); o.w = pk2(bflo(bv.w) * accv[6], bfhi(bv.w) * accv[7]);
        cb[p] = o;
    }
}

struct XsSched {
    const char *hn, *wkt; int G, c;
    __device__ __forceinline__ bool next(int i, gg::Unit& u) const {
        const long L = (long)i * G + c; if (L >= 256) return false;
        const int xcd = (int)(L % 8), off = (int)(L / 8), w = xcd * 32 + off;
        const int pm = w >> 2, h = w & 3, b = pm >> 4;
        u.kind = 0; u.pm = pm; u.pn = h; u.aux = 0;
        u.A = hn + (size_t)pm * 256 * D * 2; u.B = wkt + ((size_t)(b * 1024 + h * 256) * D) * 2; return true;
    }
};
struct WkSched {
    const char *kvm, *wqx; int G, c;
    __device__ __forceinline__ bool next(int i, gg::Unit& u) const {
        const long L = (long)i * G + c; if (L >= 256) return false;
        const int bh = (int)(L >> 4), ntile = (int)(L & 15), b = bh >> 2, h = bh & 3;
        u.kind = 0; u.pm = b * 4 + h; u.pn = ntile; u.aux = 0;
        u.A = kvm + ((size_t)(b * 256) * 4096 + h * 512) * 2; u.B = wqx + ((size_t)(ntile * 256) * 2048 + h * 512) * 2; return true;
    }
};
struct WkEpi {
    bf16_t* wkt;
    __device__ __forceinline__ int nst(const gg::Unit& u) const { return 16; }
    __device__ __forceinline__ bool operator()(gg::Acc& acc, const gg::Unit& u, int wr, int wc, int fr, int fq, int wid, int lane) const {
        gg::store_bf16_tile(acc, wkt, D, u.pm * 256, u.pn * 256, wr, wc, fr, fq); return true;
    }
};
struct XsEpi {
    bf16_t* prob; LAS unsigned char* ex;
    __device__ __forceinline__ int nst(const gg::Unit& u) const { return 0; }
    __device__ __forceinline__ bool operator()(gg::Acc& acc, const gg::Unit& u, int wr, int wc, int fr, int fq, int wid, int lane) const {
        LAS float* MX = (LAS float*)ex; LAS float* SM = (LAS float*)(ex + 4096);
        const float sc = 0.04419417382f * 1.44269504089f;
#pragma unroll
        for (int ai = 0; ai < 2; ++ai)
#pragma unroll
            for (int m = 0; m < 4; ++m) { float v = -3.0e38f;
#pragma unroll
                for (int bj = 0; bj < 2; ++bj)
#pragma unroll
                    for (int n = 0; n < 2; ++n) { const f32x4 x = acc[ai][bj][m][n]; v = fmaxf(v, fmaxf(fmaxf(x[0], x[1]), fmaxf(x[2], x[3]))); }
                v = fmaxf(v, __shfl_xor(v, 16)); v = fmaxf(v, __shfl_xor(v, 32));
                if (fq == 0) MX[(ai * 128 + wr * 64 + m * 16 + fr) * 4 + wc] = v; }
        LDS_WAIT(); __builtin_amdgcn_s_barrier(); asm volatile("" ::: "memory");
#pragma unroll
        for (int ai = 0; ai < 2; ++ai)
#pragma unroll
            for (int m = 0; m < 4; ++m) { const f32x4 q = *(const LAS f32x4*)(MX + (ai * 128 + wr * 64 + m * 16 + fr) * 4);
                const float rm = fmaxf(fmaxf(q[0], q[1]), fmaxf(q[2], q[3])); float s = 0.f;
#pragma unroll
                for (int bj = 0; bj < 2; ++bj)
#pragma unroll
                    for (int n = 0; n < 2; ++n) {
#pragma unroll
                        for (int j = 0; j < 4; ++j) { const float e = __builtin_amdgcn_exp2f((acc[ai][bj][m][n][j] - rm) * sc); acc[ai][bj][m][n][j] = e; s += e; } }
                s += __shfl_xor(s, 16); s += __shfl_xor(s, 32);
                if (fq == 0) SM[(ai * 128 + wr * 64 + m * 16 + fr) * 4 + wc] = s; }
        LDS_WAIT(); __builtin_amdgcn_s_barrier(); asm volatile("" ::: "memory");
        const int b = u.pm >> 4, panel = u.pm & 15, h = u.pn;
#pragma unroll
        for (int ai = 0; ai < 2; ++ai)
#pragma unroll
            for (int m = 0; m < 4; ++m) { const f32x4 q = *(const LAS f32x4*)(SM + (ai * 128 + wr * 64 + m * 16 + fr) * 4);
                const float inv = 1.0f / ((q[0] + q[1]) + (q[2] + q[3]));
                bf16_t* rowp = prob + (size_t)(b * SEQ + panel * 256 + ai * 128 + wr * 64 + m * 16 + fr) * 2048 + h * 256 + wc * 32 + 8 * fq;
#pragma unroll
                for (int bj = 0; bj < 2; ++bj) { const f32x4 v0 = acc[ai][bj][m][0] * inv, v1 = acc[ai][bj][m][1] * inv;
                    u32x4 w; w.x = pk2(v0[0], v0[1]); w.y = pk2(v0[2], v0[3]); w.z = pk2(v1[0], v1[1]); w.w = pk2(v1[2], v1[3]);
                    *(u32x4*)(rowp + bj * 128) = w; } }
        return true;
    }
};

__device__ __forceinline__ void gla_scan_unit(Frame& F, const Args& a, int unit) {
    const int dvq = unit & 3, h = (unit >> 2) & 3, b = unit >> 4;
    const int lane = F.lane, wid = F.wave, fr = lane & 15, fq = lane >> 4;
    unsigned char* ws = F.ws;
    const unsigned char* blk0 = ws + WS_GLAB + (size_t)((b * 4 + h) * 64) * GLA_BLK;
    const int dvcol = 16 * (8 * dvq + wid);
    const bf16_t* vt = (const bf16_t*)(ws + WS_VT) + (size_t)(h * 512 + dvcol + fr) * T + (size_t)b * SEQ + 8 * fq;
    bf16_t* og = (bf16_t*)(ws + WS_OG) + (size_t)(b * SEQ) * 2048 + h * 512 + dvcol + fr;
    f32x4 S[16];
#pragma unroll
    for (int i = 0; i < 16; ++i) S[i] = (f32x4){0.f, 0.f, 0.f, 0.f};
    for (int p = wid; p < 73; p += 8)
        __builtin_amdgcn_global_load_lds((const unsigned*)(blk0 + (size_t)p * 1024 + lane * 16), (LAS unsigned*)(F.lds + p * 1024), 16, 0, 0);
    bf16x8 vf[2], vn[2];
    vf[0] = *(const bf16x8*)(vt); vf[1] = *(const bf16x8*)(vt + 32);
    vn[0] = vf[0]; vn[1] = vf[1];
    VM_WAIT(); __syncthreads();
    for (int n = 0; n < 64; ++n) {
        LAS unsigned char* buf = F.lds + (n & 1) * GLA_BLK;
        if (n < 63) {
            const unsigned char* nb = blk0 + (size_t)(n + 1) * GLA_BLK; LAS unsigned char* dst = F.lds + ((n + 1) & 1) * GLA_BLK;
            for (int p = wid; p < 73; p += 8)
                __builtin_amdgcn_global_load_lds((const unsigned*)(nb + (size_t)p * 1024 + lane * 16), (LAS unsigned*)(dst + p * 1024), 16, 0, 0);
            vn[0] = *(const bf16x8*)(vt + 64 * (n + 1)); vn[1] = *(const bf16x8*)(vt + 64 * (n + 1) + 32);
        }
        f32x4 o[4];
#pragma unroll
        for (int mb = 0; mb < 4; ++mb) o[mb] = (f32x4){0.f, 0.f, 0.f, 0.f};
#pragma unroll
        for (int kk = 0; kk < 8; ++kk) {
            u32x4 bw; bw.x = pk2(S[2 * kk][0], S[2 * kk][1]); bw.y = pk2(S[2 * kk][2], S[2 * kk][3]); bw.z = pk2(S[2 * kk + 1][0], S[2 * kk + 1][1]); bw.w = pk2(S[2 * kk + 1][2], S[2 * kk + 1][3]);
            const bf16x8 bfr = __builtin_bit_cast(bf16x8, bw);
#pragma unroll
            for (int mb = 0; mb < 4; ++mb) { const bf16x8 af = *(const LAS bf16x8*)(buf + ((mb * 8 + kk) * 64 + lane) * 16);
                o[mb] = __builtin_amdgcn_mfma_f32_16x16x32_bf16(af, bfr, o[mb], 0, 0, 0); }
        }
#pragma unroll
        for (int kk = 0; kk < 2; ++kk)
#pragma unroll
            for (int mb = 0; mb < 4; ++mb) { const bf16x8 af = *(const LAS bf16x8*)(buf + 65536 + ((mb * 2 + kk) * 64 + lane) * 16);
                o[mb] = __builtin_amdgcn_mfma_f32_16x16x32_bf16(af, vf[kk], o[mb], 0, 0, 0); }
        {
            bf16_t* op = og + (size_t)(64 * n) * 2048;
#pragma unroll
            for (int mb = 0; mb < 4; ++mb)
#pragma unroll
                for (int j = 0; j < 4; ++j) op[(size_t)(16 * mb + 4 * fq + j) * 2048] = (bf16_t)f2bf(o[mb][j]);
        }
#pragma unroll
        for (int mb = 0; mb < 16; ++mb) {
            const f32x4 dc = *(const LAS f32x4*)(buf + 73728 + (16 * mb + 4 * fq) * 4);
            S[mb] = S[mb] * dc;
#pragma unroll
            for (int kk = 0; kk < 2; ++kk) { const bf16x8 af = *(const LAS bf16x8*)(buf + 32768 + ((mb * 2 + kk) * 64 + lane) * 16);
                S[mb] = __builtin_amdgcn_mfma_f32_16x16x32_bf16(af, vf[kk], S[mb], 0, 0, 0); }
        }
        vf[0] = vn[0]; vf[1] = vn[1];
        VM_WAIT(); __syncthreads();
    }
}

struct VwSched {
    const char *wxa, *kvm; int G, c;
    __device__ __forceinline__ bool next(int i, gg::Unit& u) const {
        const long L = (long)i * G + c; if (L >= 256) return false;
        const int bh = (int)(L >> 4), pm = (int)(L & 15), b = bh >> 2, h = bh & 3;
        u.kind = 0; u.pm = b * 16 + pm; u.pn = h; u.aux = 0;
        u.A = wxa + ((size_t)(pm * 256) * 2048 + h * 512) * 2; u.B = kvm + ((size_t)(b * 256) * 4096 + 2048 + h * 512) * 2; return true;
    }
};
struct VwEpi {
    bf16_t* vwt;
    __device__ __forceinline__ int nst(const gg::Unit& u) const { return 16; }
    __device__ __forceinline__ bool operator()(gg::Acc& acc, const gg::Unit& u, int wr, int wc, int fr, int fq, int wid, int lane) const {
        gg::store_bf16_tile(acc, vwt, 2048, u.pm * 256, u.pn * 256, wr, wc, fr, fq); return true;
    }
};

__device__ __forceinline__ void gla_post_phase(Frame& F, const Args& a) {
    unsigned char* ws = F.ws;
    const int gw = F.bid * 8 + F.wave, NGW = F.G * 8, lane = F.lane;
    const float* gn = a.in[6];
    const f32x4 g0 = *(const f32x4*)(gn + lane * 8), g1 = *(const f32x4*)(gn + lane * 8 + 4);
    for (int t = gw; t < T; t += NGW) {
        const u32x4* orow = (const u32x4*)((const bf16_t*)(ws + WS_OG) + (size_t)t * 2048); u32x4* rrow = (u32x4*)((bf16_t*)(ws + WS_RG) + (size_t)t * 2048);
#pragma unroll
        for (int h = 0; h < 4; ++h) {
            const u32x4 ov = orow[h * 64 + lane], rv = rrow[h * 64 + lane];
            float o[8] = {bflo(ov.x), bfhi(ov.x), bflo(ov.y), bfhi(ov.y), bflo(ov.z), bfhi(ov.z), bflo(ov.w), bfhi(ov.w)};
            float r[8] = {bflo(rv.x), bfhi(rv.x), bflo(rv.y), bfhi(rv.y), bflo(rv.z), bfhi(rv.z), bflo(rv.w), bfhi(rv.w)};
            float s = 0.f;
#pragma unroll
            for (int j = 0; j < 8; ++j) s += o[j] * o[j];
            const float rstd = rsqrtf(wave_sum(s) * (1.f / 512.f) + EPS);
            const float gv[8] = {g0.x, g0.y, g0.z, g0.w, g1.x, g1.y, g1.z, g1.w};
            float y[8];
#pragma unroll
            for (int j = 0; j < 8; ++j) y[j] = o[j] * rstd * gv[j] * (r[j] * fast_sigmoid(r[j]));
            u32x4 w; w.x = pk2(y[0], y[1]); w.y = pk2(y[2], y[3]); w.z = pk2(y[4], y[5]); w.w = pk2(y[6], y[7]);
            rrow[h * 64 + lane] = w;
        }
    }
}

struct MgSched {
    const char *a0, *a1, *a2, *wbr, *vwt; int G, c;
    __device__ __forceinline__ bool next(int i, gg::Unit& u) const {
        const int ti = i / 3, br = i - 3 * ti; int pm, pn;
        if (!gg::tile_order((long)ti * G + c, 64, 16, pm, pn)) return false;
        u.kind = br; u.pm = pm; u.pn = pn; u.aux = br == 2 ? 16 : 32;
        const char* ab = br == 0 ? a0 : (br == 1 ? a1 : a2);
        u.A = ab + (size_t)pm * 256 * 2048 * 2;
        u.B = br == 2 ? vwt + ((size_t)((pm >> 4) * 4096 + pn * 256) * 2048) * 2 : wbr + (size_t)br * 16 * MiB + (size_t)pn * 256 * 2048 * 2; return true;
    }
};
struct MgEpi {
    const bf16_t* gt; bf16_t* merged;
    __device__ __forceinline__ int nst(const gg::Unit& u) const { return u.kind == 2 ? 16 : 0; }
    __device__ __forceinline__ bool operator()(gg::Acc& acc, const gg::Unit& u, int wr, int wc, int fr, int fq, int wid, int lane) const {
        const int br = u.kind;
#pragma unroll
        for (int ai = 0; ai < 2; ++ai) {
            u32x4 ga[4][2], gb[4][2];
#pragma unroll
            for (int m = 0; m < 4; ++m) { const size_t row = (size_t)(u.pm * 256 + ai * 128 + wr * 64 + m * 16 + fr);
#pragma unroll
                for (int bj = 0; bj < 2; ++bj) { const int col = u.pn * 256 + bj * 128 + wc * 32 + 8 * fq;
                    ga[m][bj] = *(const u32x4*)(gt + row * 12288 + br * 4096 + col);
                    gb[m][bj] = (br < 2) ? *(const u32x4*)(gt + row * 12288 + (br + 1) * 4096 + col) : (u32x4){0x3f803f80u, 0x3f803f80u, 0x3f803f80u, 0x3f803f80u}; } }
#pragma unroll
            for (int m = 0; m < 4; ++m) { const size_t row = (size_t)(u.pm * 256 + ai * 128 + wr * 64 + m * 16 + fr);
#pragma unroll
                for (int bj = 0; bj < 2; ++bj) { const int col = u.pn * 256 + bj * 128 + wc * 32 + 8 * fq;
                    const u32x4 a4 = ga[m][bj], b4 = gb[m][bj];
                    float g[8] = {bflo(a4.x), bfhi(a4.x), bflo(a4.y), bfhi(a4.y), bflo(a4.z), bfhi(a4.z), bflo(a4.w), bfhi(a4.w)};
                    if (br < 2) { const float d[8] = {bflo(b4.x), bfhi(b4.x), bflo(b4.y), bfhi(b4.y), bflo(b4.z), bfhi(b4.z), bflo(b4.w), bfhi(b4.w)};
#pragma unroll
                        for (int j = 0; j < 8; ++j) g[j] = d[j] * __builtin_amdgcn_rcpf(g[j]); }
                    else {
#pragma unroll
                        for (int j = 0; j < 8; ++j) g[j] = __builtin_amdgcn_rcpf(g[j]); }
                    f32x4 v0 = acc[ai][bj][m][0], v1 = acc[ai][bj][m][1];
                    v0[0] *= g[0]; v0[1] *= g[1]; v0[2] *= g[2]; v0[3] *= g[3]; v1[0] *= g[4]; v1[1] *= g[5]; v1[2] *= g[6]; v1[3] *= g[7];
                    if (br < 2) { acc[ai][bj][m][0] = v0; acc[ai][bj][m][1] = v1; }
                    else { u32x4 w; w.x = pk2(v0[0], v0[1]); w.y = pk2(v0[2], v0[3]); w.z = pk2(v1[0], v1[1]); w.w = pk2(v1[2], v1[3]);
                        *(u32x4*)(merged + row * D + col) = w; } } }
        }
        return br == 2;
    }
};

struct GridSched {
    const char *A, *B; int nM, nN, lda2, ldb2, G, c;
    __device__ __forceinline__ bool next(int i, gg::Unit& u) const {
        int pm, pn; if (!gg::tile_order((long)i * G + c, nM, nN, pm, pn)) return false;
        u.kind = 0; u.pm = pm; u.pn = pn; u.aux = 0; u.A = A + (size_t)pm * 256 * lda2; u.B = B + (size_t)pn * 256 * ldb2; return true;
    }
};
struct ResEpi {
    const float* x; bf16_t* x1b;
    __device__ __forceinline__ int nst(const gg::Unit& u) const { return 16; }
    __device__ __forceinline__ bool operator()(gg::Acc& acc, const gg::Unit& u, int wr, int wc, int fr, int fq, int wid, int lane) const {
#pragma unroll
        for (int ai = 0; ai < 2; ++ai) {
            f32x4 xv[4][2][2];
#pragma unroll
            for (int m = 0; m < 4; ++m) { const size_t off = (size_t)(u.pm * 256 + ai * 128 + wr * 64 + m * 16 + fr) * D + u.pn * 256 + wc * 32 + 8 * fq;
#pragma unroll
                for (int bj = 0; bj < 2; ++bj) { xv[m][bj][0] = *(const f32x4*)(x + off + bj * 128); xv[m][bj][1] = *(const f32x4*)(x + off + bj * 128 + 4); } }
#pragma unroll
            for (int m = 0; m < 4; ++m) { const size_t off = (size_t)(u.pm * 256 + ai * 128 + wr * 64 + m * 16 + fr) * D + u.pn * 256 + wc * 32 + 8 * fq;
#pragma unroll
                for (int bj = 0; bj < 2; ++bj) { const f32x4 v0 = xv[m][bj][0] + acc[ai][bj][m][0], v1 = xv[m][bj][1] + acc[ai][bj][m][1];
                    u32x4 w; w.x = pk2(v0[0], v0[1]); w.y = pk2(v0[2], v0[3]); w.z = pk2(v1[0], v1[1]); w.w = pk2(v1[2], v1[3]);
                    *(u32x4*)(x1b + off + bj * 128) = w; } }
        }
        return true;
    }
};
struct PqEpi {
    bf16_t* o; const float* rs; const float* cs;
    __device__ __forceinline__ int nst(const gg::Unit& u) const { return 16; }
    __device__ __forceinline__ bool operator()(gg::Acc& acc, const gg::Unit& u, int wr, int wc, int fr, int fq, int wid, int lane) const {
        const int row0 = u.pm * 256, col0 = u.pn * 256;
        float rvv[2][4]; f32x4 cv[2][2];
#pragma unroll
        for (int ai = 0; ai < 2; ++ai)
#pragma unroll
            for (int m = 0; m < 4; ++m) rvv[ai][m] = rs[row0 + ai * 128 + wr * 64 + m * 16 + fr];
#pragma unroll
        for (int bj = 0; bj < 2; ++bj) { const float* cp = cs + col0 + bj * 128 + wc * 32 + 8 * fq; cv[bj][0] = *(const f32x4*)cp; cv[bj][1] = *(const f32x4*)(cp + 4); }
#pragma unroll
        for (int bj = 0; bj < 2; ++bj) { const f32x4 c0v = cv[bj][0], c1v = cv[bj][1];
#pragma unroll
            for (int ai = 0; ai < 2; ++ai)
#pragma unroll
                for (int m = 0; m < 4; ++m) { const int r = row0 + ai * 128 + wr * 64 + m * 16 + fr; const float rv = rvv[ai][m];
                    const i32x4 i0 = __builtin_bit_cast(i32x4, acc[ai][bj][m][0]), i1 = __builtin_bit_cast(i32x4, acc[ai][bj][m][1]);
                    const f32x4 v0 = (f32x4){(float)i0[0], (float)i0[1], (float)i0[2], (float)i0[3]} * (c0v * rv), v1 = (f32x4){(float)i1[0], (float)i1[1], (float)i1[2], (float)i1[3]} * (c1v * rv);
                    u32x4 w; w.x = pk2(v0[0], v0[1]); w.y = pk2(v0[2], v0[3]); w.z = pk2(v1[0], v1[1]); w.w = pk2(v1[2], v1[3]);
                    *(u32x4*)(o + (size_t)r * 2048 + col0 + bj * 128 + wc * 32 + 8 * fq) = w; } }
        return true;
    }
};
struct Bf16Epi {
    bf16_t* o; int ldc;
    __device__ __forceinline__ int nst(const gg::Unit& u) const { return 16; }
    __device__ __forceinline__ bool operator()(gg::Acc& acc, const gg::Unit& u, int wr, int wc, int fr, int fq, int wid, int lane) const {
        gg::store_bf16_tile(acc, o, ldc, u.pm * 256, u.pn * 256, wr, wc, fr, fq); return true;
    }
};

__device__ __forceinline__ int f2ord(float f) { const int b = __float_as_int(f); return b ^ ((b >> 31) & 0x7fffffff); }
__device__ __forceinline__ float ord2f(int o) { return __int_as_float(o ^ ((o >> 31) & 0x7fffffff)); }
__device__ __forceinline__ void cex_desc(int& hi, int& lo) { const int a = hi, b = lo; hi = a > b ? a : b; lo = a > b ? b : a; }
__device__ __forceinline__ void bsort16_desc(int (&a)[16]) {
#pragma unroll
    for (int k = 2; k <= 16; k <<= 1)
#pragma unroll
        for (int j = k >> 1; j > 0; j >>= 1)
#pragma unroll
            for (int i = 0; i < 16; ++i) { const int l = i ^ j; if (l > i) { if ((i & k) == 0) cex_desc(a[i], a[l]); else cex_desc(a[l], a[i]); } }
}
__device__ __forceinline__ void bmerge16_desc(int (&a)[16]) {
#pragma unroll
    for (int j = 8; j > 0; j >>= 1)
#pragma unroll
        for (int i = 0; i < 16; ++i) { const int l = i ^ j; if (l > i) cex_desc(a[i], a[l]); }
}
__device__ __forceinline__ void top16_merge(int (&a)[16], const int (&b)[16]) {
#pragma unroll
    for (int i = 0; i < 16; ++i) a[i] = a[i] > b[15 - i] ? a[i] : b[15 - i];
    bmerge16_desc(a);
}
constexpr int RT_SKROW = 272;
constexpr int RT_SK = 2 * 128 * RT_SKROW;
__device__ __forceinline__ void route_topk16(const f32x4 (&acc)[8], int fq, int (&res)[16]) {
    int a[16], b[16];
#pragma unroll
    for (int mb = 0; mb < 4; ++mb)
#pragma unroll
        for (int j = 0; j < 4; ++j) { a[mb * 4 + j] = (f2ord(acc[mb][j]) & ~127) | (127 - (16 * mb + 4 * fq + j)); b[mb * 4 + j] = (f2ord(acc[mb + 4][j]) & ~127) | (127 - (16 * (mb + 4) + 4 * fq + j)); }
    bsort16_desc(a); bsort16_desc(b); top16_merge(a, b);
#pragma unroll
    for (int x = 16; x <= 32; x <<= 1) {
#pragma unroll
        for (int i = 0; i < 16; ++i) b[i] = __shfl_xor(a[i], x);
        top16_merge(a, b);
    }
#pragma unroll
    for (int i = 0; i < 16; ++i) res[i] = a[i];
}
__device__ __forceinline__ void route_job(Frame& F, const Args& a, int job) {
    unsigned char* ws = F.ws;
    const int tid = F.tid, lane = F.lane, wid = F.wave, fr = lane & 15, fq = lane >> 4;
    const int h = job & 7, chunk = job >> 3;
    const bf16_t* pq = (const bf16_t*)(ws + WS_PQ); const bf16_t* sk = (const bf16_t*)(ws + WS_SUBK) + (size_t)h * 2 * 128 * 128;
    for (int p = tid; p < 4096; p += 512) { const int row = p >> 4, pc = p & 15; *(LAS u32x4*)(F.lds + row * RT_SKROW + pc * 16) = ((const u32x4*)sk)[p]; }
    __syncthreads();
    LAS int* IX = (LAS int*)(F.lds + RT_SK) + wid * 512;
#pragma unroll 1
    for (int it = 0; it < 4; ++it) {
        const int tok0 = (chunk * 32 + wid * 4 + it) * 16;
        int top[2][16];
#pragma unroll
        for (int c = 0; c < 2; ++c) {
            f32x4 acc[8];
#pragma unroll
            for (int mb = 0; mb < 8; ++mb) acc[mb] = (f32x4){0.f, 0.f, 0.f, 0.f};
            bf16x8 bfr[4];
#pragma unroll
            for (int kk = 0; kk < 4; ++kk) bfr[kk] = *(const bf16x8*)(pq + (size_t)(tok0 + fr) * 2048 + h * 256 + c * 128 + 32 * kk + 8 * fq);
#pragma unroll
            for (int kk = 0; kk < 4; ++kk)
#pragma unroll
                for (int mb = 0; mb < 8; ++mb) { const bf16x8 af = *(const LAS bf16x8*)(F.lds + (c * 128 + 16 * mb + fr) * RT_SKROW + (32 * kk + 8 * fq) * 2);
                    acc[mb] = __builtin_amdgcn_mfma_f32_16x16x32_bf16(af, bfr[kk], acc[mb], 0, 0, 0); }
            route_topk16(acc, fq, top[c]);
        }
        float f0[16], f1[16];
#pragma unroll
        for (int i = 0; i < 16; ++i) { f0[i] = ord2f(top[0][i] & ~127); f1[i] = ord2f(top[1][i] & ~127); }
        int g[4][16];
#pragma unroll
        for (int q = 0; q < 4; ++q)
#pragma unroll
            for (int i = 0; i < 16; ++i) g[q][i] = (int)0x80000000;
        {
            int nc = 0;
#pragma unroll
            for (int i = 0; i < 16; ++i)
#pragma unroll
                for (int j = 0; j < 16; ++j) if ((i + 1) * (j + 1) <= 16) { g[nc >> 4][nc & 15] = (f2ord(f0[i] + f1[j]) & ~255) | (255 - (i * 16 + j)); ++nc; }
        }
        bsort16_desc(g[0]); bsort16_desc(g[1]); bsort16_desc(g[2]); bsort16_desc(g[3]);
        top16_merge(g[0], g[1]); top16_merge(g[2], g[3]); top16_merge(g[0], g[2]);
        if (fq == 0) {
#pragma unroll
            for (int i = 0; i < 16; ++i) { IX[fr * 32 + i] = 127 - (top[0][i] & 127); IX[fr * 32 + 16 + i] = 127 - (top[1][i] & 127); }
        }
        LDS_WAIT(); asm volatile("" ::: "memory");
        if (fq == 0) {
            const float vmax = ord2f(g[0][0] & ~255); float e[16]; float s = 0.f; int ex[16];
#pragma unroll
            for (int r = 0; r < 16; ++r) { e[r] = __expf(ord2f(g[0][r] & ~255) - vmax); s += e[r]; const int ij = 255 - (g[0][r] & 255); ex[r] = IX[fr * 32 + (ij >> 4)] * 128 + IX[fr * 32 + 16 + (ij & 15)]; }
            const float inv = 1.0f / s;
            int* eidx = (int*)(ws + WS_EIDX) + (size_t)(tok0 + fr) * 128 + h * 16; float* gw = (float*)(ws + WS_GW) + (size_t)(tok0 + fr) * 128 + h * 16;
#pragma unroll
            for (int q = 0; q < 4; ++q) { *(u32x4*)(eidx + 4 * q) = (u32x4){(unsigned)ex[4 * q], (unsigned)ex[4 * q + 1], (unsigned)ex[4 * q + 2], (unsigned)ex[4 * q + 3]};
                *(f32x4*)(gw + 4 * q) = (f32x4){e[4 * q] * inv, e[4 * q + 1] * inv, e[4 * q + 2] * inv, e[4 * q + 3] * inv}; }
        }
        LDS_WAIT(); asm volatile("" ::: "memory");
    }
    __syncthreads();
}

__device__ __forceinline__ float ub0(unsigned w) { return (float)(w & 255u); }
__device__ __forceinline__ float ub1(unsigned w) { return (float)((w >> 8) & 255u); }
__device__ __forceinline__ float ub2(unsigned w) { return (float)((w >> 16) & 255u); }
__device__ __forceinline__ float ub3(unsigned w) { return (float)(w >> 24); }
#define P10_LOADU(buf, kbase) do { _Pragma("unroll") for (int r = 0; r < 4; ++r) { const int k_ = (kbase) + r; const int e_ = __builtin_amdgcn_readlane(k_ < 64 ? ev0 : ev1, k_ & 63); \
        const u32x4* rp_ = (const u32x4*)(ub + (size_t)e_ * 2048); buf[r][0] = rp_[lane]; buf[r][1] = rp_[64 + lane]; } } while (0)
#define P10_COMPU(buf, kbase) do { _Pragma("unroll") for (int r = 0; r < 4; ++r) { int s_ = 0; \
        _Pragma("unroll") for (int p = 0; p < 2; ++p) { const unsigned x0 = buf[r][p].x, x1 = buf[r][p].y, x2 = buf[r][p].z, x3 = buf[r][p].w; \
            s_ = __builtin_amdgcn_sdot4((int)(x0 & 0x0F0F0F0Fu), (int)hv[p][0].x, s_, false); s_ = __builtin_amdgcn_sdot4((int)((x0 >> 4) & 0x0F0F0F0Fu), (int)hv[p][0].y, s_, false); \
            s_ = __builtin_amdgcn_sdot4((int)(x1 & 0x0F0F0F0Fu), (int)hv[p][0].z, s_, false); s_ = __builtin_amdgcn_sdot4((int)((x1 >> 4) & 0x0F0F0F0Fu), (int)hv[p][0].w, s_, false); \
            s_ = __builtin_amdgcn_sdot4((int)(x2 & 0x0F0F0F0Fu), (int)hv[p][1].x, s_, false); s_ = __builtin_amdgcn_sdot4((int)((x2 >> 4) & 0x0F0F0F0Fu), (int)hv[p][1].y, s_, false); \
            s_ = __builtin_amdgcn_sdot4((int)(x3 & 0x0F0F0F0Fu), (int)hv[p][1].z, s_, false); s_ = __builtin_amdgcn_sdot4((int)((x3 >> 4) & 0x0F0F0F0Fu), (int)hv[p][1].w, s_, false); } \
        _Pragma("unroll") for (int o_ = 1; o_ < 64; o_ <<= 1) s_ += __shfl_xor(s_, o_); \
        const int k_ = (kbase) + r; const float av_ = (float)s_; if (k_ < 64) { if (lane == k_) a0 = av_; } else { if (lane == k_ - 64) a1 = av_; } } } while (0)
#define P10_LOADV(buf, kbase) do { _Pragma("unroll") for (int r = 0; r < 4; ++r) { const int k_ = (kbase) + r; const int e_ = __builtin_amdgcn_readlane(k_ < 64 ? ev0 : ev1, k_ & 63); \
        const u32x4* rp_ = (const u32x4*)(vb + (size_t)e_ * 2048); buf[r][0] = rp_[lane]; buf[r][1] = rp_[64 + lane]; } } while (0)
#define P10_COMPV(buf, grp) do { const int wq_ = __builtin_amdgcn_readlane(wqv, (grp)); \
        _Pragma("unroll") for (int p = 0; p < 2; ++p) { const unsigned xr_[4][4] = {{buf[0][p].x, buf[0][p].y, buf[0][p].z, buf[0][p].w}, {buf[1][p].x, buf[1][p].y, buf[1][p].z, buf[1][p].w}, {buf[2][p].x, buf[2][p].y, buf[2][p].z, buf[2][p].w}, {buf[3][p].x, buf[3][p].y, buf[3][p].z, buf[3][p].w}}; \
            _Pragma("unroll") for (int d = 0; d < 4; ++d) { int* oo = o + 32 * p + 8 * d; \
                _Pragma("unroll") for (int h = 0; h < 2; ++h) { \
                    const unsigned b0 = (xr_[0][d] >> (4 * h)) & 0x0F0F0F0Fu, b1 = (xr_[1][d] >> (4 * h)) & 0x0F0F0F0Fu, b2 = (xr_[2][d] >> (4 * h)) & 0x0F0F0F0Fu, b3 = (xr_[3][d] >> (4 * h)) & 0x0F0F0F0Fu; \
                    const unsigned a01 = __builtin_amdgcn_perm(b1, b0, 0x05010400u), c01 = __builtin_amdgcn_perm(b1, b0, 0x07030602u), a23 = __builtin_amdgcn_perm(b3, b2, 0x05010400u), c23 = __builtin_amdgcn_perm(b3, b2, 0x07030602u); \
                    const unsigned t0 = __builtin_amdgcn_perm(a23, a01, 0x05040100u), t1 = __builtin_amdgcn_perm(a23, a01, 0x07060302u), t2 = __builtin_amdgcn_perm(c23, c01, 0x05040100u), t3 = __builtin_amdgcn_perm(c23, c01, 0x07060302u); \
                    oo[0 + h] = __builtin_amdgcn_sdot4((int)t0, wq_, oo[0 + h], false); oo[2 + h] = __builtin_amdgcn_sdot4((int)t1, wq_, oo[2 + h], false); \
                    oo[4 + h] = __builtin_amdgcn_sdot4((int)t2, wq_, oo[4 + h], false); oo[6 + h] = __builtin_amdgcn_sdot4((int)t3, wq_, oo[6 + h], false); } } } } while (0)
__device__ __forceinline__ void peer_token_wave(const Args& a, unsigned char* ws, int tok, int lane) {
    const int* eidx = (const int*)(ws + WS_EIDX) + (size_t)tok * 128; const float* gw = (const float*)(ws + WS_GW) + (size_t)tok * 128;
    const int ev0 = eidx[lane], ev1 = eidx[64 + lane];
    u32x4 hv[2][2];
    const u32x4* hrow = (const u32x4*)(ws + WS_H8 + (size_t)tok * D);
#pragma unroll
    for (int p = 0; p < 2; ++p) { hv[p][0] = hrow[128 * p + 2 * lane]; hv[p][1] = hrow[128 * p + 2 * lane + 1]; }
    const float sh = ((const float*)(ws + WS_SH))[tok], shs = ((const float*)(ws + WS_SHS))[tok];
    const unsigned char* ub = ws + WS_UB; const float* su = (const float*)(ws + WS_SU); const float* sv = (const float*)(ws + WS_SV);
    float a0 = 0.f, a1 = 0.f;
    {
        u32x4 ua[4][2], uc[4][2];
        P10_LOADU(ua, 0);
#pragma unroll 1
        for (int kb = 0; kb < 128; kb += 8) {
            P10_LOADU(uc, kb + 4);
            P10_COMPU(ua, kb);
            P10_LOADU(ua, (kb + 8) & 127);
            P10_COMPU(uc, kb + 4);
        }
    }
    float w0, w1;
    { const float x0 = (a0 - 8.0f * shs) * su[ev0] * sh, x1 = (a1 - 8.0f * shs) * su[ev1] * sh;
      w0 = gw[lane] * 0.5f * x0 * (1.0f + erff(x0 * 0.70710678118f)) * sv[ev0]; w1 = gw[64 + lane] * 0.5f * x1 * (1.0f + erff(x1 * 0.70710678118f)) * sv[ev1]; }
    const float wmax = fmaxf(wave_max(fmaxf(fabsf(w0), fabsf(w1))), 1e-30f), sw = wmax * (1.0f / 127.0f), winv = 127.0f / wmax;
    const int q0 = (int)rintf(w0 * winv), q1 = (int)rintf(w1 * winv);
    int qsum = q0 + q1;
#pragma unroll
    for (int o_ = 1; o_ < 64; o_ <<= 1) qsum += __shfl_xor(qsum, o_);
    int wqv;
    { const int base = (lane & 15) * 4;
      const int s0 = __shfl(lane < 16 ? q0 : q1, base + 0), s1 = __shfl(lane < 16 ? q0 : q1, base + 1), s2 = __shfl(lane < 16 ? q0 : q1, base + 2), s3 = __shfl(lane < 16 ? q0 : q1, base + 3);
      const int a0_ = __shfl(q0, base + 0), a1_ = __shfl(q0, base + 1), a2_ = __shfl(q0, base + 2), a3_ = __shfl(q0, base + 3);
      const int b0_ = __shfl(q1, base + 0), b1_ = __shfl(q1, base + 1), b2_ = __shfl(q1, base + 2), b3_ = __shfl(q1, base + 3);
      (void)s0; (void)s1; (void)s2; (void)s3;
      const bool lowhalf = (lane & 31) < 16;
      const int c0 = lowhalf ? a0_ : b0_, c1 = lowhalf ? a1_ : b1_, c2 = lowhalf ? a2_ : b2_, c3 = lowhalf ? a3_ : b3_;
      wqv = (c0 & 255) | ((c1 & 255) << 8) | ((c2 & 255) << 16) | ((c3 & 255) << 24); }
    int o[64];
#pragma unroll
    for (int j = 0; j < 64; ++j) o[j] = 0;
    const unsigned char* vb = ws + WS_VB;
    {
        u32x4 va[4][2], vc[4][2];
        P10_LOADV(va, 0);
#pragma unroll 1
        for (int kb = 0; kb < 128; kb += 8) {
            P10_LOADV(vc, kb + 4);
            P10_COMPV(va, kb >> 2);
            P10_LOADV(va, (kb + 8) & 127);
            P10_COMPV(vc, (kb >> 2) + 1);
        }
    }
    float* orow = a.out + (size_t)tok * D; const bf16_t* xrow = (const bf16_t*)(ws + WS_X1B) + (size_t)tok * D; float s = 0.f; const int corr = 8 * qsum; float y[64];
#pragma unroll
    for (int p = 0; p < 2; ++p)
#pragma unroll
        for (int q = 0; q < 8; ++q) { const u32x2 xu = *(const u32x2*)(xrow + 2048 * p + 32 * lane + 4 * q); const f32x4 x = (f32x4){bflo(xu.x), bfhi(xu.x), bflo(xu.y), bfhi(xu.y)}; const int* oo = o + 32 * p + 4 * q; float* yy = y + 32 * p + 4 * q;
            yy[0] = x.x + sw * (float)(oo[0] - corr); yy[1] = x.y + sw * (float)(oo[1] - corr); yy[2] = x.z + sw * (float)(oo[2] - corr); yy[3] = x.w + sw * (float)(oo[3] - corr);
            s += (yy[0] * yy[0] + yy[1] * yy[1]) + (yy[2] * yy[2] + yy[3] * yy[3]); }
    const float rstd = rsqrtf(wave_sum(s) * (1.f / D) + EPS);
#pragma unroll
    for (int p = 0; p < 2; ++p)
#pragma unroll
        for (int q = 0; q < 8; ++q) { const f32x4 g = *(const f32x4*)(a.in[20] + 2048 * p + 32 * lane + 4 * q); const float* yy = y + 32 * p + 4 * q;
            *(f32x4*)(orow + 2048 * p + 32 * lane + 4 * q) = (f32x4){yy[0] * rstd * g.x, yy[1] * rstd * g.y, yy[2] * rstd * g.z, yy[3] * rstd * g.w}; }
}

__global__ void __launch_bounds__(512, 2) mega_fwd(Args args) {
    extern __shared__ __attribute__((aligned(16))) unsigned char lds_raw[];
    Frame F;
    F.lds = (LAS unsigned char*)lds_raw;
    F.tid = threadIdx.x; F.lane = F.tid & 63; F.wave = __builtin_amdgcn_readfirstlane(F.tid >> 6);
    F.G = gridDim.x; F.bid = blockIdx.x; F.ws = args.ws;
    unsigned char* ws = args.ws;
    if (F.tid < 64) ((LAS unsigned*)(F.lds + LDS_MISC))[F.tid] = 0u;
    __syncthreads();
    XcdBarrier bar = xcd_barrier_post((unsigned*)(ws + WS_CTL) + 4096, (volatile LAS unsigned*)(F.lds + LDS_MISC + 32));

    F.refresh();
    p0_weights8(F, args);
    F.refresh();
    p0_prologue_a(F, args);
    xcd_barrier(bar);
    {
        P1Sched S{(const char*)(ws + WS_HN), (const char*)(ws + WS_W8), (const char*)(ws + WS_WAL), (const char*)(ws + WS_MEMN), (const char*)(ws + WS_WKV), F.G, F.bid};
        P1Epi E{ws, args.in[12]};
        gg::gemm_phase<0>(F.lds, D * 2, D * 2, 64, S, E);
        I8Sched S8{(const char*)(ws + WS_HN8), (const char*)(ws + WS_W8), F.G, F.bid};
        I8Epi E8{ws, args.in[12]};
        gg::gemm_phase<2, true>(F.lds, D, D, 32, S8, E8);
        xcd_barrier(bar);
    }
    F.refresh();
    for (int u = F.bid; u < 512; u += F.G) gla_prep_unit(F, args, u);
    {
        WkSched Sk{(const char*)(ws + WS_KVM), (const char*)(ws + WS_WQX), F.G, F.bid};
        WkEpi Ek{(bf16_t*)(ws + WS_WKT)};
        gg::gemm_phase<0>(F.lds, 8192, 4096, 8, Sk, Ek);
        VwSched Sv{(const char*)(ws + WS_WBR + 32 * MiB), (const char*)(ws + WS_KVM), F.G, F.bid};
        VwEpi Ev{(bf16_t*)(ws + WS_VWT)};
        gg::gemm_phase<0>(F.lds, 4096, 8192, 8, Sv, Ev);
    }
    xcd_barrier(bar);
    F.refresh();
    {
        {
            XsSched S{(const char*)(ws + WS_HN), (const char*)(ws + WS_WKT), F.G, F.bid};
            XsEpi E{(bf16_t*)(ws + WS_PROB), F.lds + LDS_EX};
            gg::gemm_phase<0>(F.lds, D * 2, D * 2, 64, S, E);
        }
        const int nscan = F.G >= 128 ? 64 : 0;
        if (nscan) { if (F.bid < 64) gla_scan_unit(F, args, F.bid); }
        else for (int u = F.bid; u < 64; u += F.G) gla_scan_unit(F, args, u);
        { const int nq = nscan ? F.G - 64 : F.G, cq = nscan ? F.bid - 64 : F.bid;
          if (cq >= 0) for (int e = cq * 8 + F.wave; e < 16384; e += nq * 8) {
              quant_row_i4(args.in[18] + (size_t)e * D, ws + WS_UB + (size_t)e * 2048, (float*)(ws + WS_SU) + e, F.lane);
              quant_row_i4(args.in[19] + (size_t)e * D, ws + WS_VB + (size_t)e * 2048, (float*)(ws + WS_SV) + e, F.lane); }
          if (cq >= 0) conv_phase(F, args, cq, nq); }
    }
    xcd_barrier(bar);
    F.refresh();
    gla_post_phase(F, args);
    F.refresh();
    peer_wq_convert(F, args);
    xcd_barrier(bar);
    {
        MgSched S{(const char*)(ws + WS_RG), (const char*)(ws + WS_CB), (const char*)(ws + WS_PROB), (const char*)(ws + WS_WBR), (const char*)(ws + WS_VWT), F.G, F.bid};
        MgEpi E{(const bf16_t*)(ws + WS_GT), (bf16_t*)(ws + WS_MERGED)};
        gg::gemm_phase<0, true>(F.lds, 4096, 4096, 32, S, E);
    }
    xcd_barrier(bar);
    {
        GridSched S{(const char*)(ws + WS_MERGED), (const char*)(ws + WS_WO), 64, 16, D * 2, D * 2, F.G, F.bid};
        ResEpi E{args.in[0], (bf16_t*)(ws + WS_X1B)};
        gg::gemm_phase<0, true>(F.lds, D * 2, D * 2, 64, S, E);
    }
    xcd_barrier(bar);
    F.refresh();
    {
        const int gw = F.bid * 8 + F.wave, NGW = F.G * 8;
        for (int m = gw; m < T; m += NGW) rms_row_i8((const bf16_t*)(ws + WS_X1B) + (size_t)m * D, args.in[15], ws + WS_H8 + (size_t)m * D, (float*)(ws + WS_SH) + m, (float*)(ws + WS_SHS) + m, F.lane);
    }
    xcd_barrier(bar);
    {
        GridSched S{(const char*)(ws + WS_H8), (const char*)(ws + WS_WPQ), 64, 8, D, D, F.G, F.bid};
        PqEpi E{(bf16_t*)(ws + WS_PQ), (const float*)(ws + WS_SH), (const float*)(ws + WS_SWPQ)};
        gg::gemm_phase<2, true>(F.lds, D, D, 32, S, E);
    }
    xcd_barrier(bar);
    F.refresh();
    for (int u = F.bid; u < 256; u += F.G) route_job(F, args, u);
    xcd_barrier(bar);
    F.refresh();
    for (int tok = F.bid * 8 + F.wave; tok < T; tok += F.G * 8) peer_token_wave(args, ws, tok, F.lane);
}


extern "C" void kernel_launch(void* const* d_in, const int* in_sizes, int n_in, void* d_out, int out_size, void* d_ws, size_t ws_size, hipStream_t stream) {
    static int grid = 0;
    if (grid == 0) {
        if (n_in != 21 || ws_size < WS_END) { fprintf(stderr, "kernel_launch: unexpected inputs (n_in %d, ws %zu < %zu)\n", n_in, ws_size, (size_t)WS_END); grid = -1; return; }
        int dev = 0, cus = 0, per_cu = 0;
        if (hipGetDevice(&dev) != hipSuccess || hipDeviceGetAttribute(&cus, hipDeviceAttributeMultiprocessorCount, dev) != hipSuccess) { grid = -1; return; }
        if (hipFuncSetAttribute((const void*)mega_fwd, hipFuncAttributeMaxDynamicSharedMemorySize, LDS_BYTES) != hipSuccess) { fprintf(stderr, "kernel_launch: hipFuncSetAttribute failed\n"); grid = -1; return; }
        if (hipOccupancyMaxActiveBlocksPerMultiprocessor(&per_cu, (const void*)mega_fwd, 512, LDS_BYTES) != hipSuccess || per_cu < 1)
            fprintf(stderr, "kernel_launch: occupancy query says %d\n", per_cu);
        (void)hipGetLastError();
        grid = cus;
    }
    if (grid < 0) return;
    Args a{};
    for (int i = 0; i < 21; ++i) a.in[i] = (const float*)d_in[i];
    a.out = (float*)d_out; a.ws = (unsigned char*)d_ws;
    hipMemsetAsync((char*)d_ws + WS_CTL, 0, CTL_BYTES, stream);
    hipLaunchKernelGGL(mega_fwd, dim3(grid), dim3(512), LDS_BYTES, stream, a);
}
```

```cpp
#include <hip/hip_runtime.h>
#include <cstdio>
#include <cstdint>

#define LAS __attribute__((address_space(3)))
typedef unsigned short bf16_t;
typedef short bf16x8 __attribute__((ext_vector_type(8)));
typedef float f32x4 __attribute__((ext_vector_type(4)));
typedef float f32x2 __attribute__((ext_vector_type(2)));
typedef unsigned u32x4 __attribute__((ext_vector_type(4)));
typedef unsigned u32x2 __attribute__((ext_vector_type(2)));
typedef __bf16 bf16x2v __attribute__((ext_vector_type(2)));
typedef int i32x8 __attribute__((ext_vector_type(8)));
typedef int i32x4 __attribute__((ext_vector_type(4)));
typedef unsigned u32x8 __attribute__((ext_vector_type(8)));

constexpr int T = 16384, D = 4096, SEQ = 4096, NBATCH = 4, MEMT = 1024;
constexpr int NPAD = 26880;
constexpr int O_QG = 0, O_KG = 1024, O_VG = 2048, O_RG = 4096, O_CB = 6144, O_CC = 8192, O_CH = 10240, O_QX = 12288, O_GT = 14336, O_AL = 26624;
constexpr float EPS = 1e-6f;
constexpr int GLA_BLK = 74752;

#ifndef I8_MASK
#define I8_MASK 0x7f
#endif
constexpr int SEG_START[9] = {0, 2048, 4096, 6144, 8192, 10240, 12288, 14336, 26624};
constexpr int SEG_BIT[8] = {0, 1, 2, 3, 4, 5, -1, 6};
constexpr bool seg_i8(int s) { return SEG_BIT[s] >= 0 && ((I8_MASK >> SEG_BIT[s]) & 1); }
constexpr size_t seg_pitch(int s) { return SEG_BIT[s] < 0 ? 0 : (seg_i8(s) ? 4096 : 8192); }
constexpr size_t seg_off(int s) { size_t o = 0; for (int t = 0; t < s; ++t) o += (size_t)(SEG_START[t + 1] - SEG_START[t]) * seg_pitch(t); return o; }
constexpr bool V_I8 = seg_i8(1);
constexpr int count_tiles(bool want8) { int n = 0; for (int s = 0; s < 8; ++s) if (s != 1 && SEG_BIT[s] >= 0 && seg_i8(s) == want8) n += (SEG_START[s + 1] - SEG_START[s]) / 256; return n; }
constexpr int NT8 = count_tiles(true), NTB = count_tiles(false);
constexpr int NU_B = 64 * NTB + 64 + (V_I8 ? 0 : 512) + 64, NU_8 = 64 * NT8 + (V_I8 ? 512 : 0);
__device__ __forceinline__ size_t w_row_off(int n) {
    size_t o = 0;
#pragma unroll
    for (int s = 0; s < 8; ++s) if (n >= SEG_START[s] && n < SEG_START[s + 1]) o = seg_off(s) + (size_t)(n - SEG_START[s]) * seg_pitch(s);
    return o;
}
__device__ __forceinline__ bool w_row_is8(int n) {
    bool r = false;
#pragma unroll
    for (int s = 0; s < 8; ++s) if (n >= SEG_START[s] && n < SEG_START[s + 1]) r = seg_i8(s);
    return r;
}
__device__ __forceinline__ int map_tile(int idx, bool want8) {
    int t = 104;
#pragma unroll
    for (int s = 7; s >= 0; --s) { }
    int rem = idx; bool found = false;
#pragma unroll
    for (int s = 0; s < 8; ++s) { if (s == 1 || SEG_BIT[s] < 0 || seg_i8(s) != want8) continue; const int len = (SEG_START[s + 1] - SEG_START[s]) / 256;
        if (!found && rem < len) { t = SEG_START[s] / 256 + rem; found = true; } rem -= len; }
    return t;
}
constexpr size_t MiB = 1u << 20;
constexpr size_t WS_CTL = 0, CTL_BYTES = 1 * MiB;
constexpr size_t WS_MEMN = 1 * MiB, WS_KVM = 9 * MiB  , WS_ALR = 17 * MiB, WS_SUBK = 18 * MiB, WS_EIDX = 19 * MiB, WS_GW = 27 * MiB;
constexpr size_t WS_WBR = 64 * MiB  , WS_WO = 112 * MiB, WS_WPQ = 144 * MiB, WS_WKV = 160 * MiB;
constexpr size_t WS_UB = 192 * MiB, WS_VB = 224 * MiB;
constexpr size_t WS_HN8 = 320 * MiB;
constexpr size_t WS_W8 = 448 * MiB;
constexpr size_t WS_WAL = 56 * MiB;
constexpr size_t WS_SHN = 35 * MiB + 512 * 1024, WS_SW = 35 * MiB + 768 * 1024;
constexpr size_t WS_SWPQ = 35 * MiB + 896 * 1024;
constexpr size_t CTL_CMAXPQ = 384 * 1024;
constexpr size_t CTL_CMAX = 256 * 1024;
constexpr size_t WS_SU = 35 * MiB, WS_SV = WS_SU + 65536, WS_SH = WS_SV + 65536, WS_SHS = WS_SH + 65536;
constexpr size_t WS_H8 = 914 * MiB;
constexpr size_t WS_WTIN = 448 * MiB;
constexpr size_t WS_GLAB = 448 * MiB, WS_PROB = 521 * MiB  , WS_OG = 585 * MiB;
constexpr size_t WS_WQX = 40 * MiB;
constexpr size_t WS_WKT = 384 * MiB;
constexpr size_t WS_VWT = 320 * MiB;
constexpr size_t WS_HN = 658 * MiB;
constexpr size_t WS_MERGED = 658 * MiB;
constexpr size_t WS_X1B = 1042 * MiB;
constexpr size_t WS_QG = 786 * MiB, WS_KG = 818 * MiB, WS_VT = 850 * MiB, WS_RG = 914 * MiB, WS_CB = 978 * MiB, WS_CC = 1042 * MiB, WS_CH = 1106 * MiB, WS_QX = 1170 * MiB;
constexpr size_t WS_GT = 1234 * MiB;
constexpr size_t WS_HQ = 1234 * MiB, WS_PQ = 1362 * MiB;
constexpr size_t WS_END = 1618 * MiB;
static_assert(WS_GLAB + (size_t)16 * 64 * GLA_BLK <= WS_PROB, "gla blocks");

constexpr int LDS_BYTES = 163840;
constexpr int LDS_EX = 131072;
constexpr int LDS_MISC = LDS_BYTES - 256;

__device__ __forceinline__ float bf2f(unsigned b) { return __uint_as_float(b << 16); }
__device__ __forceinline__ float bflo(unsigned w) { return __uint_as_float(w << 16); }
__device__ __forceinline__ float bfhi(unsigned w) { return __uint_as_float(w & 0xffff0000u); }
__device__ __forceinline__ unsigned f2bf(float f) { unsigned u = __float_as_uint(f); return (u + 0x7fffu + ((u >> 16) & 1u)) >> 16; }
__device__ __forceinline__ unsigned pk2(float lo, float hi) { const f32x2 v = {lo, hi}; const bf16x2v b = __builtin_convertvector(v, bf16x2v); return __builtin_bit_cast(unsigned, b); }
__device__ __forceinline__ float dot2bf(unsigned a, unsigned b, float c) { return __builtin_amdgcn_fdot2_f32_bf16(__builtin_bit_cast(bf16x2v, a), __builtin_bit_cast(bf16x2v, b), c, false); }
__device__ __forceinline__ float wave_sum(float v) {
#pragma unroll
    for (int o = 1; o < 64; o <<= 1) v += __shfl_xor(v, o);
    return v;
}
__device__ __forceinline__ float wave_max(float v) {
#pragma unroll
    for (int o = 1; o < 64; o <<= 1) v = fmaxf(v, __shfl_xor(v, o));
    return v;
}
__device__ __forceinline__ float fast_sigmoid(float x) { return __builtin_amdgcn_rcpf(1.0f + __expf(-x)); }
__device__ __forceinline__ float inv_sigmoid(float x) { return 1.0f + __expf(fminf(-x, 69.0f)); }
#define LDS_WAIT() asm volatile("s_waitcnt lgkmcnt(0)" ::: "memory")
#define VM_WAIT() asm volatile("s_waitcnt vmcnt(0)" ::: "memory")

#define XB_TMO      128
#define XB_XCNT(j)  (256  + 64 * (j))
#define XB_XSUB(j)  (1280 + 64 * (j))
#define XB_XGEN(j)  (2304 + 64 * (j))
#define XB_TOP      3328
#define XB_TOPGEN   3392
#define XCD_BAR_WORDS 3456
#define XB_SPIN_CAP (1u << 24)
__device__ __forceinline__ unsigned xb_ld(unsigned* p)              { return __hip_atomic_load(p, __ATOMIC_RELAXED, __HIP_MEMORY_SCOPE_AGENT); }
__device__ __forceinline__ unsigned xb_add(unsigned* p, unsigned v) { return __hip_atomic_fetch_add(p, v, __ATOMIC_RELAXED, __HIP_MEMORY_SCOPE_AGENT); }
__device__ __forceinline__ unsigned xb_xcc_id() { return (unsigned)__builtin_amdgcn_s_getreg((3 << 11) | 20) & 0xFu; }
#define XB_SPIN(cond, bar) do { unsigned _sp = 0; while (cond) { __builtin_amdgcn_s_sleep(1); \
    if ((++_sp & 255u) == 0u) { if (xb_ld(&(bar)[XB_TMO])) break; if (_sp > XB_SPIN_CAP) { atomicAdd(&(bar)[XB_TMO], 1u); break; } } } } while (0)
struct XcdBarrier { unsigned* bar; unsigned x; volatile LAS unsigned* st; };
__device__ __forceinline__ XcdBarrier xcd_barrier_post(unsigned* bar, volatile LAS unsigned* st) {
    XcdBarrier b; b.bar = bar; b.x = xb_xcc_id(); b.st = st;
    if (threadIdx.x == 0) (void)xb_add(&bar[XB_XCNT(b.x)], 1u);
    return b;
}
__device__ __forceinline__ void xcd_barrier_complete(unsigned* bar, unsigned x, unsigned& nloc, unsigned& nx) {
    const unsigned G = gridDim.x * gridDim.y * gridDim.z;
    unsigned sum, cnt, mine, sp = 0u;
    for (;;) {
        sum = 0u; cnt = 0u; mine = 0u;
#pragma unroll
        for (unsigned j = 0; j < 16; ++j) { const unsigned c = xb_ld(&bar[XB_XCNT(j)]); sum += c; cnt += (c > 0u) ? 1u : 0u; mine = (j == x) ? c : mine; }
        if (sum == G) break;
        __builtin_amdgcn_s_sleep(1);
        if ((++sp & 255u) == 0u) { if (xb_ld(&bar[XB_TMO])) break; if (sp > XB_SPIN_CAP) { atomicAdd(&bar[XB_TMO], 1u); break; } }
    }
    nloc = mine > 0u ? mine : 1u; nx = cnt > 0u ? cnt : 1u;
}
__device__ __forceinline__ void xcd_barrier(const XcdBarrier& b) {
    asm volatile("s_waitcnt vmcnt(0)" ::: "memory");
    __syncthreads();
    if (threadIdx.x == 0) {
        unsigned* bar = b.bar;
        __builtin_amdgcn_s_waitcnt(0);
        unsigned nloc = b.st[0], nx = b.st[1];
        if (nloc == 0u) { xcd_barrier_complete(bar, b.x, nloc, nx); b.st[0] = nloc; b.st[1] = nx; }
        const unsigned old = xb_add(&bar[XB_XSUB(b.x)], 1u);
        const unsigned gen = old / nloc;
        if (old + 1u == (gen + 1u) * nloc) {
            __builtin_amdgcn_fence(__ATOMIC_RELEASE, "agent");
            asm volatile("s_waitcnt vmcnt(0)" ::: "memory");
            const unsigned og = xb_add(&bar[XB_TOP], 1u);
            const unsigned tg = og / nx;
            if (og + 1u == (tg + 1u) * nx) xb_add(&bar[XB_TOPGEN], 1u);
            else XB_SPIN(xb_ld(&bar[XB_TOPGEN]) == tg, bar);
            __builtin_amdgcn_fence(__ATOMIC_ACQUIRE, "agent");
            xb_add(&bar[XB_XGEN(b.x)], 1u);
            asm volatile("s_waitcnt vmcnt(0)" ::: "memory");
        } else {
            XB_SPIN(xb_ld(&bar[XB_XGEN(b.x)]) == gen, bar);
            __builtin_amdgcn_fence(__ATOMIC_ACQUIRE, "agent");
            asm volatile("s_waitcnt vmcnt(0)" ::: "memory");
        }
    }
    __syncthreads();
}

namespace gg {
constexpr int BM = 256, BK = 64, HALF = 128, HTB = HALF * BK * 2, STAGE_BYTES = 8 * HTB;
__device__ __forceinline__ int lds_byte(int r, int c) { const int st = (r >> 4) * 2 + (c >> 5), rr = r & 15, cc = c & 31, ob = rr * 64 + cc * 2; return st * 1024 + (ob ^ (((ob >> 9) & 1) << 5)); }
__device__ __forceinline__ void stage_rc(int b, int& R, int& C) { const int st = b / 1024, sb = b % 1024, swz = sb ^ (((sb >> 9) & 1) << 5); R = (st >> 1) * 16 + swz / 64; C = (st & 1) * 32 + (swz % 64) / 2; }
__device__ __forceinline__ int perm32(int rho) { const int n = rho >> 4, i = rho & 15; return 8 * (i >> 2) + 4 * n + (i & 3); }
struct Unit { const char* A; const char* B; int kind, pm, pn, aux; };
typedef f32x4 Acc[2][2][4][2];

template <int MODE, bool RX = false, class Epi, class Sched>
__device__ __forceinline__ void gemm_phase(LAS unsigned char* lds, const int ldaB, const int ldbB, const int nt, const Sched& S, const Epi& E) {
    int tid = threadIdx.x; asm volatile("" : "+v"(tid));
    const int wid = __builtin_amdgcn_readfirstlane(tid >> 6), lane = tid & 63, wr = wid >> 2, wc = wid & 3, fr = lane & 15, fq = lane >> 4;
    unsigned voffA[2], voffB[2];
#pragma unroll
    for (int i = 0; i < 2; ++i) { int R, C; stage_rc(tid * 16 + i * 8192, R, C); const int Rb = (R & ~31) + perm32(R & 31);
        voffA[i] = (unsigned)(R * ldaB + C * 2); voffB[i] = (unsigned)(Rb * ldbB + C * 2); }
    const size_t kstep = (size_t)(BK * 2);
    const size_t hstepA = (size_t)HALF * ldaB, hstepB = (size_t)HALF * ldbB;
    const unsigned ldsw = (unsigned)wid * 1024u;
    const int aoff = lds_byte(wr * 64 + fr, fq * 8), boff = lds_byte(wc * 32 + fr, fq * 8);
#define PG8_SA(b, h) (((b) * 2 + (h)) * HTB)
#define PG8_SB(b, h) ((4 + (b) * 2 + (h)) * HTB)
#define PG8_STAGE(bufoff, gbase, voff) do { _Pragma("unroll") for (int _i = 0; _i < 2; ++_i) \
        __builtin_amdgcn_global_load_lds((const unsigned*)((const char*)(gbase) + (voff)[_i]), (LAS unsigned*)(lds + (bufoff) + ldsw + _i * 8192), 16, 0, 0); } while (0)
#define PG8_LDA(dst, b, h) do { _Pragma("unroll") for (int m = 0; m < 4; ++m) { if constexpr (MODE == 1) { const u32x4 p0_ = *(const LAS u32x4*)(lds + PG8_SA(b, h) + aoff + m * 2048), p1_ = *(const LAS u32x4*)(lds + PG8_SA(b, h) + aoff + m * 2048 + 1024); \
        dst##8[m] = __builtin_shufflevector(p0_, p1_, 0, 1, 2, 3, 4, 5, 6, 7); } else { _Pragma("unroll") for (int k = 0; k < 2; ++k) dst[m][k] = *(const LAS bf16x8*)(lds + PG8_SA(b, h) + aoff + m * 2048 + k * 1024); } } } while (0)
#define PG8_LDB(dst, b, h) do { _Pragma("unroll") for (int n = 0; n < 2; ++n) { if constexpr (MODE == 1) { const u32x4 p0_ = *(const LAS u32x4*)(lds + PG8_SB(b, h) + boff + n * 2048), p1_ = *(const LAS u32x4*)(lds + PG8_SB(b, h) + boff + n * 2048 + 1024); \
        dst##8[n] = __builtin_shufflevector(p0_, p1_, 0, 1, 2, 3, 4, 5, 6, 7); } else { _Pragma("unroll") for (int k = 0; k < 2; ++k) dst[n][k] = *(const LAS bf16x8*)(lds + PG8_SB(b, h) + boff + n * 2048 + k * 1024); } } } while (0)
#define PG8_MMA(ai, bj, At, Bt) do { __builtin_amdgcn_s_setprio(1); _Pragma("unroll") for (int m = 0; m < 4; ++m) _Pragma("unroll") for (int n = 0; n < 2; ++n) { \
        if constexpr (MODE == 1) { asm volatile("v_mfma_scale_f32_16x16x128_f8f6f4 %0, %1, %2, %0, %3, %3 op_sel_hi:[0,0,0]" : "+v"(acc[ai][bj][m][n]) : "v"(Bt##8[n]), "v"(At##8[m]), "v"(sc127)); } \
        else if constexpr (MODE == 2) { _Pragma("unroll") for (int k = 0; k < 2; ++k) acc[ai][bj][m][n] = __builtin_bit_cast(f32x4, __builtin_amdgcn_mfma_i32_16x16x64_i8(__builtin_bit_cast(i32x4, Bt[n][k]), __builtin_bit_cast(i32x4, At[m][k]), __builtin_bit_cast(i32x4, acc[ai][bj][m][n]), 0, 0, 0)); } \
        else { _Pragma("unroll") for (int k = 0; k < 2; ++k) acc[ai][bj][m][n] = __builtin_amdgcn_mfma_f32_16x16x32_bf16(Bt[n][k], At[m][k], acc[ai][bj][m][n], 0, 0, 0); } } \
        __builtin_amdgcn_s_setprio(0); } while (0)
#define PG8_WAIT_V(n) asm volatile("s_waitcnt vmcnt(" #n ")" ::: "memory")
#define PG8_WAIT_V2(flag) asm volatile("s_cmp_lg_u32 %0, 0\n\ts_cbranch_scc1 1f\n\ts_waitcnt vmcnt(8)\n\ts_branch 2f\n1:\n\ts_waitcnt vmcnt(24)\n2:" :: "s"(flag) : "scc", "memory")
#define PG8_WAIT_L(n) asm volatile("s_waitcnt lgkmcnt(" #n ")" ::: "memory")
#define PG8_BAR __builtin_amdgcn_s_barrier()
#define PG8_SCHED __builtin_amdgcn_sched_barrier(0)
    Unit cur, nxt; int ui = 0;
    if (!S.next(0, cur)) return;
    Acc acc;
#pragma unroll
    for (int a = 0; a < 2; ++a)
#pragma unroll
        for (int b = 0; b < 2; ++b)
#pragma unroll
            for (int m = 0; m < 4; ++m)
#pragma unroll
                for (int n = 0; n < 2; ++n) acc[a][b][m][n] = (f32x4){0.f, 0.f, 0.f, 0.f};
    bf16x8 At[4][2], B0[2][2], B1[2][2]; u32x8 At8[4], B08[2], B18[2]; const int sc127 = 127;
    const char* cA = cur.A; const char* cB = cur.B;
    PG8_STAGE(PG8_SB(0, 0), cB, voffB); PG8_STAGE(PG8_SB(0, 1), cB + hstepB, voffB); PG8_STAGE(PG8_SA(0, 0), cA, voffA); PG8_STAGE(PG8_SA(0, 1), cA + hstepA, voffA);
    if (wr == 1) PG8_BAR;
    PG8_WAIT_V(2); PG8_BAR;
    PG8_STAGE(PG8_SB(1, 0), cB + kstep, voffB); PG8_STAGE(PG8_SA(1, 0), cA + kstep, voffA); PG8_STAGE(PG8_SB(1, 1), cB + hstepB + kstep, voffB);
    PG8_WAIT_V(6); PG8_BAR;
    bool relax = false;
    for (;;) {
        const bool has_next = S.next(ui + 1, nxt);
        const char* nA = has_next ? nxt.A : cA; const char* nB = has_next ? nxt.B : cB;
        const int unt = cur.aux ? cur.aux : nt;
#define PG8_PAIR(W0) { \
            const bool last = (t == unt - 2); const int rxf = __builtin_amdgcn_readfirstlane((relax && t == 0) ? 1 : 0); \
            const char* a1 = cA + (size_t)(t + 1) * kstep; \
            const char* a2 = last ? nA : cA + (size_t)(t + 2) * kstep; const char* b2 = last ? nB : cB + (size_t)(t + 2) * kstep; \
            const char* a3 = a2 + kstep; const char* b3 = b2 + kstep; \
              \
            PG8_LDB(B0, 0, 0); PG8_LDB(B1, 0, 1); PG8_SCHED; PG8_LDA(At, 0, 0); PG8_STAGE(PG8_SA(1, 1), a1 + hstepA, voffA); \
            if constexpr (RX) PG8_WAIT_V2(rxf); else PG8_WAIT_V(8); PG8_WAIT_L(0); PG8_BAR; PG8_MMA(0, 0, At, B0); PG8_MMA(0, 1, At, B1); PG8_BAR; PG8_SCHED; \
              \
            PG8_LDA(At, 0, 1); PG8_STAGE(PG8_SB(0, 0), b2, voffB); PG8_STAGE(PG8_SB(0, 1), b2 + hstepB, voffB); PG8_STAGE(PG8_SA(0, 0), a2, voffA); \
            if constexpr (RX) PG8_WAIT_V2(rxf); else PG8_WAIT_V(8); PG8_WAIT_L(0); PG8_BAR; PG8_MMA(1, 0, At, B0); PG8_MMA(1, 1, At, B1); PG8_BAR; PG8_SCHED; \
              \
            PG8_LDB(B0, 1, 0); PG8_LDB(B1, 1, 1); PG8_SCHED; PG8_LDA(At, 1, 0); PG8_STAGE(PG8_SA(0, 1), a2 + hstepA, voffA); \
            PG8_WAIT_V(8); PG8_WAIT_L(0); PG8_BAR; PG8_MMA(0, 0, At, B0); PG8_MMA(0, 1, At, B1); PG8_BAR; PG8_SCHED; \
              \
            PG8_LDA(At, 1, 1); PG8_STAGE(PG8_SB(1, 0), b3, voffB); PG8_STAGE(PG8_SB(1, 1), b3 + hstepB, voffB); PG8_STAGE(PG8_SA(1, 0), a3, voffA); \
            PG8_WAIT_V(8); PG8_WAIT_L(0); PG8_BAR; PG8_MMA(1, 0, At, B0); PG8_MMA(1, 1, At, B1); PG8_BAR; PG8_SCHED; }
        for (int t = 0; t < unt; t += 2) PG8_PAIR(8)
#undef PG8_PAIR
        if constexpr (MODE == 1) asm volatile("s_nop 15\n\ts_nop 15" ::: "memory");
        if (wr == 0) PG8_BAR;
        const bool reset = E(acc, cur, wr, wc, fr, fq, wid, lane);
        if constexpr (RX) relax = (E.nst(cur) >= 16);
        asm volatile("" ::: "memory");
        if (!has_next) break;
        if (reset) {
#pragma unroll
            for (int a = 0; a < 2; ++a)
#pragma unroll
                for (int b = 0; b < 2; ++b)
#pragma unroll
                    for (int m = 0; m < 4; ++m)
#pragma unroll
                        for (int n = 0; n < 2; ++n) acc[a][b][m][n] = (f32x4){0.f, 0.f, 0.f, 0.f};
        }
        cur = nxt; cA = nA; cB = nB; ++ui;
        if (wr == 1) PG8_BAR;
    }
    PG8_WAIT_V(0);
    PG8_BAR;
#undef PG8_SA
#undef PG8_SB
#undef PG8_STAGE
#undef PG8_LDA
#undef PG8_LDB
#undef PG8_MMA
#undef PG8_WAIT_V
#undef PG8_WAIT_L
#undef PG8_BAR
#undef PG8_SCHED
}

__device__ __forceinline__ bool tile_order(long L, int nM, int nN, int& pm, int& pn) {
    const int nwg = nM * nN; if (L >= nwg) return false;
    const int q = nwg / 8, xcd = (int)(L % 8), off = (int)(L / 8); const int wgid = xcd * q + off;
    const int nig = 8 * nN, gid = wgid / nig, fm = gid * 8;
    pm = fm + ((wgid % nig) % 8); pn = (wgid % nig) / 8; return true;
}
__device__ __forceinline__ void store_bf16_tile(const Acc& acc, bf16_t* base, int ldc, int row0, int col0, int wr, int wc, int fr, int fq) {
#pragma unroll
    for (int ai = 0; ai < 2; ++ai)
#pragma unroll
        for (int m = 0; m < 4; ++m) { bf16_t* rowp = base + (size_t)(row0 + ai * HALF + wr * 64 + m * 16 + fr) * ldc + col0 + wc * 32 + 8 * fq;
#pragma unroll
            for (int bj = 0; bj < 2; ++bj) { const f32x4 v0 = acc[ai][bj][m][0], v1 = acc[ai][bj][m][1];
                u32x4 w; w.x = pk2(v0[0], v0[1]); w.y = pk2(v0[2], v0[3]); w.z = pk2(v1[0], v1[1]); w.w = pk2(v1[2], v1[3]);
                *(u32x4*)(rowp + bj * HALF) = w; } }
}
}

struct Args { const float* in[21]; float* out; unsigned char* ws; };
struct Frame {
    LAS unsigned char* lds;
    int tid, lane, wave, G, bid;
    unsigned char* ws;
    __device__ __forceinline__ void refresh() { int t = threadIdx.x; asm volatile("" : "+v"(t)); tid = t; lane = t & 63; wave = __builtin_amdgcn_readfirstlane(t >> 6); }
};

__device__ __forceinline__ int src_col(int n) { return n < 6144 ? n : (n < O_AL ? n + 16 : (n < O_AL + 16 ? n - O_AL + 6144 : -1)); }
__device__ __forceinline__ void transpose_item(const float* W, int K, int N, int NT, bf16_t* WT, LAS float* scr, int item, int lane, bool remap, unsigned char* W8 = nullptr, bf16_t* WQ = nullptr, const unsigned* cmax = nullptr, float* sw = nullptr, bool i8perm = false) {
    const int nblk = NT / 32, kb = item / nblk, nb = item % nblk, k0 = 64 * kb, n0 = 32 * nb;
    const int q = lane & 7, r8 = lane >> 3;
    const int n = n0 + 4 * q; const int src = remap ? src_col(n) : n;
    f32x4 v[8];
#pragma unroll
    for (int i = 0; i < 8; ++i) v[i] = (src >= 0) ? *(const f32x4*)(W + (size_t)(k0 + 8 * i + r8) * N + src) : (f32x4){0.f, 0.f, 0.f, 0.f};
    if (remap && n0 >= O_QX && n0 < O_GT) {
#pragma unroll
        for (int i = 0; i < 8; ++i) *(u32x2*)(WQ + (size_t)(k0 + 8 * i + r8) * 2048 + (n0 - O_QX) + 4 * q) = (u32x2){pk2(v[i].x, v[i].y), pk2(v[i].z, v[i].w)};
        return;
    }
#pragma unroll
    for (int i = 0; i < 8; ++i) { LAS float* d = scr + (8 * i + r8) * 33 + 4 * q; d[0] = v[i].x; d[1] = v[i].y; d[2] = v[i].z; d[3] = v[i].w; }
    LDS_WAIT(); asm volatile("" ::: "memory");
    const int c = lane & 7;
    if (i8perm) {
#pragma unroll
        for (int j = 0; j < 4; ++j) { const int nn = (lane >> 3) + 8 * j; const LAS float* s = scr + (8 * c) * 33 + nn;
            const float mx = fmaxf(__uint_as_float(xb_ld((unsigned*)cmax + n0 + nn)), 1e-30f), inv = 127.0f / mx;
            int qv[8];
#pragma unroll
            for (int e = 0; e < 8; ++e) qv[e] = (int)rintf(s[e * 33] * inv) & 255;
            *(u32x2*)(W8 + (size_t)(n0 + nn) * K + k0 + 8 * c) = (u32x2){(unsigned)(qv[0] | (qv[2] << 8) | (qv[4] << 16) | (qv[6] << 24)), (unsigned)(qv[1] | (qv[3] << 8) | (qv[5] << 16) | (qv[7] << 24))};
            if (kb == 0 && c == 0) sw[n0 + nn] = mx * (1.0f / 127.0f); }
    } else if (remap && n0 < O_AL && w_row_is8(n0)) {
#pragma unroll
        for (int j = 0; j < 4; ++j) { const int nn = (lane >> 3) + 8 * j; const LAS float* s = scr + (8 * c) * 33 + nn;
            const float mx = fmaxf(__uint_as_float(xb_ld((unsigned*)cmax + src_col(n0 + nn))), 1e-30f), inv = 127.0f / mx;
            int qv[8];
#pragma unroll
            for (int e = 0; e < 8; ++e) qv[e] = (int)rintf(s[e * 33] * inv) & 255;
            *(u32x2*)(W8 + w_row_off(n0 + nn) + k0 + 8 * c) = (u32x2){(unsigned)(qv[0] | (qv[1] << 8) | (qv[2] << 16) | (qv[3] << 24)), (unsigned)(qv[4] | (qv[5] << 8) | (qv[6] << 16) | (qv[7] << 24))};
            if (kb == 0 && c == 0) sw[n0 + nn] = mx * (1.0f / 127.0f); }
    } else if (remap && n0 < O_AL) {
#pragma unroll
        for (int j = 0; j < 4; ++j) { const int nn = (lane >> 3) + 8 * j; const LAS float* s = scr + (8 * c) * 33 + nn;
            u32x4 o; o.x = pk2(s[0 * 33], s[1 * 33]); o.y = pk2(s[2 * 33], s[3 * 33]); o.z = pk2(s[4 * 33], s[5 * 33]); o.w = pk2(s[6 * 33], s[7 * 33]);
            *(u32x4*)(W8 + w_row_off(n0 + nn) + (size_t)(k0 + 8 * c) * 2) = o; }
    } else {
        const int rowoff = remap ? O_AL : 0;
#pragma unroll
        for (int j = 0; j < 4; ++j) { const int nn = (lane >> 3) + 8 * j; const LAS float* s = scr + (8 * c) * 33 + nn;
            u32x4 o; o.x = pk2(s[0 * 33], s[1 * 33]); o.y = pk2(s[2 * 33], s[3 * 33]); o.z = pk2(s[4 * 33], s[5 * 33]); o.w = pk2(s[6 * 33], s[7 * 33]);
            *(u32x4*)(WT + (size_t)(n0 - rowoff + nn) * K + k0 + 8 * c) = o; }
    }
    LDS_WAIT(); asm volatile("" ::: "memory");
}
__device__ __forceinline__ void rms_row_bf16(const float* xrow, const float* gain, bf16_t* orow, int lane) {
    const f32x4* xr = (const f32x4*)xrow + lane;
    f32x4 v[16]; float s = 0.f;
#pragma unroll
    for (int j = 0; j < 16; ++j) { v[j] = xr[64 * j]; s += (v[j].x * v[j].x + v[j].y * v[j].y) + (v[j].z * v[j].z + v[j].w * v[j].w); }
    const float rstd = rsqrtf(wave_sum(s) * (1.f / D) + EPS);
    u32x2* o8 = (u32x2*)orow + lane; const f32x4* gr = (const f32x4*)gain + lane;
#pragma unroll
    for (int j = 0; j < 16; ++j) { const f32x4 g = gr[64 * j]; u32x2 w; w.x = pk2(v[j].x * rstd * g.x, v[j].y * rstd * g.y); w.y = pk2(v[j].z * rstd * g.z, v[j].w * rstd * g.w); o8[64 * j] = w; }
}
__device__ __forceinline__ void rms_row_bf16_i8n(const float* xrow, const float* gain, bf16_t* orow, unsigned char* o8row, float* scale, int lane) {
    const f32x4* xr = (const f32x4*)xrow + lane;
    f32x4 v[16]; float s = 0.f;
#pragma unroll
    for (int j = 0; j < 16; ++j) { v[j] = xr[64 * j]; s += (v[j].x * v[j].x + v[j].y * v[j].y) + (v[j].z * v[j].z + v[j].w * v[j].w); }
    const float rstd = rsqrtf(wave_sum(s) * (1.f / D) + EPS);
    u32x2* o8 = (u32x2*)orow + lane; const f32x4* gr = (const f32x4*)gain + lane; float m = 0.f;
#pragma unroll
    for (int j = 0; j < 16; ++j) { const f32x4 g = gr[64 * j]; v[j].x *= rstd * g.x; v[j].y *= rstd * g.y; v[j].z *= rstd * g.z; v[j].w *= rstd * g.w;
        u32x2 w; w.x = pk2(v[j].x, v[j].y); w.y = pk2(v[j].z, v[j].w); o8[64 * j] = w;
        m = fmaxf(m, fmaxf(fmaxf(fabsf(v[j].x), fabsf(v[j].y)), fmaxf(fabsf(v[j].z), fabsf(v[j].w)))); }
    m = fmaxf(wave_max(m), 1e-30f); const float inv = 127.0f / m;
    if (lane == 0) *scale = m * (1.0f / 127.0f);
    unsigned* o4 = (unsigned*)o8row + lane;
#pragma unroll
    for (int j = 0; j < 16; ++j) { const int q0 = (int)rintf(v[j].x * inv), q1 = (int)rintf(v[j].y * inv), q2 = (int)rintf(v[j].z * inv), q3 = (int)rintf(v[j].w * inv);
        o4[64 * j] = (unsigned)(q0 & 255) | ((unsigned)(q1 & 255) << 8) | ((unsigned)(q2 & 255) << 16) | ((unsigned)(q3 & 255) << 24); }
}
__device__ __forceinline__ void rms_row_i8(const bf16_t* xrow, const float* gain, unsigned char* o8row, float* scale, float* hsum, int lane) {
    const u32x4* xr = (const u32x4*)xrow + lane;
    f32x4 v[16]; float s = 0.f;
#pragma unroll
    for (int j = 0; j < 8; ++j) { const u32x4 u = xr[64 * j]; v[2 * j] = (f32x4){bflo(u.x), bfhi(u.x), bflo(u.y), bfhi(u.y)}; v[2 * j + 1] = (f32x4){bflo(u.z), bfhi(u.z), bflo(u.w), bfhi(u.w)}; }
#pragma unroll
    for (int j = 0; j < 16; ++j) s += (v[j].x * v[j].x + v[j].y * v[j].y) + (v[j].z * v[j].z + v[j].w * v[j].w);
    const float rstd = rsqrtf(wave_sum(s) * (1.f / D) + EPS);
    const f32x4* gr = (const f32x4*)gain + 2 * lane; float m = 0.f;
#pragma unroll
    for (int j = 0; j < 8; ++j) {
#pragma unroll
        for (int q = 0; q < 2; ++q) { const f32x4 g = gr[128 * j + q]; f32x4& x = v[2 * j + q]; x.x *= rstd * g.x; x.y *= rstd * g.y; x.z *= rstd * g.z; x.w *= rstd * g.w;
            m = fmaxf(m, fmaxf(fmaxf(fabsf(x.x), fabsf(x.y)), fmaxf(fabsf(x.z), fabsf(x.w)))); }
        }
    m = fmaxf(wave_max(m), 1e-30f); const float inv = 127.0f / m;
    int isum = 0;
#pragma unroll
    for (int j = 0; j < 8; ++j) { const f32x4 a = v[2 * j], b = v[2 * j + 1];
        const int q0 = (int)rintf(a.x * inv), q1 = (int)rintf(a.y * inv), q2 = (int)rintf(a.z * inv), q3 = (int)rintf(a.w * inv), q4 = (int)rintf(b.x * inv), q5 = (int)rintf(b.y * inv), q6 = (int)rintf(b.z * inv), q7 = (int)rintf(b.w * inv);
        isum += (q0 + q1) + (q2 + q3) + (q4 + q5) + (q6 + q7);
        u32x2 w; w.x = (unsigned)(q0 & 255) | ((unsigned)(q2 & 255) << 8) | ((unsigned)(q4 & 255) << 16) | ((unsigned)(q6 & 255) << 24);
        w.y = (unsigned)(q1 & 255) | ((unsigned)(q3 & 255) << 8) | ((unsigned)(q5 & 255) << 16) | ((unsigned)(q7 & 255) << 24);
        ((u32x2*)o8row)[lane + 64 * j] = w; }
#pragma unroll
    for (int o = 1; o < 64; o <<= 1) isum += __shfl_xor(isum, o);
    if (lane == 0) { *scale = m * (1.0f / 127.0f); *hsum = (float)isum; }
}
__device__ __forceinline__ void cvt_table(const float* src, bf16_t* dst, size_t n8, size_t gt, size_t ngt) {
    for (size_t i = gt; i < n8; i += ngt) { const f32x4 a = ((const f32x4*)src)[2 * i], b = ((const f32x4*)src)[2 * i + 1];
        u32x4 w; w.x = pk2(a.x, a.y); w.y = pk2(a.z, a.w); w.z = pk2(b.x, b.y); w.w = pk2(b.z, b.w); ((u32x4*)dst)[i] = w; }
}
__device__ __forceinline__ void quant_row_i4(const float* xrow, unsigned char* orow, float* scale, int lane) {
    const f32x4* xr = (const f32x4*)xrow + 2 * lane;
    f32x4 v[16]; float s = 0.f;
#pragma unroll
    for (int j = 0; j < 8; ++j) { v[2 * j] = xr[128 * j]; v[2 * j + 1] = xr[128 * j + 1]; }
#pragma unroll
    for (int j = 0; j < 16; ++j) s += (v[j].x * v[j].x + v[j].y * v[j].y) + (v[j].z * v[j].z + v[j].w * v[j].w);
    const float sc = fmaxf(2.5f * sqrtf(wave_sum(s) * (1.f / D)) * (1.f / 7.f), 1e-30f), inv = 1.0f / sc;
    if (lane == 0) *scale = sc;
    unsigned* o4 = (unsigned*)orow + lane;
#pragma unroll
    for (int j = 0; j < 8; ++j) { const f32x4 a = v[2 * j], b = v[2 * j + 1]; const float e[8] = {a.x, a.y, a.z, a.w, b.x, b.y, b.z, b.w}; unsigned w = 0u;
#pragma unroll
        for (int i = 0; i < 8; ++i) { const int q = (int)fminf(fmaxf(rintf(e[i] * inv), -7.f), 7.f) + 8; w |= (unsigned)q << (4 * i); }
        o4[64 * j] = w; }
}
__device__ __forceinline__ int nth_block(int j, bool want8) {
    int nb = -1;
#pragma unroll
    for (int s = 0; s < 9; ++s) { const int b0 = (s < 8 ? SEG_START[s] : O_AL) / 32, b1 = (s < 8 ? SEG_START[s + 1] : NPAD) / 32; const bool is8 = s < 8 && seg_i8(s);
        if (is8 == want8) { if (nb < 0 && j >= 0 && j < b1 - b0) nb = b0 + j; j -= (b1 - b0); } }
    return nb;
}
constexpr int count_blocks8() { int n = 0; for (int s = 0; s < 8; ++s) if (seg_i8(s)) n += (SEG_START[s + 1] - SEG_START[s]) / 32; return n; }
constexpr int NB8 = count_blocks8(), NBX = NPAD / 32 - NB8;
__device__ __forceinline__ void p0_prologue_a(Frame& F, const Args& a) {
    LAS float* scr = (LAS float*)(F.lds + F.wave * 16384);
    const int gw = F.bid * 8 + F.wave, NGW = F.G * 8;
    unsigned char* ws = F.ws;
    constexpr int I_BR = 32 * 128, I_O = 64 * 128, I_KV = 64 * 128;
    constexpr int I_X = 64 * NBX;
    constexpr int NITEMS = 3 * I_BR + I_O + I_KV + I_X;
    for (int it = gw; it < NITEMS; it += NGW) {
        int r = it;
        if (r < I_X) { const int nb = nth_block(r >> 6, false); transpose_item(a.in[3], D, 26640, NPAD, (bf16_t*)(ws + WS_WAL), scr, (r & 63) * (NPAD / 32) + nb, F.lane, true, ws + WS_W8, (bf16_t*)(ws + WS_WQX), (const unsigned*)(ws + WS_CTL + CTL_CMAX), (float*)(ws + WS_SW)); continue; } r -= I_X;
        if (r < I_BR) { transpose_item(a.in[8], 2048, D, D, (bf16_t*)(ws + WS_WBR), scr, r, F.lane, false); continue; } r -= I_BR;
        if (r < I_BR) { transpose_item(a.in[9], 2048, D, D, (bf16_t*)(ws + WS_WBR + 16 * MiB), scr, r, F.lane, false); continue; } r -= I_BR;
        if (r < I_BR) { transpose_item(a.in[11], 2048, D, D, (bf16_t*)(ws + WS_WBR + 32 * MiB), scr, r, F.lane, false); continue; } r -= I_BR;
        if (r < I_O) { transpose_item(a.in[13], D, D, D, (bf16_t*)(ws + WS_WO), scr, r, F.lane, false); continue; } r -= I_O;
        transpose_item(a.in[10], D, D, D, (bf16_t*)(ws + WS_WKV), scr, r, F.lane, false);
    }
    for (int m = gw; m < T; m += NGW) rms_row_bf16_i8n(a.in[0] + (size_t)m * D, a.in[2], (bf16_t*)(ws + WS_HN) + (size_t)m * D, ws + WS_HN8 + (size_t)m * D, (float*)(ws + WS_SHN) + m, F.lane);
    for (int m = gw; m < MEMT; m += NGW) rms_row_bf16(a.in[1] + (size_t)m * D, a.in[14], (bf16_t*)(ws + WS_MEMN) + (size_t)m * D, F.lane);
    const size_t gt = (size_t)F.bid * 512 + F.tid, ngt = (size_t)F.G * 512;
    cvt_table(a.in[17], (bf16_t*)(ws + WS_SUBK), (size_t)8 * 2 * 128 * 128 / 8, gt, ngt);
    { unsigned* cmq = (unsigned*)(ws + WS_CTL + CTL_CMAXPQ);
      for (int u = F.bid; u < 256; u += F.G) { const float* wp = a.in[16] + (size_t)(16 * u) * 2048 + 4 * F.tid; f32x4 m = (f32x4){0.f, 0.f, 0.f, 0.f};
#pragma unroll
          for (int r = 0; r < 16; ++r) { const f32x4 v = *(const f32x4*)(wp + (size_t)r * 2048); m.x = fmaxf(m.x, fabsf(v.x)); m.y = fmaxf(m.y, fabsf(v.y)); m.z = fmaxf(m.z, fabsf(v.z)); m.w = fmaxf(m.w, fabsf(v.w)); }
          atomicMax(cmq + 4 * F.tid + 0, __float_as_uint(m.x)); atomicMax(cmq + 4 * F.tid + 1, __float_as_uint(m.y)); atomicMax(cmq + 4 * F.tid + 2, __float_as_uint(m.z)); atomicMax(cmq + 4 * F.tid + 3, __float_as_uint(m.w)); } }
}
__device__ __forceinline__ void p0_weights8(Frame& F, const Args& a) {
    LAS float* scr = (LAS float*)(F.lds + F.wave * 16384); LAS float* smax = (LAS float*)(F.lds + 131072); LAS float* bmax = smax + 256;
    unsigned char* ws = F.ws; const int lane = F.lane, q = lane & 7, r8 = lane >> 3, c = lane & 7;
    const float* W = a.in[3]; float* sw = (float*)(ws + WS_SW);
    for (int b = F.bid; b < NB8; b += F.G) {
        const int nb = nth_block(b, true), n0 = 32 * nb, src = src_col(n0 + 4 * q);
        const float* wp = W + (size_t)(512 * F.wave + r8) * 26640 + src;
        f32x4 mx = (f32x4){0.f, 0.f, 0.f, 0.f};
#pragma unroll 1
        for (int h = 0; h < 2; ++h) { f32x4 v[32];
#pragma unroll
            for (int i = 0; i < 32; ++i) v[i] = *(const f32x4*)(wp + (size_t)(256 * h + 8 * i) * 26640);
#pragma unroll
            for (int i = 0; i < 32; ++i) { mx.x = fmaxf(mx.x, fabsf(v[i].x)); mx.y = fmaxf(mx.y, fabsf(v[i].y)); mx.z = fmaxf(mx.z, fabsf(v[i].z)); mx.w = fmaxf(mx.w, fabsf(v[i].w)); } }
#pragma unroll
        for (int o_ = 8; o_ < 64; o_ <<= 1) { mx.x = fmaxf(mx.x, __shfl_xor(mx.x, o_)); mx.y = fmaxf(mx.y, __shfl_xor(mx.y, o_)); mx.z = fmaxf(mx.z, __shfl_xor(mx.z, o_)); mx.w = fmaxf(mx.w, __shfl_xor(mx.w, o_)); }
        if (lane < 8) { LAS float* d = smax + F.wave * 32 + 4 * q; d[0] = mx.x; d[1] = mx.y; d[2] = mx.z; d[3] = mx.w; }
        __syncthreads();
        if (F.tid < 32) { float m = 0.f;
#pragma unroll
            for (int w = 0; w < 8; ++w) m = fmaxf(m, smax[w * 32 + F.tid]);
            m = fmaxf(m, 1e-30f); bmax[F.tid] = m; sw[n0 + F.tid] = m * (1.0f / 127.0f); }
        __syncthreads();
        float inv[4]; size_t roff[4];
#pragma unroll
        for (int j = 0; j < 4; ++j) { const int nn = r8 + 8 * j; inv[j] = 127.0f / bmax[nn]; roff[j] = w_row_off(n0 + nn); }
        f32x4 v[8], vn[8];
#pragma unroll
        for (int i = 0; i < 8; ++i) v[i] = *(const f32x4*)(wp + (size_t)(8 * i) * 26640);
#pragma unroll 1
        for (int ck = 0; ck < 8; ++ck) {
            if (ck < 7) {
#pragma unroll
                for (int i = 0; i < 8; ++i) vn[i] = *(const f32x4*)(wp + (size_t)(64 * (ck + 1) + 8 * i) * 26640); }
#pragma unroll
            for (int i = 0; i < 8; ++i) { LAS float* d = scr + (8 * i + r8) * 33 + 4 * q; d[0] = v[i].x; d[1] = v[i].y; d[2] = v[i].z; d[3] = v[i].w; }
            LDS_WAIT(); asm volatile("" ::: "memory");
            const int k0 = 512 * F.wave + 64 * ck;
#pragma unroll
            for (int j = 0; j < 4; ++j) { const int nn = r8 + 8 * j; const LAS float* s_ = scr + (8 * c) * 33 + nn; int qv[8];
#pragma unroll
                for (int e_ = 0; e_ < 8; ++e_) qv[e_] = (int)rintf(s_[e_ * 33] * inv[j]) & 255;
                *(u32x2*)(ws + WS_W8 + roff[j] + k0 + 8 * c) = (u32x2){(unsigned)(qv[0] | (qv[1] << 8) | (qv[2] << 16) | (qv[3] << 24)), (unsigned)(qv[4] | (qv[5] << 8) | (qv[6] << 16) | (qv[7] << 24))}; }
            LDS_WAIT(); asm volatile("" ::: "memory");
#pragma unroll
            for (int i = 0; i < 8; ++i) v[i] = vn[i];
        }
        __syncthreads();
    }
}
__device__ __forceinline__ void peer_wq_convert(Frame& F, const Args& a) {
    LAS float* scr = (LAS float*)(F.lds + F.wave * 16384);
    const int gw = F.bid * 8 + F.wave, NGW = F.G * 8; unsigned char* ws = F.ws;
    for (int it = gw; it < 64 * 64; it += NGW)
        transpose_item(a.in[16], D, 2048, 2048, nullptr, scr, it, F.lane, false, ws + WS_WPQ, nullptr, (const unsigned*)(ws + WS_CTL + CTL_CMAXPQ), (float*)(ws + WS_SWPQ), true);
}

struct P1Sched {
    const char *hn, *wreg, *wal, *memn, *wkv; int G, c;
    __device__ __forceinline__ bool next(int i, gg::Unit& u) const {
        long L = (long)i * G + c; u.aux = 0;
        if (L < 64 * NTB) { int pm, pn; gg::tile_order(L, 64, NTB > 0 ? NTB : 1, pm, pn); pn = map_tile(pn, false);
            u.kind = 0; u.pm = pm; u.pn = pn; u.A = hn + (size_t)pm * 256 * D * 2; u.B = wreg + w_row_off(256 * pn); return true; }
        L -= 64 * NTB;
        if (L < 64) { u.kind = 0; u.pm = (int)L; u.pn = 104; u.A = hn + (size_t)L * 256 * D * 2; u.B = wal; return true; }
        L -= 64;
        if (!V_I8) { if (L < 512) { u.kind = 1; u.pm = (int)(L % 8); u.pn = (int)(L / 8); u.A = wreg + w_row_off(O_VG + 256 * u.pm); u.B = hn + (size_t)u.pn * 256 * D * 2; return true; } L -= 512; }
        if (L < 64) { u.kind = 2; u.pm = (int)(L % 4); u.pn = (int)(L / 4); u.A = memn + (size_t)u.pm * 256 * D * 2; u.B = wkv + (size_t)u.pn * 256 * D * 2; return true; }
        return false;
    }
};
struct I8Sched {
    const char *hn8, *wreg; int G, c;
    __device__ __forceinline__ bool next(int i, gg::Unit& u) const {
        const int rb = NU_B % G, ext = (rb > 0 && NU_8 >= 2 * (G - rb)) ? 2 * (G - rb) : 0, x = (NU_8 - ext) / G, rem = (NU_8 - ext) % G;
        const int cnt1 = x + (c < rem ? 1 : 0);
        long L; u.aux = 0;
        if (i < cnt1) L = (long)i * G + c; else if (ext > 0 && c >= rb && i - cnt1 < 2) L = (long)x * G + rem + 2 * (c - rb) + (i - cnt1); else return false;
        if (L < 64 * NT8) { int pm, pn; gg::tile_order(L, 64, NT8 > 0 ? NT8 : 1, pm, pn); pn = map_tile(pn, true);
            u.kind = 0; u.pm = pm; u.pn = pn; u.A = hn8 + (size_t)pm * 256 * D; u.B = wreg + w_row_off(256 * pn); return true; }
        L -= 64 * NT8;
        if (V_I8 && L < 512) { u.kind = 1; u.pm = (int)(L % 8); u.pn = (int)(L / 8); u.A = wreg + w_row_off(O_VG + 256 * u.pm); u.B = hn8 + (size_t)u.pn * 256 * D; return true; }
        return false;
    }
};
struct I8Epi {
    unsigned char* ws; const float* bgate;
    __device__ __forceinline__ int nst(const gg::Unit& u) const { return 16; }
    __device__ __forceinline__ bool operator()(gg::Acc& acc, const gg::Unit& u, int wr, int wc, int fr, int fq, int wid, int lane) const {
        bf16_t* base; int ldc, col0, mode = 0; const int row0 = u.pm * 256; const float *rs, *cs;
        const float* shn = (const float*)(ws + WS_SHN); const float* sw = (const float*)(ws + WS_SW);
        if (u.kind == 0) { const int c0 = u.pn * 256; rs = shn + row0; cs = sw + c0;
            if (c0 < O_KG) { base = (bf16_t*)(ws + WS_QG); ldc = 1024; col0 = c0; }
            else if (c0 < O_VG) { base = (bf16_t*)(ws + WS_KG); ldc = 1024; col0 = c0 - O_KG; }
            else if (c0 < O_CB) { base = (bf16_t*)(ws + WS_RG); ldc = 2048; col0 = c0 - O_RG; }
            else if (c0 < O_CC) { base = (bf16_t*)(ws + WS_CB); ldc = 2048; col0 = c0 - O_CB; }
            else if (c0 < O_CH) { base = (bf16_t*)(ws + WS_CC); ldc = 2048; col0 = c0 - O_CC; }
            else if (c0 < O_QX) { base = (bf16_t*)(ws + WS_CH); ldc = 2048; col0 = c0 - O_CH; }
            else { base = (bf16_t*)(ws + WS_GT); ldc = 12288; col0 = c0 - O_GT; mode = 1; }
        } else { base = (bf16_t*)(ws + WS_VT); ldc = T; col0 = u.pn * 256; rs = sw + O_VG + row0; cs = shn + col0; }
        float rvv[2][4]; f32x4 cv[2][2], bv[2][2];
#pragma unroll
        for (int ai = 0; ai < 2; ++ai)
#pragma unroll
            for (int m = 0; m < 4; ++m) rvv[ai][m] = rs[ai * 128 + wr * 64 + m * 16 + fr];
#pragma unroll
        for (int bj = 0; bj < 2; ++bj) { const float* cp = cs + bj * 128 + wc * 32 + 8 * fq; cv[bj][0] = *(const f32x4*)cp; cv[bj][1] = *(const f32x4*)(cp + 4);
            bv[bj][0] = (f32x4){0.f, 0.f, 0.f, 0.f}; bv[bj][1] = bv[bj][0];
            if (mode == 1) { const float* bp = bgate + col0 + bj * 128 + wc * 32 + 8 * fq; bv[bj][0] = *(const f32x4*)bp; bv[bj][1] = *(const f32x4*)(bp + 4); } }
#pragma unroll
        for (int bj = 0; bj < 2; ++bj) { const f32x4 c0v = cv[bj][0], c1v = cv[bj][1], b0 = bv[bj][0], b1 = bv[bj][1];
#pragma unroll
            for (int ai = 0; ai < 2; ++ai)
#pragma unroll
                for (int m = 0; m < 4; ++m) { const int r = ai * 128 + wr * 64 + m * 16 + fr; const float rv = rvv[ai][m];
                    const i32x4 i0 = __builtin_bit_cast(i32x4, acc[ai][bj][m][0]), i1 = __builtin_bit_cast(i32x4, acc[ai][bj][m][1]);
                    f32x4 v0 = (f32x4){(float)i0[0], (float)i0[1], (float)i0[2], (float)i0[3]} * (c0v * rv) + b0, v1 = (f32x4){(float)i1[0], (float)i1[1], (float)i1[2], (float)i1[3]} * (c1v * rv) + b1;
                    if (mode == 1) {
#pragma unroll
                        for (int j = 0; j < 4; ++j) { v0[j] = inv_sigmoid(v0[j]); v1[j] = inv_sigmoid(v1[j]); } }
                    u32x4 w; w.x = pk2(v0[0], v0[1]); w.y = pk2(v0[2], v0[3]); w.z = pk2(v1[0], v1[1]); w.w = pk2(v1[2], v1[3]);
                    *(u32x4*)(base + (size_t)(row0 + r) * ldc + col0 + bj * 128 + wc * 32 + 8 * fq) = w; } }
        return true;
    }
};
struct P1Epi {
    unsigned char* ws; const float* bgate;
    __device__ __forceinline__ int nst(const gg::Unit& u) const { return 0; }
    __device__ __forceinline__ bool operator()(gg::Acc& acc, const gg::Unit& u, int wr, int wc, int fr, int fq, int wid, int lane) const {
        bf16_t* base; int ldc, col0, mode = 0; const int row0 = u.pm * 256;
        if (u.kind == 0) { const int c0 = u.pn * 256;
            if (c0 < O_KG) { base = (bf16_t*)(ws + WS_QG); ldc = 1024; col0 = c0; }
            else if (c0 < O_VG) { base = (bf16_t*)(ws + WS_KG); ldc = 1024; col0 = c0 - O_KG; }
            else if (c0 < O_CB) { base = (bf16_t*)(ws + WS_RG); ldc = 2048; col0 = c0 - O_RG; }
            else if (c0 < O_CC) { base = (bf16_t*)(ws + WS_CB); ldc = 2048; col0 = c0 - O_CB; }
            else if (c0 < O_CH) { base = (bf16_t*)(ws + WS_CC); ldc = 2048; col0 = c0 - O_CC; }
            else if (c0 < O_QX) { base = (bf16_t*)(ws + WS_CH); ldc = 2048; col0 = c0 - O_CH; }
            else if (c0 < O_GT) { base = (bf16_t*)(ws + WS_QX); ldc = 2048; col0 = c0 - O_QX; }
            else if (c0 < O_AL) { base = (bf16_t*)(ws + WS_GT); ldc = 12288; col0 = c0 - O_GT; mode = 1; }
            else { base = nullptr; ldc = 0; col0 = 0; mode = 2; }
        } else if (u.kind == 1) { base = (bf16_t*)(ws + WS_VT); ldc = T; col0 = u.pn * 256; }
        else { base = (bf16_t*)(ws + WS_KVM); ldc = 4096; col0 = u.pn * 256; }
        if (mode == 0) { gg::store_bf16_tile(acc, base, ldc, row0, col0, wr, wc, fr, fq); }
        else if (mode == 1) {
#pragma unroll
            for (int bj = 0; bj < 2; ++bj) { const float* bp = bgate + col0 + bj * 128 + wc * 32 + 8 * fq; const f32x4 b0 = *(const f32x4*)bp, b1 = *(const f32x4*)(bp + 4);
#pragma unroll
                for (int ai = 0; ai < 2; ++ai)
#pragma unroll
                    for (int m = 0; m < 4; ++m) { f32x4 v0 = acc[ai][bj][m][0] + b0, v1 = acc[ai][bj][m][1] + b1;
#pragma unroll
                        for (int j = 0; j < 4; ++j) { v0[j] = inv_sigmoid(v0[j]); v1[j] = inv_sigmoid(v1[j]); }
                        u32x4 w; w.x = pk2(v0[0], v0[1]); w.y = pk2(v0[2], v0[3]); w.z = pk2(v1[0], v1[1]); w.w = pk2(v1[2], v1[3]);
                        *(u32x4*)(base + (size_t)(row0 + ai * 128 + wr * 64 + m * 16 + fr) * ldc + col0 + bj * 128 + wc * 32 + 8 * fq) = w; } }
        } else {
            if (wc == 0 && fq < 2) { float* alr = (float*)(ws + WS_ALR);
#pragma unroll
                for (int ai = 0; ai < 2; ++ai)
#pragma unroll
                    for (int m = 0; m < 4; ++m) { float* p = alr + (size_t)(row0 + ai * 128 + wr * 64 + m * 16 + fr) * 16 + 8 * fq;
                        *(f32x4*)p = acc[ai][0][m][0]; *(f32x4*)(p + 4) = acc[ai][0][m][1]; } }
        }
        return true;
    }
};

constexpr int PREP_ROWB = 528;
constexpr int PREP_QT = 0, PREP_KI = 2 * 64 * PREP_ROWB, PREP_ALR = 4 * 64 * PREP_ROWB;
constexpr int PREP_KOT_ROWB = 144;
__device__ __forceinline__ void gla_prep_unit(Frame& F, const Args& a, int unit) {
    const int hp = unit & 1, n = (unit >> 1) & 63, b = unit >> 7;
    const int tid = F.tid, hh = tid >> 8, c = tid & 255, h = 2 * hp + hh, lane = F.lane, wid = F.wave;
    const int tok0 = b * SEQ + n * 64;
    unsigned char* ws = F.ws;
    LAS float* alr_s = (LAS float*)(F.lds + PREP_ALR);
    LAS unsigned char* qt_s = F.lds + PREP_QT + hh * 64 * PREP_ROWB;
    LAS unsigned char* ki_s = F.lds + PREP_KI + hh * 64 * PREP_ROWB;
    if (tid < 256) ((LAS f32x4*)alr_s)[tid] = ((const f32x4*)((const float*)(ws + WS_ALR) + (size_t)tok0 * 16))[tid];
    float w[16];
#pragma unroll
    for (int r = 0; r < 16; ++r) w[r] = a.in[4][r * 1024 + h * 256 + c];
    const float ba = a.in[5][h * 256 + c];
    __syncthreads();
    float bt[64]; float cum = 0.f;
#pragma unroll
    for (int t = 0; t < 64; ++t) {
        float z = ba;
#pragma unroll
        for (int r = 0; r < 16; ++r) z += alr_s[t * 16 + r] * w[r];
        const float ls = fminf(z, 0.f) - __logf(1.0f + __expf(-fabsf(z)));
        cum += ls * (1.0f / 16.0f); bt[t] = cum;
    }
    const bf16_t* qg = (const bf16_t*)(ws + WS_QG) + (size_t)tok0 * 1024 + h * 256 + c;
    const bf16_t* kg = (const bf16_t*)(ws + WS_KG) + (size_t)tok0 * 1024 + h * 256 + c;
#pragma unroll
    for (int t = 0; t < 64; ++t) {
        const float q = bf2f(qg[(size_t)t * 1024]), k = bf2f(kg[(size_t)t * 1024]);
        const float eb = __expf(bt[t]);
        *(LAS bf16_t*)(qt_s + t * PREP_ROWB + c * 2) = (bf16_t)f2bf(q * eb * 0.0625f);
        *(LAS bf16_t*)(ki_s + t * PREP_ROWB + c * 2) = (bf16_t)f2bf(k * __expf(-bt[t]));
    }
    unsigned char* blk = ws + WS_GLAB + (size_t)((b * 4 + h) * 64 + n) * GLA_BLK;
    ((float*)(blk + 73728))[c] = __expf(cum);
    __syncthreads();
    {
        const int whh = wid >> 2, mb = wid & 3, fr = lane & 15, fq = lane >> 4;
        LAS unsigned char* qs = F.lds + PREP_QT + whh * 64 * PREP_ROWB; LAS unsigned char* ks = F.lds + PREP_KI + whh * 64 * PREP_ROWB;
        unsigned char* wblk = ws + WS_GLAB + (size_t)((b * 4 + 2 * hp + whh) * 64 + n) * GLA_BLK;
        bf16_t* attf = (bf16_t*)(wblk + 65536);
#pragma unroll
        for (int nb = 0; nb < 4; ++nb) {
            f32x4 acc = (f32x4){0.f, 0.f, 0.f, 0.f};
            if (nb <= mb) {
#pragma unroll
                for (int kk = 0; kk < 8; ++kk) {
                    const bf16x8 av = *(const LAS bf16x8*)(qs + (16 * mb + fr) * PREP_ROWB + (32 * kk + 8 * fq) * 2);
                    const bf16x8 bv = *(const LAS bf16x8*)(ks + (16 * nb + fr) * PREP_ROWB + (32 * kk + 8 * fq) * 2);
                    acc = __builtin_amdgcn_mfma_f32_16x16x32_bf16(av, bv, acc, 0, 0, 0);
                }
            }
            const int s = 16 * nb + fr;
#pragma unroll
            for (int j = 0; j < 4; ++j) { const int t = 16 * mb + 4 * fq + j; const float v = (s <= t) ? acc[j] : 0.f;
                attf[((mb * 2 + (s >> 5)) * 64 + (t & 15) + 16 * ((s & 31) >> 3)) * 8 + (s & 7)] = (bf16_t)f2bf(v); }
        }
        u32x4* qtf = (u32x4*)wblk;
#pragma unroll
        for (int i = 0; i < 8; ++i) { const int f = (wid & 3) * 8 + i, mb2 = f >> 3, kk = f & 7;
            const LAS unsigned char* rowp = qs + (16 * mb2 + fr) * PREP_ROWB + (32 * kk + 4 * fq) * 2;
            const u32x2 lo = *(const LAS u32x2*)rowp, hi = *(const LAS u32x2*)(rowp + 32);
            u32x4 o; o.x = lo.x; o.y = lo.y; o.z = hi.x; o.w = hi.y; qtf[f * 64 + lane] = o; }
    }
    __syncthreads();
    {
        LAS unsigned char* kot = F.lds + hh * 256 * PREP_KOT_ROWB + c * PREP_KOT_ROWB;
#pragma unroll
        for (int t8 = 0; t8 < 8; ++t8) { float v[8];
#pragma unroll
            for (int j = 0; j < 8; ++j) { const int t = t8 * 8 + j; v[j] = bf2f(kg[(size_t)t * 1024]) * __expf(cum - bt[t]); }
            u32x4 o; o.x = pk2(v[0], v[1]); o.y = pk2(v[2], v[3]); o.z = pk2(v[4], v[5]); o.w = pk2(v[6], v[7]);
            *(LAS u32x4*)(kot + t8 * 16) = o; }
    }
    __syncthreads();
    {
        const int whh = wid >> 2, fr = lane & 15, fq = lane >> 4;
        unsigned char* wblk = ws + WS_GLAB + (size_t)((b * 4 + 2 * hp + whh) * 64 + n) * GLA_BLK;
        u32x4* kof = (u32x4*)(wblk + 32768);
        const LAS unsigned char* kb = F.lds + whh * 256 * PREP_KOT_ROWB;
#pragma unroll
        for (int i = 0; i < 8; ++i) { const int f = (wid & 3) * 8 + i, mbc = f >> 1, kk2 = f & 1;
            kof[f * 64 + lane] = *(const LAS u32x4*)(kb + (16 * mbc + fr) * PREP_KOT_ROWB + (32 * kk2 + 8 * fq) * 2); }
    }
    __syncthreads();
}

__device__ __forceinline__ void conv_phase(Frame& F, const Args& a, int wg, int nwg) {
    unsigned char* ws = F.ws;
    const size_t gt = (size_t)wg * 512 + F.tid, ngt = (size_t)nwg * 512;
    u32x4* cb = (u32x4*)(ws + WS_CB); const u32x4* cc = (const u32x4*)(ws + WS_CC); const u32x4* ch = (const u32x4*)(ws + WS_CH);
    const float* cw = a.in[7];
    for (size_t p = gt; p < (size_t)T * 256; p += ngt) {
        const int t = (int)(p >> 8), c8 = (int)(p & 255) * 8, pos = t & (SEQ - 1);
        float accv[8];
#pragma unroll
        for (int j = 0; j < 8; ++j) accv[j] = 0.f;
#pragma unroll
        for (int d = 0; d < 3; ++d) {
            if (pos >= d) { const u32x4 x = cc[p - (size_t)d * 256], y = ch[p - (size_t)d * 256];
                const f32x4 w0 = *(const f32x4*)(cw + d * 2048 + c8), w1 = *(const f32x4*)(cw + d * 2048 + c8 + 4);
                accv[0] += w0.x * (bflo(x.x) * bflo(y.x)); accv[1] += w0.y * (bfhi(x.x) * bfhi(y.x));
                accv[2] += w0.z * (bflo(x.y) * bflo(y.y)); accv[3] += w0.w * (bfhi(x.y) * bfhi(y.y));
                accv[4] += w1.x * (bflo(x.z) * bflo(y.z)); accv[5] += w1.y * (bfhi(x.z) * bfhi(y.z));
                accv[6] += w1.z * (bflo(x.w) * bflo(y.w)); accv[7] += w1.w * (bfhi(x.w) * bfhi(y.w)); }
        }
        const u32x4 bv = cb[p]; u32x4 o;
        o.x = pk2(bflo(bv.x) * accv[0], bfhi(bv.x) * accv[1]); o.y = pk2(bflo(bv.y) * accv[2], bfhi(bv.y) * accv[3]);
        o.z = pk2(bflo(bv.z) * accv[4], bfhi(bv.z) * accv[5]); o.w = pk2(bflo(bv.w) * accv[6], bfhi(bv.w) * accv[7]);
        cb[p] = o;
    }
}

struct XsSched {
    const char *hn, *wkt; int G, c;
    __device__ __forceinline__ bool next(int i, gg::Unit& u) const {
        const long L = (long)i * G + c; if (L >= 256) return false;
        const int xcd = (int)(L % 8), off = (int)(L / 8), w = xcd * 32 + off;
        const int pm = w >> 2, h = w & 3, b = pm >> 4;
        u.kind = 0; u.pm = pm; u.pn = h; u.aux = 0;
        u.A = hn + (size_t)pm * 256 * D * 2; u.B = wkt + ((size_t)(b * 1024 + h * 256) * D) * 2; return true;
    }
};
struct WkSched {
    const char *kvm, *wqx; int G, c;
    __device__ __forceinline__ bool next(int i, gg::Unit& u) const {
        const long L = (long)i * G + c; if (L >= 256) return false;
        const int bh = (int)(L >> 4), ntile = (int)(L & 15), b = bh >> 2, h = bh & 3;
        u.kind = 0; u.pm = b * 4 + h; u.pn = ntile; u.aux = 0;
        u.A = kvm + ((size_t)(b * 256) * 4096 + h * 512) * 2; u.B = wqx + ((size_t)(ntile * 256) * 2048 + h * 512) * 2; return true;
    }
};
struct WkEpi {
    bf16_t* wkt;
    __device__ __forceinline__ int nst(const gg::Unit& u) const { return 16; }
    __device__ __forceinline__ bool operator()(gg::Acc& acc, const gg::Unit& u, int wr, int wc, int fr, int fq, int wid, int lane) const {
        gg::store_bf16_tile(acc, wkt, D, u.pm * 256, u.pn * 256, wr, wc, fr, fq); return true;
    }
};
struct XsEpi {
    bf16_t* prob; LAS unsigned char* ex;
    __device__ __forceinline__ int nst(const gg::Unit& u) const { return 0; }
    __device__ __forceinline__ bool operator()(gg::Acc& acc, const gg::Unit& u, int wr, int wc, int fr, int fq, int wid, int lane) const {
        LAS float* MX = (LAS float*)ex; LAS float* SM = (LAS float*)(ex + 4096);
        const float sc = 0.04419417382f * 1.44269504089f;
#pragma unroll
        for (int ai = 0; ai < 2; ++ai)
#pragma unroll
            for (int m = 0; m < 4; ++m) { float v = -3.0e38f;
#pragma unroll
                for (int bj = 0; bj < 2; ++bj)
#pragma unroll
                    for (int n = 0; n < 2; ++n) { const f32x4 x = acc[ai][bj][m][n]; v = fmaxf(v, fmaxf(fmaxf(x[0], x[1]), fmaxf(x[2], x[3]))); }
                v = fmaxf(v, __shfl_xor(v, 16)); v = fmaxf(v, __shfl_xor(v, 32));
                if (fq == 0) MX[(ai * 128 + wr * 64 + m * 16 + fr) * 4 + wc] = v; }
        LDS_WAIT(); __builtin_amdgcn_s_barrier(); asm volatile("" ::: "memory");
#pragma unroll
        for (int ai = 0; ai < 2; ++ai)
#pragma unroll
            for (int m = 0; m < 4; ++m) { const f32x4 q = *(const LAS f32x4*)(MX + (ai * 128 + wr * 64 + m * 16 + fr) * 4);
                const float rm = fmaxf(fmaxf(q[0], q[1]), fmaxf(q[2], q[3])); float s = 0.f;
#pragma unroll
                for (int bj = 0; bj < 2; ++bj)
#pragma unroll
                    for (int n = 0; n < 2; ++n) {
#pragma unroll
                        for (int j = 0; j < 4; ++j) { const float e = __builtin_amdgcn_exp2f((acc[ai][bj][m][n][j] - rm) * sc); acc[ai][bj][m][n][j] = e; s += e; } }
                s += __shfl_xor(s, 16); s += __shfl_xor(s, 32);
                if (fq == 0) SM[(ai * 128 + wr * 64 + m * 16 + fr) * 4 + wc] = s; }
        LDS_WAIT(); __builtin_amdgcn_s_barrier(); asm volatile("" ::: "memory");
        const int b = u.pm >> 4, panel = u.pm & 15, h = u.pn;
#pragma unroll
        for (int ai = 0; ai < 2; ++ai)
#pragma unroll
            for (int m = 0; m < 4; ++m) { const f32x4 q = *(const LAS f32x4*)(SM + (ai * 128 + wr * 64 + m * 16 + fr) * 4);
                const float inv = 1.0f / ((q[0] + q[1]) + (q[2] + q[3]));
                bf16_t* rowp = prob + (size_t)(b * SEQ + panel * 256 + ai * 128 + wr * 64 + m * 16 + fr) * 2048 + h * 256 + wc * 32 + 8 * fq;
#pragma unroll
                for (int bj = 0; bj < 2; ++bj) { const f32x4 v0 = acc[ai][bj][m][0] * inv, v1 = acc[ai][bj][m][1] * inv;
                    u32x4 w; w.x = pk2(v0[0], v0[1]); w.y = pk2(v0[2], v0[3]); w.z = pk2(v1[0], v1[1]); w.w = pk2(v1[2], v1[3]);
                    *(u32x4*)(rowp + bj * 128) = w; } }
        return true;
    }
};

__device__ __forceinline__ void gla_scan_unit(Frame& F, const Args& a, int unit) {
    const int dvq = (unit >> 3) & 3, bh = (unit & 7) + 8 * (unit >> 5), h = bh & 3, b = bh >> 2;
    const int lane = F.lane, wid = F.wave, fr = lane & 15, fq = lane >> 4;
    unsigned char* ws = F.ws;
    const unsigned char* blk0 = ws + WS_GLAB + (size_t)((b * 4 + h) * 64) * GLA_BLK;
    const int dvcol = 16 * (8 * dvq + wid);
    const bf16_t* vt = (const bf16_t*)(ws + WS_VT) + (size_t)(h * 512 + dvcol + fr) * T + (size_t)b * SEQ + 8 * fq;
    bf16_t* og = (bf16_t*)(ws + WS_OG) + (size_t)(b * SEQ) * 2048 + h * 512 + dvcol + fr;
    f32x4 S[16];
#pragma unroll
    for (int i = 0; i < 16; ++i) S[i] = (f32x4){0.f, 0.f, 0.f, 0.f};
    for (int p = wid; p < 73; p += 8)
        __builtin_amdgcn_global_load_lds((const unsigned*)(blk0 + (size_t)p * 1024 + lane * 16), (LAS unsigned*)(F.lds + p * 1024), 16, 0, 0);
    bf16x8 vf[2], vn[2];
    vf[0] = *(const bf16x8*)(vt); vf[1] = *(const bf16x8*)(vt + 32);
    vn[0] = vf[0]; vn[1] = vf[1];
    VM_WAIT(); __syncthreads();
    for (int n = 0; n < 64; ++n) {
        LAS unsigned char* buf = F.lds + (n & 1) * GLA_BLK;
        if (n < 63) {
            const unsigned char* nb = blk0 + (size_t)(n + 1) * GLA_BLK; LAS unsigned char* dst = F.lds + ((n + 1) & 1) * GLA_BLK;
            for (int p = wid; p < 73; p += 8)
                __builtin_amdgcn_global_load_lds((const unsigned*)(nb + (size_t)p * 1024 + lane * 16), (LAS unsigned*)(dst + p * 1024), 16, 0, 0);
            vn[0] = *(const bf16x8*)(vt + 64 * (n + 1)); vn[1] = *(const bf16x8*)(vt + 64 * (n + 1) + 32);
        }
        f32x4 o[4];
#pragma unroll
        for (int mb = 0; mb < 4; ++mb) o[mb] = (f32x4){0.f, 0.f, 0.f, 0.f};
#pragma unroll
        for (int kk = 0; kk < 8; ++kk) {
            u32x4 bw; bw.x = pk2(S[2 * kk][0], S[2 * kk][1]); bw.y = pk2(S[2 * kk][2], S[2 * kk][3]); bw.z = pk2(S[2 * kk + 1][0], S[2 * kk + 1][1]); bw.w = pk2(S[2 * kk + 1][2], S[2 * kk + 1][3]);
            const bf16x8 bfr = __builtin_bit_cast(bf16x8, bw);
#pragma unroll
            for (int mb = 0; mb < 4; ++mb) { const bf16x8 af = *(const LAS bf16x8*)(buf + ((mb * 8 + kk) * 64 + lane) * 16);
                o[mb] = __builtin_amdgcn_mfma_f32_16x16x32_bf16(af, bfr, o[mb], 0, 0, 0); }
        }
#pragma unroll
        for (int kk = 0; kk < 2; ++kk)
#pragma unroll
            for (int mb = 0; mb < 4; ++mb) { const bf16x8 af = *(const LAS bf16x8*)(buf + 65536 + ((mb * 2 + kk) * 64 + lane) * 16);
                o[mb] = __builtin_amdgcn_mfma_f32_16x16x32_bf16(af, vf[kk], o[mb], 0, 0, 0); }
        {
            bf16_t* op = og + (size_t)(64 * n) * 2048;
#pragma unroll
            for (int mb = 0; mb < 4; ++mb)
#pragma unroll
                for (int j = 0; j < 4; ++j) op[(size_t)(16 * mb + 4 * fq + j) * 2048] = (bf16_t)f2bf(o[mb][j]);
        }
#pragma unroll
        for (int mb = 0; mb < 16; ++mb) {
            const f32x4 dc = *(const LAS f32x4*)(buf + 73728 + (16 * mb + 4 * fq) * 4);
            S[mb] = S[mb] * dc;
#pragma unroll
            for (int kk = 0; kk < 2; ++kk) { const bf16x8 af = *(const LAS bf16x8*)(buf + 32768 + ((mb * 2 + kk) * 64 + lane) * 16);
                S[mb] = __builtin_amdgcn_mfma_f32_16x16x32_bf16(af, vf[kk], S[mb], 0, 0, 0); }
        }
        vf[0] = vn[0]; vf[1] = vn[1];
        VM_WAIT(); __syncthreads();
    }
}

struct VwSched {
    const char *wxa, *kvm; int G, c;
    __device__ __forceinline__ bool next(int i, gg::Unit& u) const {
        const long L = (long)i * G + c; if (L >= 256) return false;
        const int bh = (int)(L >> 4), pm = (int)(L & 15), b = bh >> 2, h = bh & 3;
        u.kind = 0; u.pm = b * 16 + pm; u.pn = h; u.aux = 0;
        u.A = wxa + ((size_t)(pm * 256) * 2048 + h * 512) * 2; u.B = kvm + ((size_t)(b * 256) * 4096 + 2048 + h * 512) * 2; return true;
    }
};
struct VwEpi {
    bf16_t* vwt;
    __device__ __forceinline__ int nst(const gg::Unit& u) const { return 16; }
    __device__ __forceinline__ bool operator()(gg::Acc& acc, const gg::Unit& u, int wr, int wc, int fr, int fq, int wid, int lane) const {
        gg::store_bf16_tile(acc, vwt, 2048, u.pm * 256, u.pn * 256, wr, wc, fr, fq); return true;
    }
};

__device__ __forceinline__ void gla_post_phase(Frame& F, const Args& a) {
    unsigned char* ws = F.ws;
    const int gw = F.bid * 8 + F.wave, NGW = F.G * 8, lane = F.lane;
    const float* gn = a.in[6];
    const f32x4 g0 = *(const f32x4*)(gn + lane * 8), g1 = *(const f32x4*)(gn + lane * 8 + 4);
    for (int t = gw; t < T; t += NGW) {
        const u32x4* orow = (const u32x4*)((const bf16_t*)(ws + WS_OG) + (size_t)t * 2048); u32x4* rrow = (u32x4*)((bf16_t*)(ws + WS_RG) + (size_t)t * 2048);
#pragma unroll
        for (int h = 0; h < 4; ++h) {
            const u32x4 ov = orow[h * 64 + lane], rv = rrow[h * 64 + lane];
            float o[8] = {bflo(ov.x), bfhi(ov.x), bflo(ov.y), bfhi(ov.y), bflo(ov.z), bfhi(ov.z), bflo(ov.w), bfhi(ov.w)};
            float r[8] = {bflo(rv.x), bfhi(rv.x), bflo(rv.y), bfhi(rv.y), bflo(rv.z), bfhi(rv.z), bflo(rv.w), bfhi(rv.w)};
            float s = 0.f;
#pragma unroll
            for (int j = 0; j < 8; ++j) s += o[j] * o[j];
            const float rstd = rsqrtf(wave_sum(s) * (1.f / 512.f) + EPS);
            const float gv[8] = {g0.x, g0.y, g0.z, g0.w, g1.x, g1.y, g1.z, g1.w};
            float y[8];
#pragma unroll
            for (int j = 0; j < 8; ++j) y[j] = o[j] * rstd * gv[j] * (r[j] * fast_sigmoid(r[j]));
            u32x4 w; w.x = pk2(y[0], y[1]); w.y = pk2(y[2], y[3]); w.z = pk2(y[4], y[5]); w.w = pk2(y[6], y[7]);
            rrow[h * 64 + lane] = w;
        }
    }
}

struct MgSched {
    const char *a0, *a1, *a2, *wbr, *vwt; int G, c;
    __device__ __forceinline__ bool next(int i, gg::Unit& u) const {
        const int ti = i / 3, br = i - 3 * ti; int pm, pn;
        if (!gg::tile_order((long)ti * G + c, 64, 16, pm, pn)) return false;
        u.kind = br; u.pm = pm; u.pn = pn; u.aux = br == 2 ? 16 : 32;
        const char* ab = br == 0 ? a0 : (br == 1 ? a1 : a2);
        u.A = ab + (size_t)pm * 256 * 2048 * 2;
        u.B = br == 2 ? vwt + ((size_t)((pm >> 4) * 4096 + pn * 256) * 2048) * 2 : wbr + (size_t)br * 16 * MiB + (size_t)pn * 256 * 2048 * 2; return true;
    }
};
struct MgEpi {
    const bf16_t* gt; bf16_t* merged;
    __device__ __forceinline__ int nst(const gg::Unit& u) const { return u.kind == 2 ? 16 : 0; }
    __device__ __forceinline__ bool operator()(gg::Acc& acc, const gg::Unit& u, int wr, int wc, int fr, int fq, int wid, int lane) const {
        const int br = u.kind;
#pragma unroll
        for (int ai = 0; ai < 2; ++ai) {
            u32x4 ga[4][2], gb[4][2];
#pragma unroll
            for (int m = 0; m < 4; ++m) { const size_t row = (size_t)(u.pm * 256 + ai * 128 + wr * 64 + m * 16 + fr);
#pragma unroll
                for (int bj = 0; bj < 2; ++bj) { const int col = u.pn * 256 + bj * 128 + wc * 32 + 8 * fq;
                    ga[m][bj] = *(const u32x4*)(gt + row * 12288 + br * 4096 + col);
                    gb[m][bj] = (br < 2) ? *(const u32x4*)(gt + row * 12288 + (br + 1) * 4096 + col) : (u32x4){0x3f803f80u, 0x3f803f80u, 0x3f803f80u, 0x3f803f80u}; } }
#pragma unroll
            for (int m = 0; m < 4; ++m) { const size_t row = (size_t)(u.pm * 256 + ai * 128 + wr * 64 + m * 16 + fr);
#pragma unroll
                for (int bj = 0; bj < 2; ++bj) { const int col = u.pn * 256 + bj * 128 + wc * 32 + 8 * fq;
                    const u32x4 a4 = ga[m][bj], b4 = gb[m][bj];
                    float g[8] = {bflo(a4.x), bfhi(a4.x), bflo(a4.y), bfhi(a4.y), bflo(a4.z), bfhi(a4.z), bflo(a4.w), bfhi(a4.w)};
                    if (br < 2) { const float d[8] = {bflo(b4.x), bfhi(b4.x), bflo(b4.y), bfhi(b4.y), bflo(b4.z), bfhi(b4.z), bflo(b4.w), bfhi(b4.w)};
#pragma unroll
                        for (int j = 0; j < 8; ++j) g[j] = d[j] * __builtin_amdgcn_rcpf(g[j]); }
                    else {
#pragma unroll
                        for (int j = 0; j < 8; ++j) g[j] = __builtin_amdgcn_rcpf(g[j]); }
                    f32x4 v0 = acc[ai][bj][m][0], v1 = acc[ai][bj][m][1];
                    v0[0] *= g[0]; v0[1] *= g[1]; v0[2] *= g[2]; v0[3] *= g[3]; v1[0] *= g[4]; v1[1] *= g[5]; v1[2] *= g[6]; v1[3] *= g[7];
                    if (br < 2) { acc[ai][bj][m][0] = v0; acc[ai][bj][m][1] = v1; }
                    else { u32x4 w; w.x = pk2(v0[0], v0[1]); w.y = pk2(v0[2], v0[3]); w.z = pk2(v1[0], v1[1]); w.w = pk2(v1[2], v1[3]);
                        *(u32x4*)(merged + row * D + col) = w; } } }
        }
        return br == 2;
    }
};

struct GridSched {
    const char *A, *B; int nM, nN, lda2, ldb2, G, c;
    __device__ __forceinline__ bool next(int i, gg::Unit& u) const {
        int pm, pn; if (!gg::tile_order((long)i * G + c, nM, nN, pm, pn)) return false;
        u.kind = 0; u.pm = pm; u.pn = pn; u.aux = 0; u.A = A + (size_t)pm * 256 * lda2; u.B = B + (size_t)pn * 256 * ldb2; return true;
    }
};
struct ResEpi {
    const float* x; bf16_t* x1b;
    __device__ __forceinline__ int nst(const gg::Unit& u) const { return 16; }
    __device__ __forceinline__ bool operator()(gg::Acc& acc, const gg::Unit& u, int wr, int wc, int fr, int fq, int wid, int lane) const {
#pragma unroll
        for (int ai = 0; ai < 2; ++ai) {
            f32x4 xv[4][2][2];
#pragma unroll
            for (int m = 0; m < 4; ++m) { const size_t off = (size_t)(u.pm * 256 + ai * 128 + wr * 64 + m * 16 + fr) * D + u.pn * 256 + wc * 32 + 8 * fq;
#pragma unroll
                for (int bj = 0; bj < 2; ++bj) { xv[m][bj][0] = *(const f32x4*)(x + off + bj * 128); xv[m][bj][1] = *(const f32x4*)(x + off + bj * 128 + 4); } }
#pragma unroll
            for (int m = 0; m < 4; ++m) { const size_t off = (size_t)(u.pm * 256 + ai * 128 + wr * 64 + m * 16 + fr) * D + u.pn * 256 + wc * 32 + 8 * fq;
#pragma unroll
                for (int bj = 0; bj < 2; ++bj) { const f32x4 v0 = xv[m][bj][0] + acc[ai][bj][m][0], v1 = xv[m][bj][1] + acc[ai][bj][m][1];
                    u32x4 w; w.x = pk2(v0[0], v0[1]); w.y = pk2(v0[2], v0[3]); w.z = pk2(v1[0], v1[1]); w.w = pk2(v1[2], v1[3]);
                    *(u32x4*)(x1b + off + bj * 128) = w; } }
        }
        return true;
    }
};
struct PqEpi {
    bf16_t* o; const float* rs; const float* cs;
    __device__ __forceinline__ int nst(const gg::Unit& u) const { return 16; }
    __device__ __forceinline__ bool operator()(gg::Acc& acc, const gg::Unit& u, int wr, int wc, int fr, int fq, int wid, int lane) const {
        const int row0 = u.pm * 256, col0 = u.pn * 256;
        float rvv[2][4]; f32x4 cv[2][2];
#pragma unroll
        for (int ai = 0; ai < 2; ++ai)
#pragma unroll
            for (int m = 0; m < 4; ++m) rvv[ai][m] = rs[row0 + ai * 128 + wr * 64 + m * 16 + fr];
#pragma unroll
        for (int bj = 0; bj < 2; ++bj) { const float* cp = cs + col0 + bj * 128 + wc * 32 + 8 * fq; cv[bj][0] = *(const f32x4*)cp; cv[bj][1] = *(const f32x4*)(cp + 4); }
#pragma unroll
        for (int bj = 0; bj < 2; ++bj) { const f32x4 c0v = cv[bj][0], c1v = cv[bj][1];
#pragma unroll
            for (int ai = 0; ai < 2; ++ai)
#pragma unroll
                for (int m = 0; m < 4; ++m) { const int r = row0 + ai * 128 + wr * 64 + m * 16 + fr; const float rv = rvv[ai][m];
                    const i32x4 i0 = __builtin_bit_cast(i32x4, acc[ai][bj][m][0]), i1 = __builtin_bit_cast(i32x4, acc[ai][bj][m][1]);
                    const f32x4 v0 = (f32x4){(float)i0[0], (float)i0[1], (float)i0[2], (float)i0[3]} * (c0v * rv), v1 = (f32x4){(float)i1[0], (float)i1[1], (float)i1[2], (float)i1[3]} * (c1v * rv);
                    u32x4 w; w.x = pk2(v0[0], v0[1]); w.y = pk2(v0[2], v0[3]); w.z = pk2(v1[0], v1[1]); w.w = pk2(v1[2], v1[3]);
                    *(u32x4*)(o + (size_t)r * 2048 + col0 + bj * 128 + wc * 32 + 8 * fq) = w; } }
        return true;
    }
};
struct Bf16Epi {
    bf16_t* o; int ldc;
    __device__ __forceinline__ int nst(const gg::Unit& u) const { return 16; }
    __device__ __forceinline__ bool operator()(gg::Acc& acc, const gg::Unit& u, int wr, int wc, int fr, int fq, int wid, int lane) const {
        gg::store_bf16_tile(acc, o, ldc, u.pm * 256, u.pn * 256, wr, wc, fr, fq); return true;
    }
};

__device__ __forceinline__ int f2ord(float f) { const int b = __float_as_int(f); return b ^ ((b >> 31) & 0x7fffffff); }
__device__ __forceinline__ float ord2f(int o) { return __int_as_float(o ^ ((o >> 31) & 0x7fffffff)); }
__device__ __forceinline__ void cex_desc(int& hi, int& lo) { const int a = hi, b = lo; hi = a > b ? a : b; lo = a > b ? b : a; }
__device__ __forceinline__ void bsort16_desc(int (&a)[16]) {
#pragma unroll
    for (int k = 2; k <= 16; k <<= 1)
#pragma unroll
        for (int j = k >> 1; j > 0; j >>= 1)
#pragma unroll
            for (int i = 0; i < 16; ++i) { const int l = i ^ j; if (l > i) { if ((i & k) == 0) cex_desc(a[i], a[l]); else cex_desc(a[l], a[i]); } }
}
__device__ __forceinline__ void bmerge16_desc(int (&a)[16]) {
#pragma unroll
    for (int j = 8; j > 0; j >>= 1)
#pragma unroll
        for (int i = 0; i < 16; ++i) { const int l = i ^ j; if (l > i) cex_desc(a[i], a[l]); }
}
__device__ __forceinline__ void top16_merge(int (&a)[16], const int (&b)[16]) {
#pragma unroll
    for (int i = 0; i < 16; ++i) a[i] = a[i] > b[15 - i] ? a[i] : b[15 - i];
    bmerge16_desc(a);
}
constexpr int RT_SKROW = 272;
constexpr int RT_SK = 2 * 128 * RT_SKROW;
__device__ __forceinline__ void route_topk16(const f32x4 (&acc)[8], int fq, int (&res)[16]) {
    int a[16], b[16];
#pragma unroll
    for (int mb = 0; mb < 4; ++mb)
#pragma unroll
        for (int j = 0; j < 4; ++j) { a[mb * 4 + j] = (f2ord(acc[mb][j]) & ~127) | (127 - (16 * mb + 4 * fq + j)); b[mb * 4 + j] = (f2ord(acc[mb + 4][j]) & ~127) | (127 - (16 * (mb + 4) + 4 * fq + j)); }
    bsort16_desc(a); bsort16_desc(b); top16_merge(a, b);
#pragma unroll
    for (int x = 16; x <= 32; x <<= 1) {
#pragma unroll
        for (int i = 0; i < 16; ++i) b[i] = __shfl_xor(a[i], x);
        top16_merge(a, b);
    }
#pragma unroll
    for (int i = 0; i < 16; ++i) res[i] = a[i];
}
__device__ __forceinline__ void route_job(Frame& F, const Args& a, int job) {
    unsigned char* ws = F.ws;
    const int tid = F.tid, lane = F.lane, wid = F.wave, fr = lane & 15, fq = lane >> 4;
    const int h = job & 7, chunk = job >> 3;
    const bf16_t* pq = (const bf16_t*)(ws + WS_PQ); const bf16_t* sk = (const bf16_t*)(ws + WS_SUBK) + (size_t)h * 2 * 128 * 128;
    for (int p = tid; p < 4096; p += 512) { const int row = p >> 4, pc = p & 15; *(LAS u32x4*)(F.lds + row * RT_SKROW + pc * 16) = ((const u32x4*)sk)[p]; }
    __syncthreads();
    LAS int* IX = (LAS int*)(F.lds + RT_SK) + wid * 512;
#pragma unroll 1
    for (int it = 0; it < 4; ++it) {
        const int tok0 = (chunk * 32 + wid * 4 + it) * 16;
        int top[2][16];
#pragma unroll
        for (int c = 0; c < 2; ++c) {
            f32x4 acc[8];
#pragma unroll
            for (int mb = 0; mb < 8; ++mb) acc[mb] = (f32x4){0.f, 0.f, 0.f, 0.f};
            bf16x8 bfr[4];
#pragma unroll
            for (int kk = 0; kk < 4; ++kk) bfr[kk] = *(const bf16x8*)(pq + (size_t)(tok0 + fr) * 2048 + h * 256 + c * 128 + 32 * kk + 8 * fq);
#pragma unroll
            for (int kk = 0; kk < 4; ++kk)
#pragma unroll
                for (int mb = 0; mb < 8; ++mb) { const bf16x8 af = *(const LAS bf16x8*)(F.lds + (c * 128 + 16 * mb + fr) * RT_SKROW + (32 * kk + 8 * fq) * 2);
                    acc[mb] = __builtin_amdgcn_mfma_f32_16x16x32_bf16(af, bfr[kk], acc[mb], 0, 0, 0); }
            route_topk16(acc, fq, top[c]);
        }
        float f0[16], f1[16];
#pragma unroll
        for (int i = 0; i < 16; ++i) { f0[i] = ord2f(top[0][i] & ~127); f1[i] = ord2f(top[1][i] & ~127); }
        int g[4][16];
#pragma unroll
        for (int q = 0; q < 4; ++q)
#pragma unroll
            for (int i = 0; i < 16; ++i) g[q][i] = (int)0x80000000;
        {
            int nc = 0;
#pragma unroll
            for (int i = 0; i < 16; ++i)
#pragma unroll
                for (int j = 0; j < 16; ++j) if ((i + 1) * (j + 1) <= 16) { g[nc >> 4][nc & 15] = (f2ord(f0[i] + f1[j]) & ~255) | (255 - (i * 16 + j)); ++nc; }
        }
        bsort16_desc(g[0]); bsort16_desc(g[1]); bsort16_desc(g[2]); bsort16_desc(g[3]);
        top16_merge(g[0], g[1]); top16_merge(g[2], g[3]); top16_merge(g[0], g[2]);
        if (fq == 0) {
#pragma unroll
            for (int i = 0; i < 16; ++i) { IX[fr * 32 + i] = 127 - (top[0][i] & 127); IX[fr * 32 + 16 + i] = 127 - (top[1][i] & 127); }
        }
        LDS_WAIT(); asm volatile("" ::: "memory");
        if (fq == 0) {
            const float vmax = ord2f(g[0][0] & ~255); float e[16]; float s = 0.f; int ex[16];
#pragma unroll
            for (int r = 0; r < 16; ++r) { e[r] = __expf(ord2f(g[0][r] & ~255) - vmax); s += e[r]; const int ij = 255 - (g[0][r] & 255); ex[r] = IX[fr * 32 + (ij >> 4)] * 128 + IX[fr * 32 + 16 + (ij & 15)]; }
            const float inv = 1.0f / s;
            int* eidx = (int*)(ws + WS_EIDX) + (size_t)(tok0 + fr) * 128 + h * 16; float* gw = (float*)(ws + WS_GW) + (size_t)(tok0 + fr) * 128 + h * 16;
#pragma unroll
            for (int q = 0; q < 4; ++q) { *(u32x4*)(eidx + 4 * q) = (u32x4){(unsigned)ex[4 * q], (unsigned)ex[4 * q + 1], (unsigned)ex[4 * q + 2], (unsigned)ex[4 * q + 3]};
                *(f32x4*)(gw + 4 * q) = (f32x4){e[4 * q] * inv, e[4 * q + 1] * inv, e[4 * q + 2] * inv, e[4 * q + 3] * inv}; }
        }
        LDS_WAIT(); asm volatile("" ::: "memory");
    }
    __syncthreads();
}

__device__ __forceinline__ float ub0(unsigned w) { return (float)(w & 255u); }
__device__ __forceinline__ float ub1(unsigned w) { return (float)((w >> 8) & 255u); }
__device__ __forceinline__ float ub2(unsigned w) { return (float)((w >> 16) & 255u); }
__device__ __forceinline__ float ub3(unsigned w) { return (float)(w >> 24); }
#define P10_LOADU(buf, kbase) do { _Pragma("unroll") for (int r = 0; r < 4; ++r) { const int k_ = (kbase) + r; const int e_ = __builtin_amdgcn_readlane(k_ < 64 ? ev0 : ev1, k_ & 63); \
        const u32x4* rp_ = (const u32x4*)(ub + (size_t)e_ * 2048); buf[r][0] = rp_[lane]; buf[r][1] = rp_[64 + lane]; } } while (0)
#define P10_COMPU(buf, kbase) do { _Pragma("unroll") for (int r = 0; r < 4; ++r) { int s_ = 0; \
        _Pragma("unroll") for (int p = 0; p < 2; ++p) { const unsigned x0 = buf[r][p].x, x1 = buf[r][p].y, x2 = buf[r][p].z, x3 = buf[r][p].w; \
            s_ = __builtin_amdgcn_sdot4((int)(x0 & 0x0F0F0F0Fu), (int)hv[p][0].x, s_, false); s_ = __builtin_amdgcn_sdot4((int)((x0 >> 4) & 0x0F0F0F0Fu), (int)hv[p][0].y, s_, false); \
            s_ = __builtin_amdgcn_sdot4((int)(x1 & 0x0F0F0F0Fu), (int)hv[p][0].z, s_, false); s_ = __builtin_amdgcn_sdot4((int)((x1 >> 4) & 0x0F0F0F0Fu), (int)hv[p][0].w, s_, false); \
            s_ = __builtin_amdgcn_sdot4((int)(x2 & 0x0F0F0F0Fu), (int)hv[p][1].x, s_, false); s_ = __builtin_amdgcn_sdot4((int)((x2 >> 4) & 0x0F0F0F0Fu), (int)hv[p][1].y, s_, false); \
            s_ = __builtin_amdgcn_sdot4((int)(x3 & 0x0F0F0F0Fu), (int)hv[p][1].z, s_, false); s_ = __builtin_amdgcn_sdot4((int)((x3 >> 4) & 0x0F0F0F0Fu), (int)hv[p][1].w, s_, false); } \
        _Pragma("unroll") for (int o_ = 1; o_ < 64; o_ <<= 1) s_ += __shfl_xor(s_, o_); \
        const int k_ = (kbase) + r; const float av_ = (float)s_; if (k_ < 64) { if (lane == k_) a0 = av_; } else { if (lane == k_ - 64) a1 = av_; } } } while (0)
#define P10_LOADV(buf, kbase) do { _Pragma("unroll") for (int r = 0; r < 4; ++r) { const int k_ = (kbase) + r; const int e_ = __builtin_amdgcn_readlane(k_ < 64 ? ev0 : ev1, k_ & 63); \
        const u32x4* rp_ = (const u32x4*)(vb + (size_t)e_ * 2048); buf[r][0] = rp_[lane]; buf[r][1] = rp_[64 + lane]; } } while (0)
#define P10_COMPV(buf, grp) do { const int wq_ = __builtin_amdgcn_readlane(wqv, (grp)); \
        _Pragma("unroll") for (int p = 0; p < 2; ++p) { const unsigned xr_[4][4] = {{buf[0][p].x, buf[0][p].y, buf[0][p].z, buf[0][p].w}, {buf[1][p].x, buf[1][p].y, buf[1][p].z, buf[1][p].w}, {buf[2][p].x, buf[2][p].y, buf[2][p].z, buf[2][p].w}, {buf[3][p].x, buf[3][p].y, buf[3][p].z, buf[3][p].w}}; \
            _Pragma("unroll") for (int d = 0; d < 4; ++d) { int* oo = o + 32 * p + 8 * d; \
                _Pragma("unroll") for (int h = 0; h < 2; ++h) { \
                    const unsigned b0 = (xr_[0][d] >> (4 * h)) & 0x0F0F0F0Fu, b1 = (xr_[1][d] >> (4 * h)) & 0x0F0F0F0Fu, b2 = (xr_[2][d] >> (4 * h)) & 0x0F0F0F0Fu, b3 = (xr_[3][d] >> (4 * h)) & 0x0F0F0F0Fu; \
                    const unsigned a01 = __builtin_amdgcn_perm(b1, b0, 0x05010400u), c01 = __builtin_amdgcn_perm(b1, b0, 0x07030602u), a23 = __builtin_amdgcn_perm(b3, b2, 0x05010400u), c23 = __builtin_amdgcn_perm(b3, b2, 0x07030602u); \
                    const unsigned t0 = __builtin_amdgcn_perm(a23, a01, 0x05040100u), t1 = __builtin_amdgcn_perm(a23, a01, 0x07060302u), t2 = __builtin_amdgcn_perm(c23, c01, 0x05040100u), t3 = __builtin_amdgcn_perm(c23, c01, 0x07060302u); \
                    oo[0 + h] = __builtin_amdgcn_sdot4((int)t0, wq_, oo[0 + h], false); oo[2 + h] = __builtin_amdgcn_sdot4((int)t1, wq_, oo[2 + h], false); \
                    oo[4 + h] = __builtin_amdgcn_sdot4((int)t2, wq_, oo[4 + h], false); oo[6 + h] = __builtin_amdgcn_sdot4((int)t3, wq_, oo[6 + h], false); } } } } while (0)
__device__ __forceinline__ void peer_token_wave(const Args& a, unsigned char* ws, int tok, int lane) {
    const int* eidx = (const int*)(ws + WS_EIDX) + (size_t)tok * 128; const float* gw = (const float*)(ws + WS_GW) + (size_t)tok * 128;
    const int ev0 = eidx[lane], ev1 = eidx[64 + lane];
    u32x4 hv[2][2];
    const u32x4* hrow = (const u32x4*)(ws + WS_H8 + (size_t)tok * D);
#pragma unroll
    for (int p = 0; p < 2; ++p) { hv[p][0] = hrow[128 * p + 2 * lane]; hv[p][1] = hrow[128 * p + 2 * lane + 1]; }
    const float sh = ((const float*)(ws + WS_SH))[tok], shs = ((const float*)(ws + WS_SHS))[tok];
    const unsigned char* ub = ws + WS_UB; const float* su = (const float*)(ws + WS_SU); const float* sv = (const float*)(ws + WS_SV);
    float a0 = 0.f, a1 = 0.f;
    {
        u32x4 ua[4][2], uc[4][2];
        P10_LOADU(ua, 0);
#pragma unroll 1
        for (int kb = 0; kb < 128; kb += 8) {
            P10_LOADU(uc, kb + 4);
            P10_COMPU(ua, kb);
            P10_LOADU(ua, (kb + 8) & 127);
            P10_COMPU(uc, kb + 4);
        }
    }
    float w0, w1;
    { const float x0 = (a0 - 8.0f * shs) * su[ev0] * sh, x1 = (a1 - 8.0f * shs) * su[ev1] * sh;
      w0 = gw[lane] * 0.5f * x0 * (1.0f + erff(x0 * 0.70710678118f)) * sv[ev0]; w1 = gw[64 + lane] * 0.5f * x1 * (1.0f + erff(x1 * 0.70710678118f)) * sv[ev1]; }
    const float wmax = fmaxf(wave_max(fmaxf(fabsf(w0), fabsf(w1))), 1e-30f), sw = wmax * (1.0f / 127.0f), winv = 127.0f / wmax;
    const int q0 = (int)rintf(w0 * winv), q1 = (int)rintf(w1 * winv);
    int qsum = q0 + q1;
#pragma unroll
    for (int o_ = 1; o_ < 64; o_ <<= 1) qsum += __shfl_xor(qsum, o_);
    int wqv;
    { const int base = (lane & 15) * 4;
      const int s0 = __shfl(lane < 16 ? q0 : q1, base + 0), s1 = __shfl(lane < 16 ? q0 : q1, base + 1), s2 = __shfl(lane < 16 ? q0 : q1, base + 2), s3 = __shfl(lane < 16 ? q0 : q1, base + 3);
      const int a0_ = __shfl(q0, base + 0), a1_ = __shfl(q0, base + 1), a2_ = __shfl(q0, base + 2), a3_ = __shfl(q0, base + 3);
      const int b0_ = __shfl(q1, base + 0), b1_ = __shfl(q1, base + 1), b2_ = __shfl(q1, base + 2), b3_ = __shfl(q1, base + 3);
      (void)s0; (void)s1; (void)s2; (void)s3;
      const bool lowhalf = (lane & 31) < 16;
      const int c0 = lowhalf ? a0_ : b0_, c1 = lowhalf ? a1_ : b1_, c2 = lowhalf ? a2_ : b2_, c3 = lowhalf ? a3_ : b3_;
      wqv = (c0 & 255) | ((c1 & 255) << 8) | ((c2 & 255) << 16) | ((c3 & 255) << 24); }
    int o[64];
#pragma unroll
    for (int j = 0; j < 64; ++j) o[j] = 0;
    const unsigned char* vb = ws + WS_VB;
    {
        u32x4 va[4][2], vc[4][2];
        P10_LOADV(va, 0);
#pragma unroll 1
        for (int kb = 0; kb < 128; kb += 8) {
            P10_LOADV(vc, kb + 4);
            P10_COMPV(va, kb >> 2);
            P10_LOADV(va, (kb + 8) & 127);
            P10_COMPV(vc, (kb >> 2) + 1);
        }
    }
    float* orow = a.out + (size_t)tok * D; const bf16_t* xrow = (const bf16_t*)(ws + WS_X1B) + (size_t)tok * D; float s = 0.f; const int corr = 8 * qsum; float y[64];
#pragma unroll
    for (int p = 0; p < 2; ++p)
#pragma unroll
        for (int q = 0; q < 8; ++q) { const u32x2 xu = *(const u32x2*)(xrow + 2048 * p + 32 * lane + 4 * q); const f32x4 x = (f32x4){bflo(xu.x), bfhi(xu.x), bflo(xu.y), bfhi(xu.y)}; const int* oo = o + 32 * p + 4 * q; float* yy = y + 32 * p + 4 * q;
            yy[0] = x.x + sw * (float)(oo[0] - corr); yy[1] = x.y + sw * (float)(oo[1] - corr); yy[2] = x.z + sw * (float)(oo[2] - corr); yy[3] = x.w + sw * (float)(oo[3] - corr);
            s += (yy[0] * yy[0] + yy[1] * yy[1]) + (yy[2] * yy[2] + yy[3] * yy[3]); }
    const float rstd = rsqrtf(wave_sum(s) * (1.f / D) + EPS);
#pragma unroll
    for (int p = 0; p < 2; ++p)
#pragma unroll
        for (int q = 0; q < 8; ++q) { const f32x4 g = *(const f32x4*)(a.in[20] + 2048 * p + 32 * lane + 4 * q); const float* yy = y + 32 * p + 4 * q;
            *(f32x4*)(orow + 2048 * p + 32 * lane + 4 * q) = (f32x4){yy[0] * rstd * g.x, yy[1] * rstd * g.y, yy[2] * rstd * g.z, yy[3] * rstd * g.w}; }
}

__global__ void __launch_bounds__(512, 2) mega_fwd(Args args) {
    extern __shared__ __attribute__((aligned(16))) unsigned char lds_raw[];
    Frame F;
    F.lds = (LAS unsigned char*)lds_raw;
    F.tid = threadIdx.x; F.lane = F.tid & 63; F.wave = __builtin_amdgcn_readfirstlane(F.tid >> 6);
    F.G = gridDim.x; F.bid = blockIdx.x; F.ws = args.ws;
    unsigned char* ws = args.ws;
    if (F.tid < 64) ((LAS unsigned*)(F.lds + LDS_MISC))[F.tid] = 0u;
    __syncthreads();
    XcdBarrier bar = xcd_barrier_post((unsigned*)(ws + WS_CTL) + 4096, (volatile LAS unsigned*)(F.lds + LDS_MISC + 32));

    F.refresh();
    p0_weights8(F, args);
    F.refresh();
    p0_prologue_a(F, args);
    xcd_barrier(bar);
    {
        P1Sched S{(const char*)(ws + WS_HN), (const char*)(ws + WS_W8), (const char*)(ws + WS_WAL), (const char*)(ws + WS_MEMN), (const char*)(ws + WS_WKV), F.G, F.bid};
        P1Epi E{ws, args.in[12]};
        gg::gemm_phase<0>(F.lds, D * 2, D * 2, 64, S, E);
        I8Sched S8{(const char*)(ws + WS_HN8), (const char*)(ws + WS_W8), F.G, F.bid};
        I8Epi E8{ws, args.in[12]};
        gg::gemm_phase<2, true>(F.lds, D, D, 32, S8, E8);
        xcd_barrier(bar);
    }
    F.refresh();
    for (int u = F.bid; u < 512; u += F.G) gla_prep_unit(F, args, u);
    {
        WkSched Sk{(const char*)(ws + WS_KVM), (const char*)(ws + WS_WQX), F.G, F.bid};
        WkEpi Ek{(bf16_t*)(ws + WS_WKT)};
        gg::gemm_phase<0>(F.lds, 8192, 4096, 8, Sk, Ek);
        VwSched Sv{(const char*)(ws + WS_WBR + 32 * MiB), (const char*)(ws + WS_KVM), F.G, F.bid};
        VwEpi Ev{(bf16_t*)(ws + WS_VWT)};
        gg::gemm_phase<0>(F.lds, 4096, 8192, 8, Sv, Ev);
    }
    xcd_barrier(bar);
    F.refresh();
    {
        {
            XsSched S{(const char*)(ws + WS_HN), (const char*)(ws + WS_WKT), F.G, F.bid};
            XsEpi E{(bf16_t*)(ws + WS_PROB), F.lds + LDS_EX};
            gg::gemm_phase<0>(F.lds, D * 2, D * 2, 64, S, E);
        }
        const int nscan = F.G >= 128 ? 64 : 0;
        if (nscan) { if (F.bid < 64) gla_scan_unit(F, args, F.bid); }
        else for (int u = F.bid; u < 64; u += F.G) gla_scan_unit(F, args, u);
        { const int nq = nscan ? F.G - 64 : F.G, cq = nscan ? F.bid - 64 : F.bid;
          if (cq >= 0) for (int e = cq * 8 + F.wave; e < 16384; e += nq * 8) {
              quant_row_i4(args.in[18] + (size_t)e * D, ws + WS_UB + (size_t)e * 2048, (float*)(ws + WS_SU) + e, F.lane);
              quant_row_i4(args.in[19] + (size_t)e * D, ws + WS_VB + (size_t)e * 2048, (float*)(ws + WS_SV) + e, F.lane); }
          if (cq >= 0) conv_phase(F, args, cq, nq); }
    }
    xcd_barrier(bar);
    F.refresh();
    gla_post_phase(F, args);
    F.refresh();
    peer_wq_convert(F, args);
    xcd_barrier(bar);
    {
        MgSched S{(const char*)(ws + WS_RG), (const char*)(ws + WS_CB), (const char*)(ws + WS_PROB), (const char*)(ws + WS_WBR), (const char*)(ws + WS_VWT), F.G, F.bid};
        MgEpi E{(const bf16_t*)(ws + WS_GT), (bf16_t*)(ws + WS_MERGED)};
        gg::gemm_phase<0, true>(F.lds, 4096, 4096, 32, S, E);
    }
    xcd_barrier(bar);
    {
        GridSched S{(const char*)(ws + WS_MERGED), (const char*)(ws + WS_WO), 64, 16, D * 2, D * 2, F.G, F.bid};
        ResEpi E{args.in[0], (bf16_t*)(ws + WS_X1B)};
        gg::gemm_phase<0, true>(F.lds, D * 2, D * 2, 64, S, E);
    }
    xcd_barrier(bar);
    F.refresh();
    {
        const int gw = F.bid * 8 + F.wave, NGW = F.G * 8;
        for (int m = gw; m < T; m += NGW) rms_row_i8((const bf16_t*)(ws + WS_X1B) + (size_t)m * D, args.in[15], ws + WS_H8 + (size_t)m * D, (float*)(ws + WS_SH) + m, (float*)(ws + WS_SHS) + m, F.lane);
    }
    xcd_barrier(bar);
    {
        GridSched S{(const char*)(ws + WS_H8), (const char*)(ws + WS_WPQ), 64, 8, D, D, F.G, F.bid};
        PqEpi E{(bf16_t*)(ws + WS_PQ), (const float*)(ws + WS_SH), (const float*)(ws + WS_SWPQ)};
        gg::gemm_phase<2, true>(F.lds, D, D, 32, S, E);
    }
    xcd_barrier(bar);
    F.refresh();
    for (int u = F.bid; u < 256; u += F.G) route_job(F, args, u);
    xcd_barrier(bar);
    F.refresh();
    for (int tok = F.bid * 8 + F.wave; tok < T; tok += F.G * 8) peer_token_wave(args, ws, tok, F.lane);
}


extern "C" void kernel_launch(void* const* d_in, const int* in_sizes, int n_in, void* d_out, int out_size, void* d_ws, size_t ws_size, hipStream_t stream) {
    static int grid = 0;
    if (grid == 0) {
        if (n_in != 21 || ws_size < WS_END) { fprintf(stderr, "kernel_launch: unexpected inputs (n_in %d, ws %zu < %zu)\n", n_in, ws_size, (size_t)WS_END); grid = -1; return; }
        int dev = 0, cus = 0, per_cu = 0;
        if (hipGetDevice(&dev) != hipSuccess || hipDeviceGetAttribute(&cus, hipDeviceAttributeMultiprocessorCount, dev) != hipSuccess) { grid = -1; return; }
        if (hipFuncSetAttribute((const void*)mega_fwd, hipFuncAttributeMaxDynamicSharedMemorySize, LDS_BYTES) != hipSuccess) { fprintf(stderr, "kernel_launch: hipFuncSetAttribute failed\n"); grid = -1; return; }
        if (hipOccupancyMaxActiveBlocksPerMultiprocessor(&per_cu, (const void*)mega_fwd, 512, LDS_BYTES) != hipSuccess || per_cu < 1)
            fprintf(stderr, "kernel_launch: occupancy query says %d\n", per_cu);
        (void)hipGetLastError();
        grid = cus;
    }
    if (grid < 0) return;
    Args a{};
    for (int i = 0; i < 21; ++i) a.in[i] = (const float*)d_in[i];
    a.out = (float*)d_out; a.ws = (unsigned char*)d_ws;
    hipMemsetAsync((char*)d_ws + WS_CTL, 0, CTL_BYTES, stream);
    hipLaunchKernelGGL(mega_fwd, dim3(grid), dim3(512), LDS_BYTES, stream, a);
}
```

```cpp
#include <hip/hip_runtime.h>
#include <cstdio>
#include <cstdint>

#define LAS __attribute__((address_space(3)))
typedef unsigned short bf16_t;
typedef short bf16x8 __attribute__((ext_vector_type(8)));
typedef float f32x4 __attribute__((ext_vector_type(4)));
typedef float f32x2 __attribute__((ext_vector_type(2)));
typedef unsigned u32x4 __attribute__((ext_vector_type(4)));
typedef unsigned u32x2 __attribute__((ext_vector_type(2)));
typedef __bf16 bf16x2v __attribute__((ext_vector_type(2)));
typedef int i32x8 __attribute__((ext_vector_type(8)));
typedef int i32x4 __attribute__((ext_vector_type(4)));
typedef unsigned u32x8 __attribute__((ext_vector_type(8)));

constexpr int T = 16384, D = 4096, SEQ = 4096, NBATCH = 4, MEMT = 1024;
constexpr int NPAD = 26880;
constexpr int O_QG = 0, O_KG = 1024, O_VG = 2048, O_RG = 4096, O_CB = 6144, O_CC = 8192, O_CH = 10240, O_QX = 12288, O_GT = 14336, O_AL = 26624;
constexpr float EPS = 1e-6f;
constexpr int GLA_BLK = 74752;

#ifndef I8_MASK
#define I8_MASK 0x7f
#endif
constexpr int SEG_START[9] = {0, 2048, 4096, 6144, 8192, 10240, 12288, 14336, 26624};
constexpr int SEG_BIT[8] = {0, 1, 2, 3, 4, 5, -1, 6};
constexpr bool seg_i8(int s) { return SEG_BIT[s] >= 0 && ((I8_MASK >> SEG_BIT[s]) & 1); }
constexpr size_t seg_pitch(int s) { return SEG_BIT[s] < 0 ? 0 : (seg_i8(s) ? 4096 : 8192); }
constexpr size_t seg_off(int s) { size_t o = 0; for (int t = 0; t < s; ++t) o += (size_t)(SEG_START[t + 1] - SEG_START[t]) * seg_pitch(t); return o; }
constexpr bool V_I8 = seg_i8(1);
constexpr int count_tiles(bool want8) { int n = 0; for (int s = 0; s < 8; ++s) if (s != 1 && SEG_BIT[s] >= 0 && seg_i8(s) == want8) n += (SEG_START[s + 1] - SEG_START[s]) / 256; return n; }
constexpr int NT8 = count_tiles(true), NTB = count_tiles(false);
constexpr int NU_B = 64 * NTB + 64 + (V_I8 ? 0 : 512) + 64, NU_8 = 64 * NT8 + (V_I8 ? 512 : 0);
__device__ __forceinline__ size_t w_row_off(int n) {
    size_t o = 0;
#pragma unroll
    for (int s = 0; s < 8; ++s) if (n >= SEG_START[s] && n < SEG_START[s + 1]) o = seg_off(s) + (size_t)(n - SEG_START[s]) * seg_pitch(s);
    return o;
}
__device__ __forceinline__ bool w_row_is8(int n) {
    bool r = false;
#pragma unroll
    for (int s = 0; s < 8; ++s) if (n >= SEG_START[s] && n < SEG_START[s + 1]) r = seg_i8(s);
    return r;
}
__device__ __forceinline__ int map_tile(int idx, bool want8) {
    int t = 104;
#pragma unroll
    for (int s = 7; s >= 0; --s) { }
    int rem = idx; bool found = false;
#pragma unroll
    for (int s = 0; s < 8; ++s) { if (s == 1 || SEG_BIT[s] < 0 || seg_i8(s) != want8) continue; const int len = (SEG_START[s + 1] - SEG_START[s]) / 256;
        if (!found && rem < len) { t = SEG_START[s] / 256 + rem; found = true; } rem -= len; }
    return t;
}
constexpr size_t MiB = 1u << 20;
constexpr size_t WS_CTL = 0, CTL_BYTES = 1 * MiB;
constexpr size_t WS_MEMN = 1 * MiB, WS_KVM = 9 * MiB  , WS_ALR = 17 * MiB, WS_SUBK = 18 * MiB, WS_EIDX = 19 * MiB, WS_GW = 27 * MiB;
constexpr size_t WS_WBR = 64 * MiB  , WS_WO = 112 * MiB, WS_WPQ = 144 * MiB, WS_WKV = 160 * MiB;
constexpr size_t WS_UB = 192 * MiB, WS_VB = 224 * MiB;
constexpr size_t WS_HN8 = 320 * MiB;
constexpr size_t WS_W8 = 448 * MiB;
constexpr size_t WS_WAL = 56 * MiB;
constexpr size_t WS_SHN = 35 * MiB + 512 * 1024, WS_SW = 35 * MiB + 768 * 1024;
constexpr size_t WS_SWPQ = 35 * MiB + 896 * 1024;
constexpr size_t CTL_CMAXPQ = 384 * 1024;
constexpr size_t CTL_CMAX = 256 * 1024;
constexpr size_t WS_SU = 35 * MiB, WS_SV = WS_SU + 65536, WS_SH = WS_SV + 65536, WS_SHS = WS_SH + 65536;
constexpr size_t WS_H8 = 914 * MiB;
constexpr size_t WS_WTIN = 448 * MiB;
constexpr size_t WS_GLAB = 448 * MiB, WS_PROB = 521 * MiB  , WS_OG = 585 * MiB;
constexpr size_t WS_WQX = 40 * MiB;
constexpr size_t WS_WKT = 384 * MiB;
constexpr size_t WS_VWT = 320 * MiB;
constexpr size_t WS_HN = 658 * MiB;
constexpr size_t WS_MERGED = 658 * MiB;
constexpr size_t WS_X1B = 1042 * MiB;
constexpr size_t WS_QG = 786 * MiB, WS_KG = 818 * MiB, WS_VT = 850 * MiB, WS_RG = 914 * MiB, WS_CB = 978 * MiB, WS_CC = 1042 * MiB, WS_CH = 1106 * MiB, WS_QX = 1170 * MiB;
constexpr size_t WS_GT = 1234 * MiB;
constexpr size_t WS_HQ = 1234 * MiB, WS_PQ = 1362 * MiB;
constexpr size_t WS_END = 1618 * MiB;
static_assert(WS_GLAB + (size_t)16 * 64 * GLA_BLK <= WS_PROB, "gla blocks");

constexpr int LDS_BYTES = 163840;
constexpr int LDS_EX = 131072;
constexpr int LDS_MISC = LDS_BYTES - 256;

__device__ __forceinline__ float bf2f(unsigned b) { return __uint_as_float(b << 16); }
__device__ __forceinline__ float bflo(unsigned w) { return __uint_as_float(w << 16); }
__device__ __forceinline__ float bfhi(unsigned w) { return __uint_as_float(w & 0xffff0000u); }
__device__ __forceinline__ unsigned f2bf(float f) { unsigned u = __float_as_uint(f); return (u + 0x7fffu + ((u >> 16) & 1u)) >> 16; }
__device__ __forceinline__ unsigned pk2(float lo, float hi) { const f32x2 v = {lo, hi}; const bf16x2v b = __builtin_convertvector(v, bf16x2v); return __builtin_bit_cast(unsigned, b); }
__device__ __forceinline__ float dot2bf(unsigned a, unsigned b, float c) { return __builtin_amdgcn_fdot2_f32_bf16(__builtin_bit_cast(bf16x2v, a), __builtin_bit_cast(bf16x2v, b), c, false); }
__device__ __forceinline__ float wave_sum(float v) {
#pragma unroll
    for (int o = 1; o < 64; o <<= 1) v += __shfl_xor(v, o);
    return v;
}
__device__ __forceinline__ float wave_max(float v) {
#pragma unroll
    for (int o = 1; o < 64; o <<= 1) v = fmaxf(v, __shfl_xor(v, o));
    return v;
}
__device__ __forceinline__ float fast_sigmoid(float x) { return __builtin_amdgcn_rcpf(1.0f + __expf(-x)); }
__device__ __forceinline__ float inv_sigmoid(float x) { return 1.0f + __expf(fminf(-x, 69.0f)); }
#define LDS_WAIT() asm volatile("s_waitcnt lgkmcnt(0)" ::: "memory")
#define VM_WAIT() asm volatile("s_waitcnt vmcnt(0)" ::: "memory")

#define XB_TMO      128
#define XB_XCNT(j)  (256  + 64 * (j))
#define XB_XSUB(j)  (1280 + 64 * (j))
#define XB_XGEN(j)  (2304 + 64 * (j))
#define XB_TOP      3328
#define XB_TOPGEN   3392
#define XCD_BAR_WORDS 3456
#define XB_SPIN_CAP (1u << 24)
__device__ __forceinline__ unsigned xb_ld(unsigned* p)              { return __hip_atomic_load(p, __ATOMIC_RELAXED, __HIP_MEMORY_SCOPE_AGENT); }
__device__ __forceinline__ unsigned xb_add(unsigned* p, unsigned v) { return __hip_atomic_fetch_add(p, v, __ATOMIC_RELAXED, __HIP_MEMORY_SCOPE_AGENT); }
__device__ __forceinline__ unsigned xb_xcc_id() { return (unsigned)__builtin_amdgcn_s_getreg((3 << 11) | 20) & 0xFu; }
#define XB_SPIN(cond, bar) do { unsigned _sp = 0; while (cond) { __builtin_amdgcn_s_sleep(1); \
    if ((++_sp & 255u) == 0u) { if (xb_ld(&(bar)[XB_TMO])) break; if (_sp > XB_SPIN_CAP) { atomicAdd(&(bar)[XB_TMO], 1u); break; } } } } while (0)
struct XcdBarrier { unsigned* bar; unsigned x; volatile LAS unsigned* st; };
__device__ __forceinline__ XcdBarrier xcd_barrier_post(unsigned* bar, volatile LAS unsigned* st) {
    XcdBarrier b; b.bar = bar; b.x = xb_xcc_id(); b.st = st;
    if (threadIdx.x == 0) (void)xb_add(&bar[XB_XCNT(b.x)], 1u);
    return b;
}
__device__ __forceinline__ void xcd_barrier_complete(unsigned* bar, unsigned x, unsigned& nloc, unsigned& nx) {
    const unsigned G = gridDim.x * gridDim.y * gridDim.z;
    unsigned sum, cnt, mine, sp = 0u;
    for (;;) {
        sum = 0u; cnt = 0u; mine = 0u;
#pragma unroll
        for (unsigned j = 0; j < 16; ++j) { const unsigned c = xb_ld(&bar[XB_XCNT(j)]); sum += c; cnt += (c > 0u) ? 1u : 0u; mine = (j == x) ? c : mine; }
        if (sum == G) break;
        __builtin_amdgcn_s_sleep(1);
        if ((++sp & 255u) == 0u) { if (xb_ld(&bar[XB_TMO])) break; if (sp > XB_SPIN_CAP) { atomicAdd(&bar[XB_TMO], 1u); break; } }
    }
    nloc = mine > 0u ? mine : 1u; nx = cnt > 0u ? cnt : 1u;
}
__device__ __forceinline__ void xcd_barrier(const XcdBarrier& b) {
    asm volatile("s_waitcnt vmcnt(0)" ::: "memory");
    __syncthreads();
    if (threadIdx.x == 0) {
        unsigned* bar = b.bar;
        __builtin_amdgcn_s_waitcnt(0);
        unsigned nloc = b.st[0], nx = b.st[1];
        if (nloc == 0u) { xcd_barrier_complete(bar, b.x, nloc, nx); b.st[0] = nloc; b.st[1] = nx; }
        const unsigned old = xb_add(&bar[XB_XSUB(b.x)], 1u);
        const unsigned gen = old / nloc;
        if (old + 1u == (gen + 1u) * nloc) {
            __builtin_amdgcn_fence(__ATOMIC_RELEASE, "agent");
            asm volatile("s_waitcnt vmcnt(0)" ::: "memory");
            const unsigned og = xb_add(&bar[XB_TOP], 1u);
            const unsigned tg = og / nx;
            if (og + 1u == (tg + 1u) * nx) xb_add(&bar[XB_TOPGEN], 1u);
            else XB_SPIN(xb_ld(&bar[XB_TOPGEN]) == tg, bar);
            __builtin_amdgcn_fence(__ATOMIC_ACQUIRE, "agent");
            xb_add(&bar[XB_XGEN(b.x)], 1u);
            asm volatile("s_waitcnt vmcnt(0)" ::: "memory");
        } else {
            XB_SPIN(xb_ld(&bar[XB_XGEN(b.x)]) == gen, bar);
            __builtin_amdgcn_fence(__ATOMIC_ACQUIRE, "agent");
            asm volatile("s_waitcnt vmcnt(0)" ::: "memory");
        }
    }
    __syncthreads();
}

namespace gg {
constexpr int BM = 256, BK = 64, HALF = 128, HTB = HALF * BK * 2, STAGE_BYTES = 8 * HTB;
__device__ __forceinline__ int lds_byte(int r, int c) { const int st = (r >> 4) * 2 + (c >> 5), rr = r & 15, cc = c & 31, ob = rr * 64 + cc * 2; return st * 1024 + (ob ^ (((ob >> 9) & 1) << 5)); }
__device__ __forceinline__ void stage_rc(int b, int& R, int& C) { const int st = b / 1024, sb = b % 1024, swz = sb ^ (((sb >> 9) & 1) << 5); R = (st >> 1) * 16 + swz / 64; C = (st & 1) * 32 + (swz % 64) / 2; }
__device__ __forceinline__ int perm32(int rho) { const int n = rho >> 4, i = rho & 15; return 8 * (i >> 2) + 4 * n + (i & 3); }
struct Unit { const char* A; const char* B; int kind, pm, pn, aux; };
typedef f32x4 Acc[2][2][4][2];

template <int MODE, bool RX = false, class Epi, class Sched>
__device__ __forceinline__ void gemm_phase(LAS unsigned char* lds, const int ldaB, const int ldbB, const int nt, const Sched& S, const Epi& E) {
    int tid = threadIdx.x; asm volatile("" : "+v"(tid));
    const int wid = __builtin_amdgcn_readfirstlane(tid >> 6), lane = tid & 63, wr = wid >> 2, wc = wid & 3, fr = lane & 15, fq = lane >> 4;
    unsigned voffA[2], voffB[2];
#pragma unroll
    for (int i = 0; i < 2; ++i) { int R, C; stage_rc(tid * 16 + i * 8192, R, C); const int Rb = (R & ~31) + perm32(R & 31);
        voffA[i] = (unsigned)(R * ldaB + C * 2); voffB[i] = (unsigned)(Rb * ldbB + C * 2); }
    const size_t kstep = (size_t)(BK * 2);
    const size_t hstepA = (size_t)HALF * ldaB, hstepB = (size_t)HALF * ldbB;
    const unsigned ldsw = (unsigned)wid * 1024u;
    const int aoff = lds_byte(wr * 64 + fr, fq * 8), boff = lds_byte(wc * 32 + fr, fq * 8);
#define PG8_SA(b, h) (((b) * 2 + (h)) * HTB)
#define PG8_SB(b, h) ((4 + (b) * 2 + (h)) * HTB)
#define PG8_STAGE(bufoff, gbase, voff) do { _Pragma("unroll") for (int _i = 0; _i < 2; ++_i) \
        __builtin_amdgcn_global_load_lds((const unsigned*)((const char*)(gbase) + (voff)[_i]), (LAS unsigned*)(lds + (bufoff) + ldsw + _i * 8192), 16, 0, 0); } while (0)
#define PG8_LDA(dst, b, h) do { _Pragma("unroll") for (int m = 0; m < 4; ++m) { if constexpr (MODE == 1) { const u32x4 p0_ = *(const LAS u32x4*)(lds + PG8_SA(b, h) + aoff + m * 2048), p1_ = *(const LAS u32x4*)(lds + PG8_SA(b, h) + aoff + m * 2048 + 1024); \
        dst##8[m] = __builtin_shufflevector(p0_, p1_, 0, 1, 2, 3, 4, 5, 6, 7); } else { _Pragma("unroll") for (int k = 0; k < 2; ++k) dst[m][k] = *(const LAS bf16x8*)(lds + PG8_SA(b, h) + aoff + m * 2048 + k * 1024); } } } while (0)
#define PG8_LDB(dst, b, h) do { _Pragma("unroll") for (int n = 0; n < 2; ++n) { if constexpr (MODE == 1) { const u32x4 p0_ = *(const LAS u32x4*)(lds + PG8_SB(b, h) + boff + n * 2048), p1_ = *(const LAS u32x4*)(lds + PG8_SB(b, h) + boff + n * 2048 + 1024); \
        dst##8[n] = __builtin_shufflevector(p0_, p1_, 0, 1, 2, 3, 4, 5, 6, 7); } else { _Pragma("unroll") for (int k = 0; k < 2; ++k) dst[n][k] = *(const LAS bf16x8*)(lds + PG8_SB(b, h) + boff + n * 2048 + k * 1024); } } } while (0)
#define PG8_MMA(ai, bj, At, Bt) do { __builtin_amdgcn_s_setprio(1); _Pragma("unroll") for (int m = 0; m < 4; ++m) _Pragma("unroll") for (int n = 0; n < 2; ++n) { \
        if constexpr (MODE == 1) { asm volatile("v_mfma_scale_f32_16x16x128_f8f6f4 %0, %1, %2, %0, %3, %3 op_sel_hi:[0,0,0]" : "+v"(acc[ai][bj][m][n]) : "v"(Bt##8[n]), "v"(At##8[m]), "v"(sc127)); } \
        else if constexpr (MODE == 2) { _Pragma("unroll") for (int k = 0; k < 2; ++k) acc[ai][bj][m][n] = __builtin_bit_cast(f32x4, __builtin_amdgcn_mfma_i32_16x16x64_i8(__builtin_bit_cast(i32x4, Bt[n][k]), __builtin_bit_cast(i32x4, At[m][k]), __builtin_bit_cast(i32x4, acc[ai][bj][m][n]), 0, 0, 0)); } \
        else { _Pragma("unroll") for (int k = 0; k < 2; ++k) acc[ai][bj][m][n] = __builtin_amdgcn_mfma_f32_16x16x32_bf16(Bt[n][k], At[m][k], acc[ai][bj][m][n], 0, 0, 0); } } \
        __builtin_amdgcn_s_setprio(0); } while (0)
#define PG8_WAIT_V(n) asm volatile("s_waitcnt vmcnt(" #n ")" ::: "memory")
#define PG8_WAIT_V2(flag) asm volatile("s_cmp_lg_u32 %0, 0\n\ts_cbranch_scc1 1f\n\ts_waitcnt vmcnt(8)\n\ts_branch 2f\n1:\n\ts_waitcnt vmcnt(24)\n2:" :: "s"(flag) : "scc", "memory")
#define PG8_WAIT_L(n) asm volatile("s_waitcnt lgkmcnt(" #n ")" ::: "memory")
#define PG8_BAR __builtin_amdgcn_s_barrier()
#define PG8_SCHED __builtin_amdgcn_sched_barrier(0)
    Unit cur, nxt; int ui = 0;
    if (!S.next(0, cur)) return;
    Acc acc;
#pragma unroll
    for (int a = 0; a < 2; ++a)
#pragma unroll
        for (int b = 0; b < 2; ++b)
#pragma unroll
            for (int m = 0; m < 4; ++m)
#pragma unroll
                for (int n = 0; n < 2; ++n) acc[a][b][m][n] = (f32x4){0.f, 0.f, 0.f, 0.f};
    bf16x8 At[4][2], B0[2][2], B1[2][2]; u32x8 At8[4], B08[2], B18[2]; const int sc127 = 127;
    const char* cA = cur.A; const char* cB = cur.B;
    PG8_STAGE(PG8_SB(0, 0), cB, voffB); PG8_STAGE(PG8_SB(0, 1), cB + hstepB, voffB); PG8_STAGE(PG8_SA(0, 0), cA, voffA); PG8_STAGE(PG8_SA(0, 1), cA + hstepA, voffA);
    if (wr == 1) PG8_BAR;
    PG8_WAIT_V(2); PG8_BAR;
    PG8_STAGE(PG8_SB(1, 0), cB + kstep, voffB); PG8_STAGE(PG8_SA(1, 0), cA + kstep, voffA); PG8_STAGE(PG8_SB(1, 1), cB + hstepB + kstep, voffB);
    PG8_WAIT_V(6); PG8_BAR;
    bool relax = false;
    for (;;) {
        const bool has_next = S.next(ui + 1, nxt);
        const char* nA = has_next ? nxt.A : cA; const char* nB = has_next ? nxt.B : cB;
        const int unt = cur.aux ? cur.aux : nt;
#define PG8_PAIR(W0) { \
            const bool last = (t == unt - 2); const int rxf = __builtin_amdgcn_readfirstlane((relax && t == 0) ? 1 : 0); \
            const char* a1 = cA + (size_t)(t + 1) * kstep; \
            const char* a2 = last ? nA : cA + (size_t)(t + 2) * kstep; const char* b2 = last ? nB : cB + (size_t)(t + 2) * kstep; \
            const char* a3 = a2 + kstep; const char* b3 = b2 + kstep; \
              \
            PG8_LDB(B0, 0, 0); PG8_LDB(B1, 0, 1); PG8_SCHED; PG8_LDA(At, 0, 0); PG8_STAGE(PG8_SA(1, 1), a1 + hstepA, voffA); \
            if constexpr (RX) PG8_WAIT_V2(rxf); else PG8_WAIT_V(8); PG8_WAIT_L(0); PG8_BAR; PG8_MMA(0, 0, At, B0); PG8_MMA(0, 1, At, B1); PG8_BAR; PG8_SCHED; \
              \
            PG8_LDA(At, 0, 1); PG8_STAGE(PG8_SB(0, 0), b2, voffB); PG8_STAGE(PG8_SB(0, 1), b2 + hstepB, voffB); PG8_STAGE(PG8_SA(0, 0), a2, voffA); \
            if constexpr (RX) PG8_WAIT_V2(rxf); else PG8_WAIT_V(8); PG8_WAIT_L(0); PG8_BAR; PG8_MMA(1, 0, At, B0); PG8_MMA(1, 1, At, B1); PG8_BAR; PG8_SCHED; \
              \
            PG8_LDB(B0, 1, 0); PG8_LDB(B1, 1, 1); PG8_SCHED; PG8_LDA(At, 1, 0); PG8_STAGE(PG8_SA(0, 1), a2 + hstepA, voffA); \
            PG8_WAIT_V(8); PG8_WAIT_L(0); PG8_BAR; PG8_MMA(0, 0, At, B0); PG8_MMA(0, 1, At, B1); PG8_BAR; PG8_SCHED; \
              \
            PG8_LDA(At, 1, 1); PG8_STAGE(PG8_SB(1, 0), b3, voffB); PG8_STAGE(PG8_SB(1, 1), b3 + hstepB, voffB); PG8_STAGE(PG8_SA(1, 0), a3, voffA); \
            PG8_WAIT_V(8); PG8_WAIT_L(0); PG8_BAR; PG8_MMA(1, 0, At, B0); PG8_MMA(1, 1, At, B1); PG8_BAR; PG8_SCHED; }
        for (int t = 0; t < unt; t += 2) PG8_PAIR(8)
#undef PG8_PAIR
        if constexpr (MODE == 1) asm volatile("s_nop 15\n\ts_nop 15" ::: "memory");
        if (wr == 0) PG8_BAR;
        const bool reset = E(acc, cur, wr, wc, fr, fq, wid, lane);
        if constexpr (RX) relax = (E.nst(cur) >= 16);
        asm volatile("" ::: "memory");
        if (!has_next) break;
        if (reset) {
#pragma unroll
            for (int a = 0; a < 2; ++a)
#pragma unroll
                for (int b = 0; b < 2; ++b)
#pragma unroll
                    for (int m = 0; m < 4; ++m)
#pragma unroll
                        for (int n = 0; n < 2; ++n) acc[a][b][m][n] = (f32x4){0.f, 0.f, 0.f, 0.f};
        }
        cur = nxt; cA = nA; cB = nB; ++ui;
        if (wr == 1) PG8_BAR;
    }
    PG8_WAIT_V(0);
    PG8_BAR;
#undef PG8_SA
#undef PG8_SB
#undef PG8_STAGE
#undef PG8_LDA
#undef PG8_LDB
#undef PG8_MMA
#undef PG8_WAIT_V
#undef PG8_WAIT_L
#undef PG8_BAR
#undef PG8_SCHED
}

__device__ __forceinline__ bool tile_order(long L, int nM, int nN, int& pm, int& pn) {
    const int nwg = nM * nN; if (L >= nwg) return false;
    const int q = nwg / 8, xcd = (int)(L % 8), off = (int)(L / 8); const int wgid = xcd * q + off;
    const int nig = 8 * nN, gid = wgid / nig, fm = gid * 8;
    pm = fm + ((wgid % nig) % 8); pn = (wgid % nig) / 8; return true;
}
__device__ __forceinline__ void store_bf16_tile(const Acc& acc, bf16_t* base, int ldc, int row0, int col0, int wr, int wc, int fr, int fq) {
#pragma unroll
    for (int ai = 0; ai < 2; ++ai)
#pragma unroll
        for (int m = 0; m < 4; ++m) { bf16_t* rowp = base + (size_t)(row0 + ai * HALF + wr * 64 + m * 16 + fr) * ldc + col0 + wc * 32 + 8 * fq;
#pragma unroll
            for (int bj = 0; bj < 2; ++bj) { const f32x4 v0 = acc[ai][bj][m][0], v1 = acc[ai][bj][m][1];
                u32x4 w; w.x = pk2(v0[0], v0[1]); w.y = pk2(v0[2], v0[3]); w.z = pk2(v1[0], v1[1]); w.w = pk2(v1[2], v1[3]);
                *(u32x4*)(rowp + bj * HALF) = w; } }
}
}

struct Args { const float* in[21]; float* out; unsigned char* ws; };
struct Frame {
    LAS unsigned char* lds;
    int tid, lane, wave, G, bid;
    unsigned char* ws;
    __device__ __forceinline__ void refresh() { int t = threadIdx.x; asm volatile("" : "+v"(t)); tid = t; lane = t & 63; wave = __builtin_amdgcn_readfirstlane(t >> 6); }
};

__device__ __forceinline__ int src_col(int n) { return n < 6144 ? n : (n < O_AL ? n + 16 : (n < O_AL + 16 ? n - O_AL + 6144 : -1)); }
__device__ __forceinline__ void transpose_item(const float* W, int K, int N, int NT, bf16_t* WT, LAS float* scr, int item, int lane, bool remap, unsigned char* W8 = nullptr, bf16_t* WQ = nullptr, const unsigned* cmax = nullptr, float* sw = nullptr, bool i8perm = false) {
    const int nblk = NT / 32, kb = item / nblk, nb = item % nblk, k0 = 64 * kb, n0 = 32 * nb;
    const int q = lane & 7, r8 = lane >> 3;
    const int n = n0 + 4 * q; const int src = remap ? src_col(n) : n;
    f32x4 v[8];
#pragma unroll
    for (int i = 0; i < 8; ++i) v[i] = (src >= 0) ? *(const f32x4*)(W + (size_t)(k0 + 8 * i + r8) * N + src) : (f32x4){0.f, 0.f, 0.f, 0.f};
    if (remap && n0 >= O_QX && n0 < O_GT) {
#pragma unroll
        for (int i = 0; i < 8; ++i) *(u32x2*)(WQ + (size_t)(k0 + 8 * i + r8) * 2048 + (n0 - O_QX) + 4 * q) = (u32x2){pk2(v[i].x, v[i].y), pk2(v[i].z, v[i].w)};
        return;
    }
#pragma unroll
    for (int i = 0; i < 8; ++i) { LAS float* d = scr + (8 * i + r8) * 33 + 4 * q; d[0] = v[i].x; d[1] = v[i].y; d[2] = v[i].z; d[3] = v[i].w; }
    LDS_WAIT(); asm volatile("" ::: "memory");
    const int c = lane & 7;
    if (i8perm) {
#pragma unroll
        for (int j = 0; j < 4; ++j) { const int nn = (lane >> 3) + 8 * j; const LAS float* s = scr + (8 * c) * 33 + nn;
            const float mx = fmaxf(__uint_as_float(xb_ld((unsigned*)cmax + n0 + nn)), 1e-30f), inv = 127.0f / mx;
            int qv[8];
#pragma unroll
            for (int e = 0; e < 8; ++e) qv[e] = (int)rintf(s[e * 33] * inv) & 255;
            *(u32x2*)(W8 + (size_t)(n0 + nn) * K + k0 + 8 * c) = (u32x2){(unsigned)(qv[0] | (qv[2] << 8) | (qv[4] << 16) | (qv[6] << 24)), (unsigned)(qv[1] | (qv[3] << 8) | (qv[5] << 16) | (qv[7] << 24))};
            if (kb == 0 && c == 0) sw[n0 + nn] = mx * (1.0f / 127.0f); }
    } else if (remap && n0 < O_AL && w_row_is8(n0)) {
#pragma unroll
        for (int j = 0; j < 4; ++j) { const int nn = (lane >> 3) + 8 * j; const LAS float* s = scr + (8 * c) * 33 + nn;
            const float mx = fmaxf(__uint_as_float(xb_ld((unsigned*)cmax + src_col(n0 + nn))), 1e-30f), inv = 127.0f / mx;
            int qv[8];
#pragma unroll
            for (int e = 0; e < 8; ++e) qv[e] = (int)rintf(s[e * 33] * inv) & 255;
            *(u32x2*)(W8 + w_row_off(n0 + nn) + k0 + 8 * c) = (u32x2){(unsigned)(qv[0] | (qv[1] << 8) | (qv[2] << 16) | (qv[3] << 24)), (unsigned)(qv[4] | (qv[5] << 8) | (qv[6] << 16) | (qv[7] << 24))};
            if (kb == 0 && c == 0) sw[n0 + nn] = mx * (1.0f / 127.0f); }
    } else if (remap && n0 < O_AL) {
#pragma unroll
        for (int j = 0; j < 4; ++j) { const int nn = (lane >> 3) + 8 * j; const LAS float* s = scr + (8 * c) * 33 + nn;
            u32x4 o; o.x = pk2(s[0 * 33], s[1 * 33]); o.y = pk2(s[2 * 33], s[3 * 33]); o.z = pk2(s[4 * 33], s[5 * 33]); o.w = pk2(s[6 * 33], s[7 * 33]);
            *(u32x4*)(W8 + w_row_off(n0 + nn) + (size_t)(k0 + 8 * c) * 2) = o; }
    } else {
        const int rowoff = remap ? O_AL : 0;
#pragma unroll
        for (int j = 0; j < 4; ++j) { const int nn = (lane >> 3) + 8 * j; const LAS float* s = scr + (8 * c) * 33 + nn;
            u32x4 o; o.x = pk2(s[0 * 33], s[1 * 33]); o.y = pk2(s[2 * 33], s[3 * 33]); o.z = pk2(s[4 * 33], s[5 * 33]); o.w = pk2(s[6 * 33], s[7 * 33]);
            *(u32x4*)(WT + (size_t)(n0 - rowoff + nn) * K + k0 + 8 * c) = o; }
    }
    LDS_WAIT(); asm volatile("" ::: "memory");
}
__device__ __forceinline__ void rms_row_bf16(const float* xrow, const float* gain, bf16_t* orow, int lane) {
    const f32x4* xr = (const f32x4*)xrow + lane;
    f32x4 v[16]; float s = 0.f;
#pragma unroll
    for (int j = 0; j < 16; ++j) { v[j] = xr[64 * j]; s += (v[j].x * v[j].x + v[j].y * v[j].y) + (v[j].z * v[j].z + v[j].w * v[j].w); }
    const float rstd = rsqrtf(wave_sum(s) * (1.f / D) + EPS);
    u32x2* o8 = (u32x2*)orow + lane; const f32x4* gr = (const f32x4*)gain + lane;
#pragma unroll
    for (int j = 0; j < 16; ++j) { const f32x4 g = gr[64 * j]; u32x2 w; w.x = pk2(v[j].x * rstd * g.x, v[j].y * rstd * g.y); w.y = pk2(v[j].z * rstd * g.z, v[j].w * rstd * g.w); o8[64 * j] = w; }
}
__device__ __forceinline__ void rms_row_bf16_i8n(const float* xrow, const float* gain, bf16_t* orow, unsigned char* o8row, float* scale, int lane) {
    const f32x4* xr = (const f32x4*)xrow + lane;
    f32x4 v[16]; float s = 0.f;
#pragma unroll
    for (int j = 0; j < 16; ++j) { v[j] = xr[64 * j]; s += (v[j].x * v[j].x + v[j].y * v[j].y) + (v[j].z * v[j].z + v[j].w * v[j].w); }
    const float rstd = rsqrtf(wave_sum(s) * (1.f / D) + EPS);
    u32x2* o8 = (u32x2*)orow + lane; const f32x4* gr = (const f32x4*)gain + lane; float m = 0.f;
#pragma unroll
    for (int j = 0; j < 16; ++j) { const f32x4 g = gr[64 * j]; v[j].x *= rstd * g.x; v[j].y *= rstd * g.y; v[j].z *= rstd * g.z; v[j].w *= rstd * g.w;
        u32x2 w; w.x = pk2(v[j].x, v[j].y); w.y = pk2(v[j].z, v[j].w); o8[64 * j] = w;
        m = fmaxf(m, fmaxf(fmaxf(fabsf(v[j].x), fabsf(v[j].y)), fmaxf(fabsf(v[j].z), fabsf(v[j].w)))); }
    m = fmaxf(wave_max(m), 1e-30f); const float inv = 127.0f / m;
    if (lane == 0) *scale = m * (1.0f / 127.0f);
    unsigned* o4 = (unsigned*)o8row + lane;
#pragma unroll
    for (int j = 0; j < 16; ++j) { const int q0 = (int)rintf(v[j].x * inv), q1 = (int)rintf(v[j].y * inv), q2 = (int)rintf(v[j].z * inv), q3 = (int)rintf(v[j].w * inv);
        o4[64 * j] = (unsigned)(q0 & 255) | ((unsigned)(q1 & 255) << 8) | ((unsigned)(q2 & 255) << 16) | ((unsigned)(q3 & 255) << 24); }
}
__device__ __forceinline__ void rms_row_i8(const bf16_t* xrow, const float* gain, unsigned char* o8row, float* scale, float* hsum, int lane) {
    const u32x4* xr = (const u32x4*)xrow + lane;
    f32x4 v[16]; float s = 0.f;
#pragma unroll
    for (int j = 0; j < 8; ++j) { const u32x4 u = xr[64 * j]; v[2 * j] = (f32x4){bflo(u.x), bfhi(u.x), bflo(u.y), bfhi(u.y)}; v[2 * j + 1] = (f32x4){bflo(u.z), bfhi(u.z), bflo(u.w), bfhi(u.w)}; }
#pragma unroll
    for (int j = 0; j < 16; ++j) s += (v[j].x * v[j].x + v[j].y * v[j].y) + (v[j].z * v[j].z + v[j].w * v[j].w);
    const float rstd = rsqrtf(wave_sum(s) * (1.f / D) + EPS);
    const f32x4* gr = (const f32x4*)gain + 2 * lane; float m = 0.f;
#pragma unroll
    for (int j = 0; j < 8; ++j) {
#pragma unroll
        for (int q = 0; q < 2; ++q) { const f32x4 g = gr[128 * j + q]; f32x4& x = v[2 * j + q]; x.x *= rstd * g.x; x.y *= rstd * g.y; x.z *= rstd * g.z; x.w *= rstd * g.w;
            m = fmaxf(m, fmaxf(fmaxf(fabsf(x.x), fabsf(x.y)), fmaxf(fabsf(x.z), fabsf(x.w)))); }
        }
    m = fmaxf(wave_max(m), 1e-30f); const float inv = 127.0f / m;
    int isum = 0;
#pragma unroll
    for (int j = 0; j < 8; ++j) { const f32x4 a = v[2 * j], b = v[2 * j + 1];
        const int q0 = (int)rintf(a.x * inv), q1 = (int)rintf(a.y * inv), q2 = (int)rintf(a.z * inv), q3 = (int)rintf(a.w * inv), q4 = (int)rintf(b.x * inv), q5 = (int)rintf(b.y * inv), q6 = (int)rintf(b.z * inv), q7 = (int)rintf(b.w * inv);
        isum += (q0 + q1) + (q2 + q3) + (q4 + q5) + (q6 + q7);
        u32x2 w; w.x = (unsigned)(q0 & 255) | ((unsigned)(q2 & 255) << 8) | ((unsigned)(q4 & 255) << 16) | ((unsigned)(q6 & 255) << 24);
        w.y = (unsigned)(q1 & 255) | ((unsigned)(q3 & 255) << 8) | ((unsigned)(q5 & 255) << 16) | ((unsigned)(q7 & 255) << 24);
        ((u32x2*)o8row)[lane + 64 * j] = w; }
#pragma unroll
    for (int o = 1; o < 64; o <<= 1) isum += __shfl_xor(isum, o);
    if (lane == 0) { *scale = m * (1.0f / 127.0f); *hsum = (float)isum; }
}
__device__ __forceinline__ void cvt_table(const float* src, bf16_t* dst, size_t n8, size_t gt, size_t ngt) {
    for (size_t i = gt; i < n8; i += ngt) { const f32x4 a = ((const f32x4*)src)[2 * i], b = ((const f32x4*)src)[2 * i + 1];
        u32x4 w; w.x = pk2(a.x, a.y); w.y = pk2(a.z, a.w); w.z = pk2(b.x, b.y); w.w = pk2(b.z, b.w); ((u32x4*)dst)[i] = w; }
}
__device__ __forceinline__ void quant_row_i4_v(const float* xrow, unsigned char* orow, float* scale, int lane) {
    const f32x4* xr = (const f32x4*)xrow + lane;
    f32x4 v[2][4][2]; float s = 0.f;
#pragma unroll
    for (int p = 0; p < 2; ++p)
#pragma unroll
        for (int d = 0; d < 4; ++d)
#pragma unroll
            for (int h = 0; h < 2; ++h) v[p][d][h] = xr[512 * p + 128 * d + 64 * h];
#pragma unroll
    for (int p = 0; p < 2; ++p)
#pragma unroll
        for (int d = 0; d < 4; ++d)
#pragma unroll
            for (int h = 0; h < 2; ++h) { const f32x4 x = v[p][d][h]; s += (x.x * x.x + x.y * x.y) + (x.z * x.z + x.w * x.w); }
    const float sc = fmaxf(2.5f * sqrtf(wave_sum(s) * (1.f / D)) * (1.f / 7.f), 1e-30f), inv = 1.0f / sc;
    if (lane == 0) *scale = sc;
#pragma unroll
    for (int p = 0; p < 2; ++p) { unsigned wd[4];
#pragma unroll
        for (int d = 0; d < 4; ++d) { const f32x4 a = v[p][d][0], b = v[p][d][1]; const float e[8] = {a.x, a.y, a.z, a.w, b.x, b.y, b.z, b.w}; unsigned w = 0u;
#pragma unroll
            for (int i = 0; i < 8; ++i) { const int q = (int)fminf(fmaxf(rintf(e[i] * inv), -7.f), 7.f) + 8; w |= (unsigned)q << (4 * i); }
            wd[d] = w; }
        ((u32x4*)orow)[64 * p + lane] = (u32x4){wd[0], wd[1], wd[2], wd[3]}; }
}
__device__ __forceinline__ void quant_row_i4(const float* xrow, unsigned char* orow, float* scale, int lane) {
    const f32x4* xr = (const f32x4*)xrow + 2 * lane;
    f32x4 v[16]; float s = 0.f;
#pragma unroll
    for (int j = 0; j < 8; ++j) { v[2 * j] = xr[128 * j]; v[2 * j + 1] = xr[128 * j + 1]; }
#pragma unroll
    for (int j = 0; j < 16; ++j) s += (v[j].x * v[j].x + v[j].y * v[j].y) + (v[j].z * v[j].z + v[j].w * v[j].w);
    const float sc = fmaxf(2.5f * sqrtf(wave_sum(s) * (1.f / D)) * (1.f / 7.f), 1e-30f), inv = 1.0f / sc;
    if (lane == 0) *scale = sc;
    unsigned* o4 = (unsigned*)orow + lane;
#pragma unroll
    for (int j = 0; j < 8; ++j) { const f32x4 a = v[2 * j], b = v[2 * j + 1]; const float e[8] = {a.x, a.y, a.z, a.w, b.x, b.y, b.z, b.w}; unsigned w = 0u;
#pragma unroll
        for (int i = 0; i < 8; ++i) { const int q = (int)fminf(fmaxf(rintf(e[i] * inv), -7.f), 7.f) + 8; w |= (unsigned)q << (4 * i); }
        o4[64 * j] = w; }
}
__device__ __forceinline__ int nth_block(int j, bool want8) {
    int nb = -1;
#pragma unroll
    for (int s = 0; s < 9; ++s) { const int b0 = (s < 8 ? SEG_START[s] : O_AL) / 32, b1 = (s < 8 ? SEG_START[s + 1] : NPAD) / 32; const bool is8 = s < 8 && seg_i8(s);
        if (is8 == want8) { if (nb < 0 && j >= 0 && j < b1 - b0) nb = b0 + j; j -= (b1 - b0); } }
    return nb;
}
constexpr int count_blocks8() { int n = 0; for (int s = 0; s < 8; ++s) if (seg_i8(s)) n += (SEG_START[s + 1] - SEG_START[s]) / 32; return n; }
constexpr int NB8 = count_blocks8(), NBX = NPAD / 32 - NB8;
__device__ __forceinline__ void p0_prologue_a(Frame& F, const Args& a) {
    LAS float* scr = (LAS float*)(F.lds + F.wave * 16384);
    const int gw = F.bid * 8 + F.wave, NGW = F.G * 8;
    unsigned char* ws = F.ws;
    constexpr int I_BR = 32 * 128, I_O = 64 * 128, I_KV = 64 * 128;
    constexpr int I_X = 64 * NBX;
    constexpr int NITEMS = 3 * I_BR + I_O + I_KV + I_X;
    for (int it = gw; it < NITEMS; it += NGW) {
        int r = it;
        if (r < I_X) { const int nb = nth_block(r >> 6, false); transpose_item(a.in[3], D, 26640, NPAD, (bf16_t*)(ws + WS_WAL), scr, (r & 63) * (NPAD / 32) + nb, F.lane, true, ws + WS_W8, (bf16_t*)(ws + WS_WQX), (const unsigned*)(ws + WS_CTL + CTL_CMAX), (float*)(ws + WS_SW)); continue; } r -= I_X;
        if (r < I_BR) { transpose_item(a.in[8], 2048, D, D, (bf16_t*)(ws + WS_WBR), scr, r, F.lane, false); continue; } r -= I_BR;
        if (r < I_BR) { transpose_item(a.in[9], 2048, D, D, (bf16_t*)(ws + WS_WBR + 16 * MiB), scr, r, F.lane, false); continue; } r -= I_BR;
        if (r < I_BR) { transpose_item(a.in[11], 2048, D, D, (bf16_t*)(ws + WS_WBR + 32 * MiB), scr, r, F.lane, false); continue; } r -= I_BR;
        if (r < I_O) { transpose_item(a.in[13], D, D, D, (bf16_t*)(ws + WS_WO), scr, r, F.lane, false); continue; } r -= I_O;
        transpose_item(a.in[10], D, D, D, (bf16_t*)(ws + WS_WKV), scr, r, F.lane, false);
    }
    for (int m = gw; m < T; m += NGW) rms_row_bf16_i8n(a.in[0] + (size_t)m * D, a.in[2], (bf16_t*)(ws + WS_HN) + (size_t)m * D, ws + WS_HN8 + (size_t)m * D, (float*)(ws + WS_SHN) + m, F.lane);
    for (int m = gw; m < MEMT; m += NGW) rms_row_bf16(a.in[1] + (size_t)m * D, a.in[14], (bf16_t*)(ws + WS_MEMN) + (size_t)m * D, F.lane);
    const size_t gt = (size_t)F.bid * 512 + F.tid, ngt = (size_t)F.G * 512;
    cvt_table(a.in[17], (bf16_t*)(ws + WS_SUBK), (size_t)8 * 2 * 128 * 128 / 8, gt, ngt);
    { unsigned* cmq = (unsigned*)(ws + WS_CTL + CTL_CMAXPQ);
      for (int u = F.bid; u < 256; u += F.G) { const float* wp = a.in[16] + (size_t)(16 * u) * 2048 + 4 * F.tid; f32x4 m = (f32x4){0.f, 0.f, 0.f, 0.f};
#pragma unroll
          for (int r = 0; r < 16; ++r) { const f32x4 v = *(const f32x4*)(wp + (size_t)r * 2048); m.x = fmaxf(m.x, fabsf(v.x)); m.y = fmaxf(m.y, fabsf(v.y)); m.z = fmaxf(m.z, fabsf(v.z)); m.w = fmaxf(m.w, fabsf(v.w)); }
          atomicMax(cmq + 4 * F.tid + 0, __float_as_uint(m.x)); atomicMax(cmq + 4 * F.tid + 1, __float_as_uint(m.y)); atomicMax(cmq + 4 * F.tid + 2, __float_as_uint(m.z)); atomicMax(cmq + 4 * F.tid + 3, __float_as_uint(m.w)); } }
}
__device__ __forceinline__ void p0_weights8(Frame& F, const Args& a) {
    LAS float* scr = (LAS float*)(F.lds + F.wave * 16384); LAS float* smax = (LAS float*)(F.lds + 131072); LAS float* bmax = smax + 256;
    unsigned char* ws = F.ws; const int lane = F.lane, q = lane & 7, r8 = lane >> 3, c = lane & 7;
    const float* W = a.in[3]; float* sw = (float*)(ws + WS_SW);
    for (int b = F.bid; b < NB8; b += F.G) {
        const int nb = nth_block(b, true), n0 = 32 * nb, src = src_col(n0 + 4 * q);
        const float* wp = W + (size_t)(512 * F.wave + r8) * 26640 + src;
        f32x4 mx = (f32x4){0.f, 0.f, 0.f, 0.f};
#pragma unroll 1
        for (int h = 0; h < 2; ++h) { f32x4 v[32];
#pragma unroll
            for (int i = 0; i < 32; ++i) v[i] = *(const f32x4*)(wp + (size_t)(256 * h + 8 * i) * 26640);
#pragma unroll
            for (int i = 0; i < 32; ++i) { mx.x = fmaxf(mx.x, fabsf(v[i].x)); mx.y = fmaxf(mx.y, fabsf(v[i].y)); mx.z = fmaxf(mx.z, fabsf(v[i].z)); mx.w = fmaxf(mx.w, fabsf(v[i].w)); } }
#pragma unroll
        for (int o_ = 8; o_ < 64; o_ <<= 1) { mx.x = fmaxf(mx.x, __shfl_xor(mx.x, o_)); mx.y = fmaxf(mx.y, __shfl_xor(mx.y, o_)); mx.z = fmaxf(mx.z, __shfl_xor(mx.z, o_)); mx.w = fmaxf(mx.w, __shfl_xor(mx.w, o_)); }
        if (lane < 8) { LAS float* d = smax + F.wave * 32 + 4 * q; d[0] = mx.x; d[1] = mx.y; d[2] = mx.z; d[3] = mx.w; }
        __syncthreads();
        if (F.tid < 32) { float m = 0.f;
#pragma unroll
            for (int w = 0; w < 8; ++w) m = fmaxf(m, smax[w * 32 + F.tid]);
            m = fmaxf(m, 1e-30f); bmax[F.tid] = m; sw[n0 + F.tid] = m * (1.0f / 127.0f); }
        __syncthreads();
        float inv[4]; size_t roff[4];
#pragma unroll
        for (int j = 0; j < 4; ++j) { const int nn = r8 + 8 * j; inv[j] = 127.0f / bmax[nn]; roff[j] = w_row_off(n0 + nn); }
        f32x4 v[8], vn[8];
#pragma unroll
        for (int i = 0; i < 8; ++i) v[i] = *(const f32x4*)(wp + (size_t)(8 * i) * 26640);
#pragma unroll 1
        for (int ck = 0; ck < 8; ++ck) {
            if (ck < 7) {
#pragma unroll
                for (int i = 0; i < 8; ++i) vn[i] = *(const f32x4*)(wp + (size_t)(64 * (ck + 1) + 8 * i) * 26640); }
#pragma unroll
            for (int i = 0; i < 8; ++i) { LAS float* d = scr + (8 * i + r8) * 33 + 4 * q; d[0] = v[i].x; d[1] = v[i].y; d[2] = v[i].z; d[3] = v[i].w; }
            LDS_WAIT(); asm volatile("" ::: "memory");
            const int k0 = 512 * F.wave + 64 * ck;
#pragma unroll
            for (int j = 0; j < 4; ++j) { const int nn = r8 + 8 * j; const LAS float* s_ = scr + (8 * c) * 33 + nn; int qv[8];
#pragma unroll
                for (int e_ = 0; e_ < 8; ++e_) qv[e_] = (int)rintf(s_[e_ * 33] * inv[j]) & 255;
                *(u32x2*)(ws + WS_W8 + roff[j] + k0 + 8 * c) = (u32x2){(unsigned)(qv[0] | (qv[1] << 8) | (qv[2] << 16) | (qv[3] << 24)), (unsigned)(qv[4] | (qv[5] << 8) | (qv[6] << 16) | (qv[7] << 24))}; }
            LDS_WAIT(); asm volatile("" ::: "memory");
#pragma unroll
            for (int i = 0; i < 8; ++i) v[i] = vn[i];
        }
        __syncthreads();
    }
}
__device__ __forceinline__ void peer_wq_convert(Frame& F, const Args& a) {
    LAS float* scr = (LAS float*)(F.lds + F.wave * 16384);
    const int gw = F.bid * 8 + F.wave, NGW = F.G * 8; unsigned char* ws = F.ws;
    for (int it = gw; it < 64 * 64; it += NGW)
        transpose_item(a.in[16], D, 2048, 2048, nullptr, scr, it, F.lane, false, ws + WS_WPQ, nullptr, (const unsigned*)(ws + WS_CTL + CTL_CMAXPQ), (float*)(ws + WS_SWPQ), true);
}

struct P1Sched {
    const char *hn, *wreg, *wal, *memn, *wkv; int G, c;
    __device__ __forceinline__ bool next(int i, gg::Unit& u) const {
        long L = (long)i * G + c; u.aux = 0;
        if (L < 64 * NTB) { int pm, pn; gg::tile_order(L, 64, NTB > 0 ? NTB : 1, pm, pn); pn = map_tile(pn, false);
            u.kind = 0; u.pm = pm; u.pn = pn; u.A = hn + (size_t)pm * 256 * D * 2; u.B = wreg + w_row_off(256 * pn); return true; }
        L -= 64 * NTB;
        if (L < 64) { u.kind = 0; u.pm = (int)L; u.pn = 104; u.A = hn + (size_t)L * 256 * D * 2; u.B = wal; return true; }
        L -= 64;
        if (!V_I8) { if (L < 512) { u.kind = 1; u.pm = (int)(L % 8); u.pn = (int)(L / 8); u.A = wreg + w_row_off(O_VG + 256 * u.pm); u.B = hn + (size_t)u.pn * 256 * D * 2; return true; } L -= 512; }
        if (L < 64) { u.kind = 2; u.pm = (int)(L % 4); u.pn = (int)(L / 4); u.A = memn + (size_t)u.pm * 256 * D * 2; u.B = wkv + (size_t)u.pn * 256 * D * 2; return true; }
        return false;
    }
};
struct I8Sched {
    const char *hn8, *wreg; int G, c;
    __device__ __forceinline__ bool next(int i, gg::Unit& u) const {
        const int rb = NU_B % G, ext = (rb > 0 && NU_8 >= 2 * (G - rb)) ? 2 * (G - rb) : 0, x = (NU_8 - ext) / G, rem = (NU_8 - ext) % G;
        const int cnt1 = x + (c < rem ? 1 : 0);
        long L; u.aux = 0;
        if (i < cnt1) L = (long)i * G + c; else if (ext > 0 && c >= rb && i - cnt1 < 2) L = (long)x * G + rem + 2 * (c - rb) + (i - cnt1); else return false;
        if (L < 64 * NT8) { int pm, pn; gg::tile_order(L, 64, NT8 > 0 ? NT8 : 1, pm, pn); pn = map_tile(pn, true);
            u.kind = 0; u.pm = pm; u.pn = pn; u.A = hn8 + (size_t)pm * 256 * D; u.B = wreg + w_row_off(256 * pn); return true; }
        L -= 64 * NT8;
        if (V_I8 && L < 512) { u.kind = 1; u.pm = (int)(L % 8); u.pn = (int)(L / 8); u.A = wreg + w_row_off(O_VG + 256 * u.pm); u.B = hn8 + (size_t)u.pn * 256 * D; return true; }
        return false;
    }
};
struct I8Epi {
    unsigned char* ws; const float* bgate;
    __device__ __forceinline__ int nst(const gg::Unit& u) const { return 16; }
    __device__ __forceinline__ bool operator()(gg::Acc& acc, const gg::Unit& u, int wr, int wc, int fr, int fq, int wid, int lane) const {
        bf16_t* base; int ldc, col0, mode = 0; const int row0 = u.pm * 256; const float *rs, *cs;
        const float* shn = (const float*)(ws + WS_SHN); const float* sw = (const float*)(ws + WS_SW);
        if (u.kind == 0) { const int c0 = u.pn * 256; rs = shn + row0; cs = sw + c0;
            if (c0 < O_KG) { base = (bf16_t*)(ws + WS_QG); ldc = 1024; col0 = c0; }
            else if (c0 < O_VG) { base = (bf16_t*)(ws + WS_KG); ldc = 1024; col0 = c0 - O_KG; }
            else if (c0 < O_CB) { base = (bf16_t*)(ws + WS_RG); ldc = 2048; col0 = c0 - O_RG; }
            else if (c0 < O_CC) { base = (bf16_t*)(ws + WS_CB); ldc = 2048; col0 = c0 - O_CB; }
            else if (c0 < O_CH) { base = (bf16_t*)(ws + WS_CC); ldc = 2048; col0 = c0 - O_CC; }
            else if (c0 < O_QX) { base = (bf16_t*)(ws + WS_CH); ldc = 2048; col0 = c0 - O_CH; }
            else { base = (bf16_t*)(ws + WS_GT); ldc = 12288; col0 = c0 - O_GT; mode = 1; }
        } else { base = (bf16_t*)(ws + WS_VT); ldc = T; col0 = u.pn * 256; rs = sw + O_VG + row0; cs = shn + col0; }
        float rvv[2][4]; f32x4 cv[2][2], bv[2][2];
#pragma unroll
        for (int ai = 0; ai < 2; ++ai)
#pragma unroll
            for (int m = 0; m < 4; ++m) rvv[ai][m] = rs[ai * 128 + wr * 64 + m * 16 + fr];
#pragma unroll
        for (int bj = 0; bj < 2; ++bj) { const float* cp = cs + bj * 128 + wc * 32 + 8 * fq; cv[bj][0] = *(const f32x4*)cp; cv[bj][1] = *(const f32x4*)(cp + 4);
            bv[bj][0] = (f32x4){0.f, 0.f, 0.f, 0.f}; bv[bj][1] = bv[bj][0];
            if (mode == 1) { const float* bp = bgate + col0 + bj * 128 + wc * 32 + 8 * fq; bv[bj][0] = *(const f32x4*)bp; bv[bj][1] = *(const f32x4*)(bp + 4); } }
#pragma unroll
        for (int bj = 0; bj < 2; ++bj) { const f32x4 c0v = cv[bj][0], c1v = cv[bj][1], b0 = bv[bj][0], b1 = bv[bj][1];
#pragma unroll
            for (int ai = 0; ai < 2; ++ai)
#pragma unroll
                for (int m = 0; m < 4; ++m) { const int r = ai * 128 + wr * 64 + m * 16 + fr; const float rv = rvv[ai][m];
                    const i32x4 i0 = __builtin_bit_cast(i32x4, acc[ai][bj][m][0]), i1 = __builtin_bit_cast(i32x4, acc[ai][bj][m][1]);
                    f32x4 v0 = (f32x4){(float)i0[0], (float)i0[1], (float)i0[2], (float)i0[3]} * (c0v * rv) + b0, v1 = (f32x4){(float)i1[0], (float)i1[1], (float)i1[2], (float)i1[3]} * (c1v * rv) + b1;
                    if (mode == 1) {
#pragma unroll
                        for (int j = 0; j < 4; ++j) { v0[j] = inv_sigmoid(v0[j]); v1[j] = inv_sigmoid(v1[j]); } }
                    u32x4 w; w.x = pk2(v0[0], v0[1]); w.y = pk2(v0[2], v0[3]); w.z = pk2(v1[0], v1[1]); w.w = pk2(v1[2], v1[3]);
                    *(u32x4*)(base + (size_t)(row0 + r) * ldc + col0 + bj * 128 + wc * 32 + 8 * fq) = w; } }
        return true;
    }
};
struct P1Epi {
    unsigned char* ws; const float* bgate;
    __device__ __forceinline__ int nst(const gg::Unit& u) const { return 0; }
    __device__ __forceinline__ bool operator()(gg::Acc& acc, const gg::Unit& u, int wr, int wc, int fr, int fq, int wid, int lane) const {
        bf16_t* base; int ldc, col0, mode = 0; const int row0 = u.pm * 256;
        if (u.kind == 0) { const int c0 = u.pn * 256;
            if (c0 < O_KG) { base = (bf16_t*)(ws + WS_QG); ldc = 1024; col0 = c0; }
            else if (c0 < O_VG) { base = (bf16_t*)(ws + WS_KG); ldc = 1024; col0 = c0 - O_KG; }
            else if (c0 < O_CB) { base = (bf16_t*)(ws + WS_RG); ldc = 2048; col0 = c0 - O_RG; }
            else if (c0 < O_CC) { base = (bf16_t*)(ws + WS_CB); ldc = 2048; col0 = c0 - O_CB; }
            else if (c0 < O_CH) { base = (bf16_t*)(ws + WS_CC); ldc = 2048; col0 = c0 - O_CC; }
            else if (c0 < O_QX) { base = (bf16_t*)(ws + WS_CH); ldc = 2048; col0 = c0 - O_CH; }
            else if (c0 < O_GT) { base = (bf16_t*)(ws + WS_QX); ldc = 2048; col0 = c0 - O_QX; }
            else if (c0 < O_AL) { base = (bf16_t*)(ws + WS_GT); ldc = 12288; col0 = c0 - O_GT; mode = 1; }
            else { base = nullptr; ldc = 0; col0 = 0; mode = 2; }
        } else if (u.kind == 1) { base = (bf16_t*)(ws + WS_VT); ldc = T; col0 = u.pn * 256; }
        else { base = (bf16_t*)(ws + WS_KVM); ldc = 4096; col0 = u.pn * 256; }
        if (mode == 0) { gg::store_bf16_tile(acc, base, ldc, row0, col0, wr, wc, fr, fq); }
        else if (mode == 1) {
#pragma unroll
            for (int bj = 0; bj < 2; ++bj) { const float* bp = bgate + col0 + bj * 128 + wc * 32 + 8 * fq; const f32x4 b0 = *(const f32x4*)bp, b1 = *(const f32x4*)(bp + 4);
#pragma unroll
                for (int ai = 0; ai < 2; ++ai)
#pragma unroll
                    for (int m = 0; m < 4; ++m) { f32x4 v0 = acc[ai][bj][m][0] + b0, v1 = acc[ai][bj][m][1] + b1;
#pragma unroll
                        for (int j = 0; j < 4; ++j) { v0[j] = inv_sigmoid(v0[j]); v1[j] = inv_sigmoid(v1[j]); }
                        u32x4 w; w.x = pk2(v0[0], v0[1]); w.y = pk2(v0[2], v0[3]); w.z = pk2(v1[0], v1[1]); w.w = pk2(v1[2], v1[3]);
                        *(u32x4*)(base + (size_t)(row0 + ai * 128 + wr * 64 + m * 16 + fr) * ldc + col0 + bj * 128 + wc * 32 + 8 * fq) = w; } }
        } else {
            if (wc == 0 && fq < 2) { float* alr = (float*)(ws + WS_ALR);
#pragma unroll
                for (int ai = 0; ai < 2; ++ai)
#pragma unroll
                    for (int m = 0; m < 4; ++m) { float* p = alr + (size_t)(row0 + ai * 128 + wr * 64 + m * 16 + fr) * 16 + 8 * fq;
                        *(f32x4*)p = acc[ai][0][m][0]; *(f32x4*)(p + 4) = acc[ai][0][m][1]; } }
        }
        return true;
    }
};

constexpr int PREP_ROWB = 528;
constexpr int PREP_QT = 0, PREP_KI = 2 * 64 * PREP_ROWB, PREP_ALR = 4 * 64 * PREP_ROWB;
constexpr int PREP_KOT_ROWB = 144;
__device__ __forceinline__ void gla_prep_unit(Frame& F, const Args& a, int unit) {
    const int hp = unit & 1, n = (unit >> 1) & 63, b = unit >> 7;
    const int tid = F.tid, hh = tid >> 8, c = tid & 255, h = 2 * hp + hh, lane = F.lane, wid = F.wave;
    const int tok0 = b * SEQ + n * 64;
    unsigned char* ws = F.ws;
    LAS float* alr_s = (LAS float*)(F.lds + PREP_ALR);
    LAS unsigned char* qt_s = F.lds + PREP_QT + hh * 64 * PREP_ROWB;
    LAS unsigned char* ki_s = F.lds + PREP_KI + hh * 64 * PREP_ROWB;
    if (tid < 256) ((LAS f32x4*)alr_s)[tid] = ((const f32x4*)((const float*)(ws + WS_ALR) + (size_t)tok0 * 16))[tid];
    float w[16];
#pragma unroll
    for (int r = 0; r < 16; ++r) w[r] = a.in[4][r * 1024 + h * 256 + c];
    const float ba = a.in[5][h * 256 + c];
    __syncthreads();
    float bt[64]; float cum = 0.f;
#pragma unroll
    for (int t = 0; t < 64; ++t) {
        float z = ba;
#pragma unroll
        for (int r = 0; r < 16; ++r) z += alr_s[t * 16 + r] * w[r];
        const float ls = fminf(z, 0.f) - __logf(1.0f + __expf(-fabsf(z)));
        cum += ls * (1.0f / 16.0f); bt[t] = cum;
    }
    const bf16_t* qg = (const bf16_t*)(ws + WS_QG) + (size_t)tok0 * 1024 + h * 256 + c;
    const bf16_t* kg = (const bf16_t*)(ws + WS_KG) + (size_t)tok0 * 1024 + h * 256 + c;
#pragma unroll
    for (int t = 0; t < 64; ++t) {
        const float q = bf2f(qg[(size_t)t * 1024]), k = bf2f(kg[(size_t)t * 1024]);
        const float eb = __expf(bt[t]);
        *(LAS bf16_t*)(qt_s + t * PREP_ROWB + c * 2) = (bf16_t)f2bf(q * eb * 0.0625f);
        *(LAS bf16_t*)(ki_s + t * PREP_ROWB + c * 2) = (bf16_t)f2bf(k * __expf(-bt[t]));
    }
    unsigned char* blk = ws + WS_GLAB + (size_t)((b * 4 + h) * 64 + n) * GLA_BLK;
    ((float*)(blk + 73728))[c] = __expf(cum);
    __syncthreads();
    {
        const int whh = wid >> 2, mb = wid & 3, fr = lane & 15, fq = lane >> 4;
        LAS unsigned char* qs = F.lds + PREP_QT + whh * 64 * PREP_ROWB; LAS unsigned char* ks = F.lds + PREP_KI + whh * 64 * PREP_ROWB;
        unsigned char* wblk = ws + WS_GLAB + (size_t)((b * 4 + 2 * hp + whh) * 64 + n) * GLA_BLK;
        bf16_t* attf = (bf16_t*)(wblk + 65536);
#pragma unroll
        for (int nb = 0; nb < 4; ++nb) {
            f32x4 acc = (f32x4){0.f, 0.f, 0.f, 0.f};
            if (nb <= mb) {
#pragma unroll
                for (int kk = 0; kk < 8; ++kk) {
                    const bf16x8 av = *(const LAS bf16x8*)(qs + (16 * mb + fr) * PREP_ROWB + (32 * kk + 8 * fq) * 2);
                    const bf16x8 bv = *(const LAS bf16x8*)(ks + (16 * nb + fr) * PREP_ROWB + (32 * kk + 8 * fq) * 2);
                    acc = __builtin_amdgcn_mfma_f32_16x16x32_bf16(av, bv, acc, 0, 0, 0);
                }
            }
            const int s = 16 * nb + fr;
#pragma unroll
            for (int j = 0; j < 4; ++j) { const int t = 16 * mb + 4 * fq + j; const float v = (s <= t) ? acc[j] : 0.f;
                attf[((mb * 2 + (s >> 5)) * 64 + (t & 15) + 16 * ((s & 31) >> 3)) * 8 + (s & 7)] = (bf16_t)f2bf(v); }
        }
        u32x4* qtf = (u32x4*)wblk;
#pragma unroll
        for (int i = 0; i < 8; ++i) { const int f = (wid & 3) * 8 + i, mb2 = f >> 3, kk = f & 7;
            const LAS unsigned char* rowp = qs + (16 * mb2 + fr) * PREP_ROWB + (32 * kk + 4 * fq) * 2;
            const u32x2 lo = *(const LAS u32x2*)rowp, hi = *(const LAS u32x2*)(rowp + 32);
            u32x4 o; o.x = lo.x; o.y = lo.y; o.z = hi.x; o.w = hi.y; qtf[f * 64 + lane] = o; }
    }
    __syncthreads();
    {
        LAS unsigned char* kot = F.lds + hh * 256 * PREP_KOT_ROWB + c * PREP_KOT_ROWB;
#pragma unroll
        for (int t8 = 0; t8 < 8; ++t8) { float v[8];
#pragma unroll
            for (int j = 0; j < 8; ++j) { const int t = t8 * 8 + j; v[j] = bf2f(kg[(size_t)t * 1024]) * __expf(cum - bt[t]); }
            u32x4 o; o.x = pk2(v[0], v[1]); o.y = pk2(v[2], v[3]); o.z = pk2(v[4], v[5]); o.w = pk2(v[6], v[7]);
            *(LAS u32x4*)(kot + t8 * 16) = o; }
    }
    __syncthreads();
    {
        const int whh = wid >> 2, fr = lane & 15, fq = lane >> 4;
        unsigned char* wblk = ws + WS_GLAB + (size_t)((b * 4 + 2 * hp + whh) * 64 + n) * GLA_BLK;
        u32x4* kof = (u32x4*)(wblk + 32768);
        const LAS unsigned char* kb = F.lds + whh * 256 * PREP_KOT_ROWB;
#pragma unroll
        for (int i = 0; i < 8; ++i) { const int f = (wid & 3) * 8 + i, mbc = f >> 1, kk2 = f & 1;
            kof[f * 64 + lane] = *(const LAS u32x4*)(kb + (16 * mbc + fr) * PREP_KOT_ROWB + (32 * kk2 + 8 * fq) * 2); }
    }
    __syncthreads();
}

__device__ __forceinline__ void conv_phase(Frame& F, const Args& a, int wg, int nwg) {
    unsigned char* ws = F.ws;
    const size_t gt = (size_t)wg * 512 + F.tid, ngt = (size_t)nwg * 512;
    u32x4* cb = (u32x4*)(ws + WS_CB); const u32x4* cc = (const u32x4*)(ws + WS_CC); const u32x4* ch = (const u32x4*)(ws + WS_CH);
    const float* cw = a.in[7];
    for (size_t p = gt; p < (size_t)T * 256; p += ngt) {
        const int t = (int)(p >> 8), c8 = (int)(p & 255) * 8, pos = t & (SEQ - 1);
        float accv[8];
#pragma unroll
        for (int j = 0; j < 8; ++j) accv[j] = 0.f;
#pragma unroll
        for (int d = 0; d < 3; ++d) {
            if (pos >= d) { const u32x4 x = cc[p - (size_t)d * 256], y = ch[p - (size_t)d * 256];
                const f32x4 w0 = *(const f32x4*)(cw + d * 2048 + c8), w1 = *(const f32x4*)(cw + d * 2048 + c8 + 4);
                accv[0] += w0.x * (bflo(x.x) * bflo(y.x)); accv[1] += w0.y * (bfhi(x.x) * bfhi(y.x));
                accv[2] += w0.z * (bflo(x.y) * bflo(y.y)); accv[3] += w0.w * (bfhi(x.y) * bfhi(y.y));
                accv[4] += w1.x * (bflo(x.z) * bflo(y.z)); accv[5] += w1.y * (bfhi(x.z) * bfhi(y.z));
                accv[6] += w1.z * (bflo(x.w) * bflo(y.w)); accv[7] += w1.w * (bfhi(x.w) * bfhi(y.w)); }
        }
        const u32x4 bv = cb[p]; u32x4 o;
        o.x = pk2(bflo(bv.x) * accv[0], bfhi(bv.x) * accv[1]); o.y = pk2(bflo(bv.y) * accv[2], bfhi(bv.y) * accv[3]);
        o.z = pk2(bflo(bv.z) * accv[4], bfhi(bv.z) * accv[5]); o.w = pk2(bflo(bv.w) * accv[6], bfhi(bv.w) * accv[7]);
        cb[p] = o;
    }
}

struct XsSched {
    const char *hn, *wkt; int G, c;
    __device__ __forceinline__ bool next(int i, gg::Unit& u) const {
        const long L = (long)i * G + c; if (L >= 256) return false;
        const int xcd = (int)(L % 8), off = (int)(L / 8), w = xcd * 32 + off;
        const int pm = w >> 2, h = w & 3, b = pm >> 4;
        u.kind = 0; u.pm = pm; u.pn = h; u.aux = 0;
        u.A = hn + (size_t)pm * 256 * D * 2; u.B = wkt + ((size_t)(b * 1024 + h * 256) * D) * 2; return true;
    }
};
struct WkSched {
    const char *kvm, *wqx; int G, c;
    __device__ __forceinline__ bool next(int i, gg::Unit& u) const {
        const long L = (long)i * G + c; if (L >= 256) return false;
        const int bh = (int)(L >> 4), ntile = (int)(L & 15), b = bh >> 2, h = bh & 3;
        u.kind = 0; u.pm = b * 4 + h; u.pn = ntile; u.aux = 0;
        u.A = kvm + ((size_t)(b * 256) * 4096 + h * 512) * 2; u.B = wqx + ((size_t)(ntile * 256) * 2048 + h * 512) * 2; return true;
    }
};
struct WkEpi {
    bf16_t* wkt;
    __device__ __forceinline__ int nst(const gg::Unit& u) const { return 16; }
    __device__ __forceinline__ bool operator()(gg::Acc& acc, const gg::Unit& u, int wr, int wc, int fr, int fq, int wid, int lane) const {
        gg::store_bf16_tile(acc, wkt, D, u.pm * 256, u.pn * 256, wr, wc, fr, fq); return true;
    }
};
struct XsEpi {
    bf16_t* prob; LAS unsigned char* ex;
    __device__ __forceinline__ int nst(const gg::Unit& u) const { return 0; }
    __device__ __forceinline__ bool operator()(gg::Acc& acc, const gg::Unit& u, int wr, int wc, int fr, int fq, int wid, int lane) const {
        LAS float* MX = (LAS float*)ex; LAS float* SM = (LAS float*)(ex + 4096);
        const float sc = 0.04419417382f * 1.44269504089f;
#pragma unroll
        for (int ai = 0; ai < 2; ++ai)
#pragma unroll
            for (int m = 0; m < 4; ++m) { float v = -3.0e38f;
#pragma unroll
                for (int bj = 0; bj < 2; ++bj)
#pragma unroll
                    for (int n = 0; n < 2; ++n) { const f32x4 x = acc[ai][bj][m][n]; v = fmaxf(v, fmaxf(fmaxf(x[0], x[1]), fmaxf(x[2], x[3]))); }
                v = fmaxf(v, __shfl_xor(v, 16)); v = fmaxf(v, __shfl_xor(v, 32));
                if (fq == 0) MX[(ai * 128 + wr * 64 + m * 16 + fr) * 4 + wc] = v; }
        LDS_WAIT(); __builtin_amdgcn_s_barrier(); asm volatile("" ::: "memory");
#pragma unroll
        for (int ai = 0; ai < 2; ++ai)
#pragma unroll
            for (int m = 0; m < 4; ++m) { const f32x4 q = *(const LAS f32x4*)(MX + (ai * 128 + wr * 64 + m * 16 + fr) * 4);
                const float rm = fmaxf(fmaxf(q[0], q[1]), fmaxf(q[2], q[3])); float s = 0.f;
#pragma unroll
                for (int bj = 0; bj < 2; ++bj)
#pragma unroll
                    for (int n = 0; n < 2; ++n) {
#pragma unroll
                        for (int j = 0; j < 4; ++j) { const float e = __builtin_amdgcn_exp2f((acc[ai][bj][m][n][j] - rm) * sc); acc[ai][bj][m][n][j] = e; s += e; } }
                s += __shfl_xor(s, 16); s += __shfl_xor(s, 32);
                if (fq == 0) SM[(ai * 128 + wr * 64 + m * 16 + fr) * 4 + wc] = s; }
        LDS_WAIT(); __builtin_amdgcn_s_barrier(); asm volatile("" ::: "memory");
        const int b = u.pm >> 4, panel = u.pm & 15, h = u.pn;
#pragma unroll
        for (int ai = 0; ai < 2; ++ai)
#pragma unroll
            for (int m = 0; m < 4; ++m) { const f32x4 q = *(const LAS f32x4*)(SM + (ai * 128 + wr * 64 + m * 16 + fr) * 4);
                const float inv = 1.0f / ((q[0] + q[1]) + (q[2] + q[3]));
                bf16_t* rowp = prob + (size_t)(b * SEQ + panel * 256 + ai * 128 + wr * 64 + m * 16 + fr) * 2048 + h * 256 + wc * 32 + 8 * fq;
#pragma unroll
                for (int bj = 0; bj < 2; ++bj) { const f32x4 v0 = acc[ai][bj][m][0] * inv, v1 = acc[ai][bj][m][1] * inv;
                    u32x4 w; w.x = pk2(v0[0], v0[1]); w.y = pk2(v0[2], v0[3]); w.z = pk2(v1[0], v1[1]); w.w = pk2(v1[2], v1[3]);
                    *(u32x4*)(rowp + bj * 128) = w; } }
        return true;
    }
};

__device__ __forceinline__ void gla_scan_unit(Frame& F, const Args& a, int unit) {
    const int dvq = (unit >> 3) & 3, bh = (unit & 7) + 8 * (unit >> 5), h = bh & 3, b = bh >> 2;
    const int lane = F.lane, wid = F.wave, fr = lane & 15, fq = lane >> 4;
    unsigned char* ws = F.ws;
    const unsigned char* blk0 = ws + WS_GLAB + (size_t)((b * 4 + h) * 64) * GLA_BLK;
    const int dvcol = 16 * (8 * dvq + wid);
    const bf16_t* vt = (const bf16_t*)(ws + WS_VT) + (size_t)(h * 512 + dvcol + fr) * T + (size_t)b * SEQ + 8 * fq;
    bf16_t* og = (bf16_t*)(ws + WS_OG) + (size_t)(b * SEQ) * 2048 + h * 512 + dvcol + fr;
    f32x4 S[16];
#pragma unroll
    for (int i = 0; i < 16; ++i) S[i] = (f32x4){0.f, 0.f, 0.f, 0.f};
    for (int p = wid; p < 73; p += 8)
        __builtin_amdgcn_global_load_lds((const unsigned*)(blk0 + (size_t)p * 1024 + lane * 16), (LAS unsigned*)(F.lds + p * 1024), 16, 0, 0);
    bf16x8 vf[2], vn[2];
    vf[0] = *(const bf16x8*)(vt); vf[1] = *(const bf16x8*)(vt + 32);
    vn[0] = vf[0]; vn[1] = vf[1];
    VM_WAIT(); __syncthreads();
    for (int n = 0; n < 64; ++n) {
        LAS unsigned char* buf = F.lds + (n & 1) * GLA_BLK;
        if (n < 63) {
            const unsigned char* nb = blk0 + (size_t)(n + 1) * GLA_BLK; LAS unsigned char* dst = F.lds + ((n + 1) & 1) * GLA_BLK;
            for (int p = wid; p < 73; p += 8)
                __builtin_amdgcn_global_load_lds((const unsigned*)(nb + (size_t)p * 1024 + lane * 16), (LAS unsigned*)(dst + p * 1024), 16, 0, 0);
            vn[0] = *(const bf16x8*)(vt + 64 * (n + 1)); vn[1] = *(const bf16x8*)(vt + 64 * (n + 1) + 32);
        }
        f32x4 o[4];
#pragma unroll
        for (int mb = 0; mb < 4; ++mb) o[mb] = (f32x4){0.f, 0.f, 0.f, 0.f};
#pragma unroll
        for (int kk = 0; kk < 8; ++kk) {
            u32x4 bw; bw.x = pk2(S[2 * kk][0], S[2 * kk][1]); bw.y = pk2(S[2 * kk][2], S[2 * kk][3]); bw.z = pk2(S[2 * kk + 1][0], S[2 * kk + 1][1]); bw.w = pk2(S[2 * kk + 1][2], S[2 * kk + 1][3]);
            const bf16x8 bfr = __builtin_bit_cast(bf16x8, bw);
#pragma unroll
            for (int mb = 0; mb < 4; ++mb) { const bf16x8 af = *(const LAS bf16x8*)(buf + ((mb * 8 + kk) * 64 + lane) * 16);
                o[mb] = __builtin_amdgcn_mfma_f32_16x16x32_bf16(af, bfr, o[mb], 0, 0, 0); }
        }
#pragma unroll
        for (int kk = 0; kk < 2; ++kk)
#pragma unroll
            for (int mb = 0; mb < 4; ++mb) { const bf16x8 af = *(const LAS bf16x8*)(buf + 65536 + ((mb * 2 + kk) * 64 + lane) * 16);
                o[mb] = __builtin_amdgcn_mfma_f32_16x16x32_bf16(af, vf[kk], o[mb], 0, 0, 0); }
        {
            bf16_t* op = og + (size_t)(64 * n) * 2048;
#pragma unroll
            for (int mb = 0; mb < 4; ++mb)
#pragma unroll
                for (int j = 0; j < 4; ++j) op[(size_t)(16 * mb + 4 * fq + j) * 2048] = (bf16_t)f2bf(o[mb][j]);
        }
#pragma unroll
        for (int mb = 0; mb < 16; ++mb) {
            const f32x4 dc = *(const LAS f32x4*)(buf + 73728 + (16 * mb + 4 * fq) * 4);
            S[mb] = S[mb] * dc;
#pragma unroll
            for (int kk = 0; kk < 2; ++kk) { const bf16x8 af = *(const LAS bf16x8*)(buf + 32768 + ((mb * 2 + kk) * 64 + lane) * 16);
                S[mb] = __builtin_amdgcn_mfma_f32_16x16x32_bf16(af, vf[kk], S[mb], 0, 0, 0); }
        }
        vf[0] = vn[0]; vf[1] = vn[1];
        VM_WAIT(); __syncthreads();
    }
}

struct VwSched {
    const char *wxa, *kvm; int G, c;
    __device__ __forceinline__ bool next(int i, gg::Unit& u) const {
        const long L = (long)i * G + c; if (L >= 256) return false;
        const int bh = (int)(L >> 4), pm = (int)(L & 15), b = bh >> 2, h = bh & 3;
        u.kind = 0; u.pm = b * 16 + pm; u.pn = h; u.aux = 0;
        u.A = wxa + ((size_t)(pm * 256) * 2048 + h * 512) * 2; u.B = kvm + ((size_t)(b * 256) * 4096 + 2048 + h * 512) * 2; return true;
    }
};
struct VwEpi {
    bf16_t* vwt;
    __device__ __forceinline__ int nst(const gg::Unit& u) const { return 16; }
    __device__ __forceinline__ bool operator()(gg::Acc& acc, const gg::Unit& u, int wr, int wc, int fr, int fq, int wid, int lane) const {
        gg::store_bf16_tile(acc, vwt, 2048, u.pm * 256, u.pn * 256, wr, wc, fr, fq); return true;
    }
};

__device__ __forceinline__ void gla_post_phase(Frame& F, const Args& a) {
    unsigned char* ws = F.ws;
    const int gw = F.bid * 8 + F.wave, NGW = F.G * 8, lane = F.lane;
    const float* gn = a.in[6];
    const f32x4 g0 = *(const f32x4*)(gn + lane * 8), g1 = *(const f32x4*)(gn + lane * 8 + 4);
    for (int t = gw; t < T; t += NGW) {
        const u32x4* orow = (const u32x4*)((const bf16_t*)(ws + WS_OG) + (size_t)t * 2048); u32x4* rrow = (u32x4*)((bf16_t*)(ws + WS_RG) + (size_t)t * 2048);
#pragma unroll
        for (int h = 0; h < 4; ++h) {
            const u32x4 ov = orow[h * 64 + lane], rv = rrow[h * 64 + lane];
            float o[8] = {bflo(ov.x), bfhi(ov.x), bflo(ov.y), bfhi(ov.y), bflo(ov.z), bfhi(ov.z), bflo(ov.w), bfhi(ov.w)};
            float r[8] = {bflo(rv.x), bfhi(rv.x), bflo(rv.y), bfhi(rv.y), bflo(rv.z), bfhi(rv.z), bflo(rv.w), bfhi(rv.w)};
            float s = 0.f;
#pragma unroll
            for (int j = 0; j < 8; ++j) s += o[j] * o[j];
            const float rstd = rsqrtf(wave_sum(s) * (1.f / 512.f) + EPS);
            const float gv[8] = {g0.x, g0.y, g0.z, g0.w, g1.x, g1.y, g1.z, g1.w};
            float y[8];
#pragma unroll
            for (int j = 0; j < 8; ++j) y[j] = o[j] * rstd * gv[j] * (r[j] * fast_sigmoid(r[j]));
            u32x4 w; w.x = pk2(y[0], y[1]); w.y = pk2(y[2], y[3]); w.z = pk2(y[4], y[5]); w.w = pk2(y[6], y[7]);
            rrow[h * 64 + lane] = w;
        }
    }
}

struct MgSched {
    const char *a0, *a1, *a2, *wbr, *vwt; int G, c;
    __device__ __forceinline__ bool next(int i, gg::Unit& u) const {
        const int ti = i / 3, br = i - 3 * ti; int pm, pn;
        if (!gg::tile_order((long)ti * G + c, 64, 16, pm, pn)) return false;
        u.kind = br; u.pm = pm; u.pn = pn; u.aux = br == 2 ? 16 : 32;
        const char* ab = br == 0 ? a0 : (br == 1 ? a1 : a2);
        u.A = ab + (size_t)pm * 256 * 2048 * 2;
        u.B = br == 2 ? vwt + ((size_t)((pm >> 4) * 4096 + pn * 256) * 2048) * 2 : wbr + (size_t)br * 16 * MiB + (size_t)pn * 256 * 2048 * 2; return true;
    }
};
struct MgEpi {
    const bf16_t* gt; bf16_t* merged;
    __device__ __forceinline__ int nst(const gg::Unit& u) const { return u.kind == 2 ? 16 : 0; }
    __device__ __forceinline__ bool operator()(gg::Acc& acc, const gg::Unit& u, int wr, int wc, int fr, int fq, int wid, int lane) const {
        const int br = u.kind;
#pragma unroll
        for (int ai = 0; ai < 2; ++ai) {
            u32x4 ga[4][2], gb[4][2];
#pragma unroll
            for (int m = 0; m < 4; ++m) { const size_t row = (size_t)(u.pm * 256 + ai * 128 + wr * 64 + m * 16 + fr);
#pragma unroll
                for (int bj = 0; bj < 2; ++bj) { const int col = u.pn * 256 + bj * 128 + wc * 32 + 8 * fq;
                    ga[m][bj] = *(const u32x4*)(gt + row * 12288 + br * 4096 + col);
                    gb[m][bj] = (br < 2) ? *(const u32x4*)(gt + row * 12288 + (br + 1) * 4096 + col) : (u32x4){0x3f803f80u, 0x3f803f80u, 0x3f803f80u, 0x3f803f80u}; } }
#pragma unroll
            for (int m = 0; m < 4; ++m) { const size_t row = (size_t)(u.pm * 256 + ai * 128 + wr * 64 + m * 16 + fr);
#pragma unroll
                for (int bj = 0; bj < 2; ++bj) { const int col = u.pn * 256 + bj * 128 + wc * 32 + 8 * fq;
                    const u32x4 a4 = ga[m][bj], b4 = gb[m][bj];
                    float g[8] = {bflo(a4.x), bfhi(a4.x), bflo(a4.y), bfhi(a4.y), bflo(a4.z), bfhi(a4.z), bflo(a4.w), bfhi(a4.w)};
                    if (br < 2) { const float d[8] = {bflo(b4.x), bfhi(b4.x), bflo(b4.y), bfhi(b4.y), bflo(b4.z), bfhi(b4.z), bflo(b4.w), bfhi(b4.w)};
#pragma unroll
                        for (int j = 0; j < 8; ++j) g[j] = d[j] * __builtin_amdgcn_rcpf(g[j]); }
                    else {
#pragma unroll
                        for (int j = 0; j < 8; ++j) g[j] = __builtin_amdgcn_rcpf(g[j]); }
                    f32x4 v0 = acc[ai][bj][m][0], v1 = acc[ai][bj][m][1];
                    v0[0] *= g[0]; v0[1] *= g[1]; v0[2] *= g[2]; v0[3] *= g[3]; v1[0] *= g[4]; v1[1] *= g[5]; v1[2] *= g[6]; v1[3] *= g[7];
                    if (br < 2) { acc[ai][bj][m][0] = v0; acc[ai][bj][m][1] = v1; }
                    else { u32x4 w; w.x = pk2(v0[0], v0[1]); w.y = pk2(v0[2], v0[3]); w.z = pk2(v1[0], v1[1]); w.w = pk2(v1[2], v1[3]);
                        *(u32x4*)(merged + row * D + col) = w; } } }
        }
        return br == 2;
    }
};

struct GridSched {
    const char *A, *B; int nM, nN, lda2, ldb2, G, c;
    __device__ __forceinline__ bool next(int i, gg::Unit& u) const {
        int pm, pn; if (!gg::tile_order((long)i * G + c, nM, nN, pm, pn)) return false;
        u.kind = 0; u.pm = pm; u.pn = pn; u.aux = 0; u.A = A + (size_t)pm * 256 * lda2; u.B = B + (size_t)pn * 256 * ldb2; return true;
    }
};
struct ResEpi {
    const float* x; bf16_t* x1b;
    __device__ __forceinline__ int nst(const gg::Unit& u) const { return 16; }
    __device__ __forceinline__ bool operator()(gg::Acc& acc, const gg::Unit& u, int wr, int wc, int fr, int fq, int wid, int lane) const {
#pragma unroll
        for (int ai = 0; ai < 2; ++ai) {
            f32x4 xv[4][2][2];
#pragma unroll
            for (int m = 0; m < 4; ++m) { const size_t off = (size_t)(u.pm * 256 + ai * 128 + wr * 64 + m * 16 + fr) * D + u.pn * 256 + wc * 32 + 8 * fq;
#pragma unroll
                for (int bj = 0; bj < 2; ++bj) { xv[m][bj][0] = *(const f32x4*)(x + off + bj * 128); xv[m][bj][1] = *(const f32x4*)(x + off + bj * 128 + 4); } }
#pragma unroll
            for (int m = 0; m < 4; ++m) { const size_t off = (size_t)(u.pm * 256 + ai * 128 + wr * 64 + m * 16 + fr) * D + u.pn * 256 + wc * 32 + 8 * fq;
#pragma unroll
                for (int bj = 0; bj < 2; ++bj) { const f32x4 v0 = xv[m][bj][0] + acc[ai][bj][m][0], v1 = xv[m][bj][1] + acc[ai][bj][m][1];
                    u32x4 w; w.x = pk2(v0[0], v0[1]); w.y = pk2(v0[2], v0[3]); w.z = pk2(v1[0], v1[1]); w.w = pk2(v1[2], v1[3]);
                    *(u32x4*)(x1b + off + bj * 128) = w; } }
        }
        return true;
    }
};
struct PqEpi {
    bf16_t* o; const float* rs; const float* cs;
    __device__ __forceinline__ int nst(const gg::Unit& u) const { return 16; }
    __device__ __forceinline__ bool operator()(gg::Acc& acc, const gg::Unit& u, int wr, int wc, int fr, int fq, int wid, int lane) const {
        const int row0 = u.pm * 256, col0 = u.pn * 256;
        float rvv[2][4]; f32x4 cv[2][2];
#pragma unroll
        for (int ai = 0; ai < 2; ++ai)
#pragma unroll
            for (int m = 0; m < 4; ++m) rvv[ai][m] = rs[row0 + ai * 128 + wr * 64 + m * 16 + fr];
#pragma unroll
        for (int bj = 0; bj < 2; ++bj) { const float* cp = cs + col0 + bj * 128 + wc * 32 + 8 * fq; cv[bj][0] = *(const f32x4*)cp; cv[bj][1] = *(const f32x4*)(cp + 4); }
#pragma unroll
        for (int bj = 0; bj < 2; ++bj) { const f32x4 c0v = cv[bj][0], c1v = cv[bj][1];
#pragma unroll
            for (int ai = 0; ai < 2; ++ai)
#pragma unroll
                for (int m = 0; m < 4; ++m) { const int r = row0 + ai * 128 + wr * 64 + m * 16 + fr; const float rv = rvv[ai][m];
                    const i32x4 i0 = __builtin_bit_cast(i32x4, acc[ai][bj][m][0]), i1 = __builtin_bit_cast(i32x4, acc[ai][bj][m][1]);
                    const f32x4 v0 = (f32x4){(float)i0[0], (float)i0[1], (float)i0[2], (float)i0[3]} * (c0v * rv), v1 = (f32x4){(float)i1[0], (float)i1[1], (float)i1[2], (float)i1[3]} * (c1v * rv);
                    u32x4 w; w.x = pk2(v0[0], v0[1]); w.y = pk2(v0[2], v0[3]); w.z = pk2(v1[0], v1[1]); w.w = pk2(v1[2], v1[3]);
                    *(u32x4*)(o + (size_t)r * 2048 + col0 + bj * 128 + wc * 32 + 8 * fq) = w; } }
        return true;
    }
};
struct Bf16Epi {
    bf16_t* o; int ldc;
    __device__ __forceinline__ int nst(const gg::Unit& u) const { return 16; }
    __device__ __forceinline__ bool operator()(gg::Acc& acc, const gg::Unit& u, int wr, int wc, int fr, int fq, int wid, int lane) const {
        gg::store_bf16_tile(acc, o, ldc, u.pm * 256, u.pn * 256, wr, wc, fr, fq); return true;
    }
};

__device__ __forceinline__ int f2ord(float f) { const int b = __float_as_int(f); return b ^ ((b >> 31) & 0x7fffffff); }
__device__ __forceinline__ float ord2f(int o) { return __int_as_float(o ^ ((o >> 31) & 0x7fffffff)); }
__device__ __forceinline__ void cex_desc(int& hi, int& lo) { const int a = hi, b = lo; hi = a > b ? a : b; lo = a > b ? b : a; }
__device__ __forceinline__ void bsort16_desc(int (&a)[16]) {
#pragma unroll
    for (int k = 2; k <= 16; k <<= 1)
#pragma unroll
        for (int j = k >> 1; j > 0; j >>= 1)
#pragma unroll
            for (int i = 0; i < 16; ++i) { const int l = i ^ j; if (l > i) { if ((i & k) == 0) cex_desc(a[i], a[l]); else cex_desc(a[l], a[i]); } }
}
__device__ __forceinline__ void bmerge16_desc(int (&a)[16]) {
#pragma unroll
    for (int j = 8; j > 0; j >>= 1)
#pragma unroll
        for (int i = 0; i < 16; ++i) { const int l = i ^ j; if (l > i) cex_desc(a[i], a[l]); }
}
__device__ __forceinline__ void top16_merge(int (&a)[16], const int (&b)[16]) {
#pragma unroll
    for (int i = 0; i < 16; ++i) a[i] = a[i] > b[15 - i] ? a[i] : b[15 - i];
    bmerge16_desc(a);
}
constexpr int RT_SKROW = 272;
constexpr int RT_SK = 2 * 128 * RT_SKROW;
__device__ __forceinline__ void route_topk16(const f32x4 (&acc)[8], int fq, int (&res)[16]) {
    int a[16], b[16];
#pragma unroll
    for (int mb = 0; mb < 4; ++mb)
#pragma unroll
        for (int j = 0; j < 4; ++j) { a[mb * 4 + j] = (f2ord(acc[mb][j]) & ~127) | (127 - (16 * mb + 4 * fq + j)); b[mb * 4 + j] = (f2ord(acc[mb + 4][j]) & ~127) | (127 - (16 * (mb + 4) + 4 * fq + j)); }
    bsort16_desc(a); bsort16_desc(b); top16_merge(a, b);
#pragma unroll
    for (int x = 16; x <= 32; x <<= 1) {
#pragma unroll
        for (int i = 0; i < 16; ++i) b[i] = __shfl_xor(a[i], x);
        top16_merge(a, b);
    }
#pragma unroll
    for (int i = 0; i < 16; ++i) res[i] = a[i];
}
__device__ __forceinline__ void route_job(Frame& F, const Args& a, int job) {
    unsigned char* ws = F.ws;
    const int tid = F.tid, lane = F.lane, wid = F.wave, fr = lane & 15, fq = lane >> 4;
    const int h = job & 7, chunk = job >> 3;
    const bf16_t* pq = (const bf16_t*)(ws + WS_PQ); const bf16_t* sk = (const bf16_t*)(ws + WS_SUBK) + (size_t)h * 2 * 128 * 128;
    for (int p = tid; p < 4096; p += 512) { const int row = p >> 4, pc = p & 15; *(LAS u32x4*)(F.lds + row * RT_SKROW + pc * 16) = ((const u32x4*)sk)[p]; }
    __syncthreads();
    LAS int* IX = (LAS int*)(F.lds + RT_SK) + wid * 512;
#pragma unroll 1
    for (int it = 0; it < 4; ++it) {
        const int tok0 = (chunk * 32 + wid * 4 + it) * 16;
        int top[2][16];
#pragma unroll
        for (int c = 0; c < 2; ++c) {
            f32x4 acc[8];
#pragma unroll
            for (int mb = 0; mb < 8; ++mb) acc[mb] = (f32x4){0.f, 0.f, 0.f, 0.f};
            bf16x8 bfr[4];
#pragma unroll
            for (int kk = 0; kk < 4; ++kk) bfr[kk] = *(const bf16x8*)(pq + (size_t)(tok0 + fr) * 2048 + h * 256 + c * 128 + 32 * kk + 8 * fq);
#pragma unroll
            for (int kk = 0; kk < 4; ++kk)
#pragma unroll
                for (int mb = 0; mb < 8; ++mb) { const bf16x8 af = *(const LAS bf16x8*)(F.lds + (c * 128 + 16 * mb + fr) * RT_SKROW + (32 * kk + 8 * fq) * 2);
                    acc[mb] = __builtin_amdgcn_mfma_f32_16x16x32_bf16(af, bfr[kk], acc[mb], 0, 0, 0); }
            route_topk16(acc, fq, top[c]);
        }
        float f0[16], f1[16];
#pragma unroll
        for (int i = 0; i < 16; ++i) { f0[i] = ord2f(top[0][i] & ~127); f1[i] = ord2f(top[1][i] & ~127); }
        int g[4][16];
#pragma unroll
        for (int q = 0; q < 4; ++q)
#pragma unroll
            for (int i = 0; i < 16; ++i) g[q][i] = (int)0x80000000;
        {
            int nc = 0;
#pragma unroll
            for (int i = 0; i < 16; ++i)
#pragma unroll
                for (int j = 0; j < 16; ++j) if ((i + 1) * (j + 1) <= 16) { g[nc >> 4][nc & 15] = (f2ord(f0[i] + f1[j]) & ~255) | (255 - (i * 16 + j)); ++nc; }
        }
        bsort16_desc(g[0]); bsort16_desc(g[1]); bsort16_desc(g[2]); bsort16_desc(g[3]);
        top16_merge(g[0], g[1]); top16_merge(g[2], g[3]); top16_merge(g[0], g[2]);
        if (fq == 0) {
#pragma unroll
            for (int i = 0; i < 16; ++i) { IX[fr * 32 + i] = 127 - (top[0][i] & 127); IX[fr * 32 + 16 + i] = 127 - (top[1][i] & 127); }
        }
        LDS_WAIT(); asm volatile("" ::: "memory");
        if (fq == 0) {
            const float vmax = ord2f(g[0][0] & ~255); float e[16]; float s = 0.f; int ex[16];
#pragma unroll
            for (int r = 0; r < 16; ++r) { e[r] = __expf(ord2f(g[0][r] & ~255) - vmax); s += e[r]; const int ij = 255 - (g[0][r] & 255); ex[r] = IX[fr * 32 + (ij >> 4)] * 128 + IX[fr * 32 + 16 + (ij & 15)]; }
            const float inv = 1.0f / s;
            int* eidx = (int*)(ws + WS_EIDX) + (size_t)(tok0 + fr) * 128 + h * 16; float* gw = (float*)(ws + WS_GW) + (size_t)(tok0 + fr) * 128 + h * 16;
#pragma unroll
            for (int q = 0; q < 4; ++q) { *(u32x4*)(eidx + 4 * q) = (u32x4){(unsigned)ex[4 * q], (unsigned)ex[4 * q + 1], (unsigned)ex[4 * q + 2], (unsigned)ex[4 * q + 3]};
                *(f32x4*)(gw + 4 * q) = (f32x4){e[4 * q] * inv, e[4 * q + 1] * inv, e[4 * q + 2] * inv, e[4 * q + 3] * inv}; }
        }
        LDS_WAIT(); asm volatile("" ::: "memory");
    }
    __syncthreads();
}

__device__ __forceinline__ float ub0(unsigned w) { return (float)(w & 255u); }
__device__ __forceinline__ float ub1(unsigned w) { return (float)((w >> 8) & 255u); }
__device__ __forceinline__ float ub2(unsigned w) { return (float)((w >> 16) & 255u); }
__device__ __forceinline__ float ub3(unsigned w) { return (float)(w >> 24); }
#define P10_LOADU(buf, kbase) do { _Pragma("unroll") for (int r = 0; r < 4; ++r) { const int k_ = (kbase) + r; const int e_ = __builtin_amdgcn_readlane(k_ < 64 ? ev0 : ev1, k_ & 63); \
        const u32x4* rp_ = (const u32x4*)(ub + (size_t)e_ * 2048); buf[r][0] = rp_[lane]; buf[r][1] = rp_[64 + lane]; } } while (0)
#define P10_COMPU(buf, kbase) do { _Pragma("unroll") for (int r = 0; r < 4; ++r) { int s_ = 0; \
        _Pragma("unroll") for (int p = 0; p < 2; ++p) { const unsigned x0 = buf[r][p].x, x1 = buf[r][p].y, x2 = buf[r][p].z, x3 = buf[r][p].w; \
            s_ = __builtin_amdgcn_sdot4((int)(x0 & 0x0F0F0F0Fu), (int)hv[p][0].x, s_, false); s_ = __builtin_amdgcn_sdot4((int)((x0 >> 4) & 0x0F0F0F0Fu), (int)hv[p][0].y, s_, false); \
            s_ = __builtin_amdgcn_sdot4((int)(x1 & 0x0F0F0F0Fu), (int)hv[p][0].z, s_, false); s_ = __builtin_amdgcn_sdot4((int)((x1 >> 4) & 0x0F0F0F0Fu), (int)hv[p][0].w, s_, false); \
            s_ = __builtin_amdgcn_sdot4((int)(x2 & 0x0F0F0F0Fu), (int)hv[p][1].x, s_, false); s_ = __builtin_amdgcn_sdot4((int)((x2 >> 4) & 0x0F0F0F0Fu), (int)hv[p][1].y, s_, false); \
            s_ = __builtin_amdgcn_sdot4((int)(x3 & 0x0F0F0F0Fu), (int)hv[p][1].z, s_, false); s_ = __builtin_amdgcn_sdot4((int)((x3 >> 4) & 0x0F0F0F0Fu), (int)hv[p][1].w, s_, false); } \
        _Pragma("unroll") for (int o_ = 1; o_ < 64; o_ <<= 1) s_ += __shfl_xor(s_, o_); \
        const int k_ = (kbase) + r; const float av_ = (float)s_; if (k_ < 64) { if (lane == k_) a0 = av_; } else { if (lane == k_ - 64) a1 = av_; } } } while (0)
#define P10_LOADV(buf, kbase) do { _Pragma("unroll") for (int r = 0; r < 4; ++r) { const int k_ = (kbase) + r; const int e_ = __builtin_amdgcn_readlane(k_ < 64 ? ev0 : ev1, k_ & 63); \
        const u32x4* rp_ = (const u32x4*)(vb + (size_t)e_ * 2048); buf[r][0] = rp_[lane]; buf[r][1] = rp_[64 + lane]; } } while (0)
#define P10_COMPV(buf, grp) do { const int wq_ = __builtin_amdgcn_readlane(wqv, (grp)); \
        _Pragma("unroll") for (int p = 0; p < 2; ++p) { const unsigned xr_[4][4] = {{buf[0][p].x, buf[0][p].y, buf[0][p].z, buf[0][p].w}, {buf[1][p].x, buf[1][p].y, buf[1][p].z, buf[1][p].w}, {buf[2][p].x, buf[2][p].y, buf[2][p].z, buf[2][p].w}, {buf[3][p].x, buf[3][p].y, buf[3][p].z, buf[3][p].w}}; \
            _Pragma("unroll") for (int d = 0; d < 4; ++d) { int* oo = o + 32 * p + 8 * d; \
                _Pragma("unroll") for (int h = 0; h < 2; ++h) { \
                    const unsigned b0 = (xr_[0][d] >> (4 * h)) & 0x0F0F0F0Fu, b1 = (xr_[1][d] >> (4 * h)) & 0x0F0F0F0Fu, b2 = (xr_[2][d] >> (4 * h)) & 0x0F0F0F0Fu, b3 = (xr_[3][d] >> (4 * h)) & 0x0F0F0F0Fu; \
                    const unsigned a01 = __builtin_amdgcn_perm(b1, b0, 0x05010400u), c01 = __builtin_amdgcn_perm(b1, b0, 0x07030602u), a23 = __builtin_amdgcn_perm(b3, b2, 0x05010400u), c23 = __builtin_amdgcn_perm(b3, b2, 0x07030602u); \
                    const unsigned t0 = __builtin_amdgcn_perm(a23, a01, 0x05040100u), t1 = __builtin_amdgcn_perm(a23, a01, 0x07060302u), t2 = __builtin_amdgcn_perm(c23, c01, 0x05040100u), t3 = __builtin_amdgcn_perm(c23, c01, 0x07060302u); \
                    oo[0 + h] = __builtin_amdgcn_sdot4((int)t0, wq_, oo[0 + h], false); oo[2 + h] = __builtin_amdgcn_sdot4((int)t1, wq_, oo[2 + h], false); \
                    oo[4 + h] = __builtin_amdgcn_sdot4((int)t2, wq_, oo[4 + h], false); oo[6 + h] = __builtin_amdgcn_sdot4((int)t3, wq_, oo[6 + h], false); } } } } while (0)
__device__ __forceinline__ void peer_token_wave(const Args& a, unsigned char* ws, int tok, int lane) {
    const int* eidx = (const int*)(ws + WS_EIDX) + (size_t)tok * 128; const float* gw = (const float*)(ws + WS_GW) + (size_t)tok * 128;
    const int ev0 = eidx[lane], ev1 = eidx[64 + lane];
    u32x4 hv[2][2];
    const u32x4* hrow = (const u32x4*)(ws + WS_H8 + (size_t)tok * D);
#pragma unroll
    for (int p = 0; p < 2; ++p) { hv[p][0] = hrow[128 * p + 2 * lane]; hv[p][1] = hrow[128 * p + 2 * lane + 1]; }
    const float sh = ((const float*)(ws + WS_SH))[tok], shs = ((const float*)(ws + WS_SHS))[tok];
    const unsigned char* ub = ws + WS_UB; const float* su = (const float*)(ws + WS_SU); const float* sv = (const float*)(ws + WS_SV);
    float a0 = 0.f, a1 = 0.f;
    {
        u32x4 ua[4][2], uc[4][2];
        P10_LOADU(ua, 0);
#pragma unroll 1
        for (int kb = 0; kb < 128; kb += 8) {
            P10_LOADU(uc, kb + 4);
            P10_COMPU(ua, kb);
            P10_LOADU(ua, (kb + 8) & 127);
            P10_COMPU(uc, kb + 4);
        }
    }
    float w0, w1;
    { const float x0 = (a0 - 8.0f * shs) * su[ev0] * sh, x1 = (a1 - 8.0f * shs) * su[ev1] * sh;
      w0 = gw[lane] * 0.5f * x0 * (1.0f + erff(x0 * 0.70710678118f)) * sv[ev0]; w1 = gw[64 + lane] * 0.5f * x1 * (1.0f + erff(x1 * 0.70710678118f)) * sv[ev1]; }
    const float wmax = fmaxf(wave_max(fmaxf(fabsf(w0), fabsf(w1))), 1e-30f), sw = wmax * (1.0f / 127.0f), winv = 127.0f / wmax;
    const int q0 = (int)rintf(w0 * winv), q1 = (int)rintf(w1 * winv);
    int qsum = q0 + q1;
#pragma unroll
    for (int o_ = 1; o_ < 64; o_ <<= 1) qsum += __shfl_xor(qsum, o_);
    int wqv;
    { const int base = (lane & 15) * 4;
      const int s0 = __shfl(lane < 16 ? q0 : q1, base + 0), s1 = __shfl(lane < 16 ? q0 : q1, base + 1), s2 = __shfl(lane < 16 ? q0 : q1, base + 2), s3 = __shfl(lane < 16 ? q0 : q1, base + 3);
      const int a0_ = __shfl(q0, base + 0), a1_ = __shfl(q0, base + 1), a2_ = __shfl(q0, base + 2), a3_ = __shfl(q0, base + 3);
      const int b0_ = __shfl(q1, base + 0), b1_ = __shfl(q1, base + 1), b2_ = __shfl(q1, base + 2), b3_ = __shfl(q1, base + 3);
      (void)s0; (void)s1; (void)s2; (void)s3;
      const bool lowhalf = (lane & 31) < 16;
      const int c0 = lowhalf ? a0_ : b0_, c1 = lowhalf ? a1_ : b1_, c2 = lowhalf ? a2_ : b2_, c3 = lowhalf ? a3_ : b3_;
      wqv = (c0 & 255) | ((c1 & 255) << 8) | ((c2 & 255) << 16) | ((c3 & 255) << 24); }
    int o[64];
#pragma unroll
    for (int j = 0; j < 64; ++j) o[j] = 0;
    const unsigned char* vb = ws + WS_VB;
    {
        u32x4 va[4][2], vc[4][2];
        P10_LOADV(va, 0);
#pragma unroll 1
        for (int kb = 0; kb < 128; kb += 8) {
            P10_LOADV(vc, kb + 4);
            P10_COMPV(va, kb >> 2);
            P10_LOADV(va, (kb + 8) & 127);
            P10_COMPV(vc, (kb >> 2) + 1);
        }
    }
    float* orow = a.out + (size_t)tok * D; const bf16_t* xrow = (const bf16_t*)(ws + WS_X1B) + (size_t)tok * D; float s = 0.f; const int corr = 8 * qsum; float y[64];
#pragma unroll
    for (int p = 0; p < 2; ++p)
#pragma unroll
        for (int q = 0; q < 8; ++q) { const u32x2 xu = *(const u32x2*)(xrow + 2048 * p + 256 * q + 4 * lane); const f32x4 x = (f32x4){bflo(xu.x), bfhi(xu.x), bflo(xu.y), bfhi(xu.y)}; const int* oo = o + 32 * p + 4 * q; float* yy = y + 32 * p + 4 * q;
            yy[0] = x.x + sw * (float)(oo[0] - corr); yy[1] = x.y + sw * (float)(oo[1] - corr); yy[2] = x.z + sw * (float)(oo[2] - corr); yy[3] = x.w + sw * (float)(oo[3] - corr);
            s += (yy[0] * yy[0] + yy[1] * yy[1]) + (yy[2] * yy[2] + yy[3] * yy[3]); }
    const float rstd = rsqrtf(wave_sum(s) * (1.f / D) + EPS);
#pragma unroll
    for (int p = 0; p < 2; ++p)
#pragma unroll
        for (int q = 0; q < 8; ++q) { const f32x4 g = *(const f32x4*)(a.in[20] + 2048 * p + 256 * q + 4 * lane); const float* yy = y + 32 * p + 4 * q;
            *(f32x4*)(orow + 2048 * p + 256 * q + 4 * lane) = (f32x4){yy[0] * rstd * g.x, yy[1] * rstd * g.y, yy[2] * rstd * g.z, yy[3] * rstd * g.w}; }
}

__global__ void __launch_bounds__(512, 2) mega_fwd(Args args) {
    extern __shared__ __attribute__((aligned(16))) unsigned char lds_raw[];
    Frame F;
    F.lds = (LAS unsigned char*)lds_raw;
    F.tid = threadIdx.x; F.lane = F.tid & 63; F.wave = __builtin_amdgcn_readfirstlane(F.tid >> 6);
    F.G = gridDim.x; F.bid = blockIdx.x; F.ws = args.ws;
    unsigned char* ws = args.ws;
    if (F.tid < 64) ((LAS unsigned*)(F.lds + LDS_MISC))[F.tid] = 0u;
    __syncthreads();
    XcdBarrier bar = xcd_barrier_post((unsigned*)(ws + WS_CTL) + 4096, (volatile LAS unsigned*)(F.lds + LDS_MISC + 32));

    F.refresh();
    p0_weights8(F, args);
    F.refresh();
    p0_prologue_a(F, args);
    xcd_barrier(bar);
    {
        P1Sched S{(const char*)(ws + WS_HN), (const char*)(ws + WS_W8), (const char*)(ws + WS_WAL), (const char*)(ws + WS_MEMN), (const char*)(ws + WS_WKV), F.G, F.bid};
        P1Epi E{ws, args.in[12]};
        gg::gemm_phase<0>(F.lds, D * 2, D * 2, 64, S, E);
        I8Sched S8{(const char*)(ws + WS_HN8), (const char*)(ws + WS_W8), F.G, F.bid};
        I8Epi E8{ws, args.in[12]};
        gg::gemm_phase<2, true>(F.lds, D, D, 32, S8, E8);
        xcd_barrier(bar);
    }
    F.refresh();
    for (int u = F.bid; u < 512; u += F.G) gla_prep_unit(F, args, u);
    {
        WkSched Sk{(const char*)(ws + WS_KVM), (const char*)(ws + WS_WQX), F.G, F.bid};
        WkEpi Ek{(bf16_t*)(ws + WS_WKT)};
        gg::gemm_phase<0>(F.lds, 8192, 4096, 8, Sk, Ek);
        VwSched Sv{(const char*)(ws + WS_WBR + 32 * MiB), (const char*)(ws + WS_KVM), F.G, F.bid};
        VwEpi Ev{(bf16_t*)(ws + WS_VWT)};
        gg::gemm_phase<0>(F.lds, 4096, 8192, 8, Sv, Ev);
    }
    xcd_barrier(bar);
    F.refresh();
    {
        {
            XsSched S{(const char*)(ws + WS_HN), (const char*)(ws + WS_WKT), F.G, F.bid};
            XsEpi E{(bf16_t*)(ws + WS_PROB), F.lds + LDS_EX};
            gg::gemm_phase<0>(F.lds, D * 2, D * 2, 64, S, E);
        }
        const int nscan = F.G >= 128 ? 64 : 0;
        if (nscan) { if (F.bid < 64) gla_scan_unit(F, args, F.bid); }
        else for (int u = F.bid; u < 64; u += F.G) gla_scan_unit(F, args, u);
        { const int nq = nscan ? F.G - 64 : F.G, cq = nscan ? F.bid - 64 : F.bid;
          if (cq >= 0) for (int e = cq * 8 + F.wave; e < 16384; e += nq * 8) {
              quant_row_i4(args.in[18] + (size_t)e * D, ws + WS_UB + (size_t)e * 2048, (float*)(ws + WS_SU) + e, F.lane);
              quant_row_i4_v(args.in[19] + (size_t)e * D, ws + WS_VB + (size_t)e * 2048, (float*)(ws + WS_SV) + e, F.lane); }
          if (cq >= 0) conv_phase(F, args, cq, nq); }
    }
    xcd_barrier(bar);
    F.refresh();
    gla_post_phase(F, args);
    F.refresh();
    peer_wq_convert(F, args);
    xcd_barrier(bar);
    {
        MgSched S{(const char*)(ws + WS_RG), (const char*)(ws + WS_CB), (const char*)(ws + WS_PROB), (const char*)(ws + WS_WBR), (const char*)(ws + WS_VWT), F.G, F.bid};
        MgEpi E{(const bf16_t*)(ws + WS_GT), (bf16_t*)(ws + WS_MERGED)};
        gg::gemm_phase<0, true>(F.lds, 4096, 4096, 32, S, E);
    }
    xcd_barrier(bar);
    {
        GridSched S{(const char*)(ws + WS_MERGED), (const char*)(ws + WS_WO), 64, 16, D * 2, D * 2, F.G, F.bid};
        ResEpi E{args.in[0], (bf16_t*)(ws + WS_X1B)};
        gg::gemm_phase<0, true>(F.lds, D * 2, D * 2, 64, S, E);
    }
    xcd_barrier(bar);
    F.refresh();
    {
        const int gw = F.bid * 8 + F.wave, NGW = F.G * 8;
        for (int m = gw; m < T; m += NGW) rms_row_i8((const bf16_t*)(ws + WS_X1B) + (size_t)m * D, args.in[15], ws + WS_H8 + (size_t)m * D, (float*)(ws + WS_SH) + m, (float*)(ws + WS_SHS) + m, F.lane);
    }
    xcd_barrier(bar);
    {
        GridSched S{(const char*)(ws + WS_H8), (const char*)(ws + WS_WPQ), 64, 8, D, D, F.G, F.bid};
        PqEpi E{(bf16_t*)(ws + WS_PQ), (const float*)(ws + WS_SH), (const float*)(ws + WS_SWPQ)};
        gg::gemm_phase<2, true>(F.lds, D, D, 32, S, E);
    }
    xcd_barrier(bar);
    F.refresh();
    for (int u = F.bid; u < 256; u += F.G) route_job(F, args, u);
    xcd_barrier(bar);
    F.refresh();
    for (int tok = F.bid * 8 + F.wave; tok < T; tok += F.G * 8) peer_token_wave(args, ws, tok, F.lane);
}


extern "C" void kernel_launch(void* const* d_in, const int* in_sizes, int n_in, void* d_out, int out_size, void* d_ws, size_t ws_size, hipStream_t stream) {
    static int grid = 0;
    if (grid == 0) {
        if (n_in != 21 || ws_size < WS_END) { fprintf(stderr, "kernel_launch: unexpected inputs (n_in %d, ws %zu < %zu)\n", n_in, ws_size, (size_t)WS_END); grid = -1; return; }
        int dev = 0, cus = 0, per_cu = 0;
        if (hipGetDevice(&dev) != hipSuccess || hipDeviceGetAttribute(&cus, hipDeviceAttributeMultiprocessorCount, dev) != hipSuccess) { grid = -1; return; }
        if (hipFuncSetAttribute((const void*)mega_fwd, hipFuncAttributeMaxDynamicSharedMemorySize, LDS_BYTES) != hipSuccess) { fprintf(stderr, "kernel_launch: hipFuncSetAttribute failed\n"); grid = -1; return; }
        if (hipOccupancyMaxActiveBlocksPerMultiprocessor(&per_cu, (const void*)mega_fwd, 512, LDS_BYTES) != hipSuccess || per_cu < 1)
            fprintf(stderr, "kernel_launch: occupancy query says %d\n", per_cu);
        (void)hipGetLastError();
        grid = cus;
    }
    if (grid < 0) return;
    Args a{};
    for (int i = 0; i < 21; ++i) a.in[i] = (const float*)d_in[i];
    a.out = (float*)d_out; a.ws = (unsigned char*)d_ws;
    hipMemsetAsync((char*)d_ws + WS_CTL, 0, CTL_BYTES, stream);
    hipLaunchKernelGGL(mega_fwd, dim3(grid), dim3(512), LDS_BYTES, stream, a);
}
```

```cpp
#include <hip/hip_runtime.h>
#include <cstdio>
#include <cstdint>

#define LAS __attribute__((address_space(3)))
typedef unsigned short bf16_t;
typedef short bf16x8 __attribute__((ext_vector_type(8)));
typedef float f32x4 __attribute__((ext_vector_type(4)));
typedef float f32x2 __attribute__((ext_vector_type(2)));
typedef unsigned u32x4 __attribute__((ext_vector_type(4)));
typedef unsigned u32x2 __attribute__((ext_vector_type(2)));
typedef __bf16 bf16x2v __attribute__((ext_vector_type(2)));
typedef int i32x8 __attribute__((ext_vector_type(8)));
typedef int i32x4 __attribute__((ext_vector_type(4)));
typedef unsigned u32x8 __attribute__((ext_vector_type(8)));

constexpr int T = 16384, D = 4096, SEQ = 4096, NBATCH = 4, MEMT = 1024;
constexpr int NPAD = 26880;
constexpr int O_QG = 0, O_KG = 1024, O_VG = 2048, O_RG = 4096, O_CB = 6144, O_CC = 8192, O_CH = 10240, O_QX = 12288, O_GT = 14336, O_AL = 26624;
constexpr float EPS = 1e-6f;
constexpr int GLA_BLK = 74752;

#ifndef I8_MASK
#define I8_MASK 0x7f
#endif
constexpr int SEG_START[9] = {0, 2048, 4096, 6144, 8192, 10240, 12288, 14336, 26624};
constexpr int SEG_BIT[8] = {0, 1, 2, 3, 4, 5, -1, 6};
constexpr bool seg_i8(int s) { return SEG_BIT[s] >= 0 && ((I8_MASK >> SEG_BIT[s]) & 1); }
constexpr size_t seg_pitch(int s) { return SEG_BIT[s] < 0 ? 0 : (seg_i8(s) ? 4096 : 8192); }
constexpr size_t seg_off(int s) { size_t o = 0; for (int t = 0; t < s; ++t) o += (size_t)(SEG_START[t + 1] - SEG_START[t]) * seg_pitch(t); return o; }
constexpr bool V_I8 = seg_i8(1);
constexpr int count_tiles(bool want8) { int n = 0; for (int s = 0; s < 8; ++s) if (s != 1 && SEG_BIT[s] >= 0 && seg_i8(s) == want8) n += (SEG_START[s + 1] - SEG_START[s]) / 256; return n; }
constexpr int NT8 = count_tiles(true), NTB = count_tiles(false);
constexpr int NU_B = 64 * NTB + 64 + (V_I8 ? 0 : 512) + 64, NU_8 = 64 * NT8 + (V_I8 ? 512 : 0);
__device__ __forceinline__ size_t w_row_off(int n) {
    size_t o = 0;
#pragma unroll
    for (int s = 0; s < 8; ++s) if (n >= SEG_START[s] && n < SEG_START[s + 1]) o = seg_off(s) + (size_t)(n - SEG_START[s]) * seg_pitch(s);
    return o;
}
__device__ __forceinline__ bool w_row_is8(int n) {
    bool r = false;
#pragma unroll
    for (int s = 0; s < 8; ++s) if (n >= SEG_START[s] && n < SEG_START[s + 1]) r = seg_i8(s);
    return r;
}
__device__ __forceinline__ int map_tile(int idx, bool want8) {
    int t = 104;
#pragma unroll
    for (int s = 7; s >= 0; --s) { }
    int rem = idx; bool found = false;
#pragma unroll
    for (int s = 0; s < 8; ++s) { if (s == 1 || SEG_BIT[s] < 0 || seg_i8(s) != want8) continue; const int len = (SEG_START[s + 1] - SEG_START[s]) / 256;
        if (!found && rem < len) { t = SEG_START[s] / 256 + rem; found = true; } rem -= len; }
    return t;
}
constexpr size_t MiB = 1u << 20;
constexpr size_t WS_CTL = 0, CTL_BYTES = 1 * MiB;
constexpr size_t WS_MEMN = 1 * MiB, WS_KVM = 9 * MiB  , WS_ALR = 17 * MiB, WS_SUBK = 18 * MiB, WS_EIDX = 19 * MiB, WS_GW = 27 * MiB;
constexpr size_t WS_WBR = 64 * MiB  , WS_WO = 112 * MiB, WS_WPQ = 144 * MiB, WS_WKV = 160 * MiB;
constexpr size_t WS_UB = 192 * MiB, WS_VB = 224 * MiB;
constexpr size_t WS_HN8 = 320 * MiB;
constexpr size_t WS_W8 = 448 * MiB;
constexpr size_t WS_WAL = 56 * MiB;
constexpr size_t WS_SHN = 35 * MiB + 512 * 1024, WS_SW = 35 * MiB + 768 * 1024;
constexpr size_t WS_SWPQ = 35 * MiB + 896 * 1024;
constexpr size_t CTL_CMAXPQ = 384 * 1024;
constexpr size_t CTL_CMAX = 256 * 1024;
constexpr size_t WS_SU = 35 * MiB, WS_SV = WS_SU + 65536, WS_SH = WS_SV + 65536, WS_SHS = WS_SH + 65536;
constexpr size_t WS_H8 = 914 * MiB;
constexpr size_t WS_WTIN = 448 * MiB;
constexpr size_t WS_GLAB = 448 * MiB, WS_PROB = 521 * MiB  , WS_OG = 585 * MiB;
constexpr size_t WS_WQX = 40 * MiB;
constexpr size_t WS_WKT = 384 * MiB;
constexpr size_t WS_VWT = 320 * MiB;
constexpr size_t WS_HN = 658 * MiB;
constexpr size_t WS_MERGED = 658 * MiB;
constexpr size_t WS_X1B = 1042 * MiB;
constexpr size_t WS_QG = 786 * MiB, WS_KG = 818 * MiB, WS_VT = 850 * MiB, WS_RG = 914 * MiB, WS_CB = 978 * MiB, WS_CC = 1042 * MiB, WS_CH = 1106 * MiB, WS_QX = 1170 * MiB;
constexpr size_t WS_GT = 1234 * MiB;
constexpr size_t WS_HQ = 1234 * MiB, WS_PQ = 1362 * MiB;
constexpr size_t WS_END = 1618 * MiB;
static_assert(WS_GLAB + (size_t)16 * 64 * GLA_BLK <= WS_PROB, "gla blocks");

constexpr int LDS_BYTES = 163840;
constexpr int LDS_EX = 131072;
constexpr int LDS_MISC = LDS_BYTES - 256;

__device__ __forceinline__ float bf2f(unsigned b) { return __uint_as_float(b << 16); }
__device__ __forceinline__ float bflo(unsigned w) { return __uint_as_float(w << 16); }
__device__ __forceinline__ float bfhi(unsigned w) { return __uint_as_float(w & 0xffff0000u); }
__device__ __forceinline__ unsigned f2bf(float f) { unsigned u = __float_as_uint(f); return (u + 0x7fffu + ((u >> 16) & 1u)) >> 16; }
__device__ __forceinline__ unsigned pk2(float lo, float hi) { const f32x2 v = {lo, hi}; const bf16x2v b = __builtin_convertvector(v, bf16x2v); return __builtin_bit_cast(unsigned, b); }
__device__ __forceinline__ float dot2bf(unsigned a, unsigned b, float c) { return __builtin_amdgcn_fdot2_f32_bf16(__builtin_bit_cast(bf16x2v, a), __builtin_bit_cast(bf16x2v, b), c, false); }
__device__ __forceinline__ float wave_sum(float v) {
#pragma unroll
    for (int o = 1; o < 64; o <<= 1) v += __shfl_xor(v, o);
    return v;
}
__device__ __forceinline__ float wave_max(float v) {
#pragma unroll
    for (int o = 1; o < 64; o <<= 1) v = fmaxf(v, __shfl_xor(v, o));
    return v;
}
__device__ __forceinline__ float fast_sigmoid(float x) { return __builtin_amdgcn_rcpf(1.0f + __expf(-x)); }
__device__ __forceinline__ float inv_sigmoid(float x) { return 1.0f + __expf(fminf(-x, 69.0f)); }
#define LDS_WAIT() asm volatile("s_waitcnt lgkmcnt(0)" ::: "memory")
#define VM_WAIT() asm volatile("s_waitcnt vmcnt(0)" ::: "memory")

#define XB_TMO      128
#define XB_XCNT(j)  (256  + 64 * (j))
#define XB_XSUB(j)  (1280 + 64 * (j))
#define XB_XGEN(j)  (2304 + 64 * (j))
#define XB_TOP      3328
#define XB_TOPGEN   3392
#define XCD_BAR_WORDS 3456
#define XB_SPIN_CAP (1u << 24)
__device__ __forceinline__ unsigned xb_ld(unsigned* p)              { return __hip_atomic_load(p, __ATOMIC_RELAXED, __HIP_MEMORY_SCOPE_AGENT); }
__device__ __forceinline__ unsigned xb_add(unsigned* p, unsigned v) { return __hip_atomic_fetch_add(p, v, __ATOMIC_RELAXED, __HIP_MEMORY_SCOPE_AGENT); }
__device__ __forceinline__ unsigned xb_xcc_id() { return (unsigned)__builtin_amdgcn_s_getreg((3 << 11) | 20) & 0xFu; }
#define XB_SPIN(cond, bar) do { unsigned _sp = 0; while (cond) { __builtin_amdgcn_s_sleep(1); \
    if ((++_sp & 255u) == 0u) { if (xb_ld(&(bar)[XB_TMO])) break; if (_sp > XB_SPIN_CAP) { atomicAdd(&(bar)[XB_TMO], 1u); break; } } } } while (0)
struct XcdBarrier { unsigned* bar; unsigned x; volatile LAS unsigned* st; };
__device__ __forceinline__ XcdBarrier xcd_barrier_post(unsigned* bar, volatile LAS unsigned* st) {
    XcdBarrier b; b.bar = bar; b.x = xb_xcc_id(); b.st = st;
    if (threadIdx.x == 0) (void)xb_add(&bar[XB_XCNT(b.x)], 1u);
    return b;
}
__device__ __forceinline__ void xcd_barrier_complete(unsigned* bar, unsigned x, unsigned& nloc, unsigned& nx) {
    const unsigned G = gridDim.x * gridDim.y * gridDim.z;
    unsigned sum, cnt, mine, sp = 0u;
    for (;;) {
        sum = 0u; cnt = 0u; mine = 0u;
#pragma unroll
        for (unsigned j = 0; j < 16; ++j) { const unsigned c = xb_ld(&bar[XB_XCNT(j)]); sum += c; cnt += (c > 0u) ? 1u : 0u; mine = (j == x) ? c : mine; }
        if (sum == G) break;
        __builtin_amdgcn_s_sleep(1);
        if ((++sp & 255u) == 0u) { if (xb_ld(&bar[XB_TMO])) break; if (sp > XB_SPIN_CAP) { atomicAdd(&bar[XB_TMO], 1u); break; } }
    }
    nloc = mine > 0u ? mine : 1u; nx = cnt > 0u ? cnt : 1u;
}
__device__ __forceinline__ void xcd_barrier(const XcdBarrier& b) {
    asm volatile("s_waitcnt vmcnt(0)" ::: "memory");
    __syncthreads();
    if (threadIdx.x == 0) {
        unsigned* bar = b.bar;
        __builtin_amdgcn_s_waitcnt(0);
        unsigned nloc = b.st[0], nx = b.st[1];
        if (nloc == 0u) { xcd_barrier_complete(bar, b.x, nloc, nx); b.st[0] = nloc; b.st[1] = nx; }
        const unsigned old = xb_add(&bar[XB_XSUB(b.x)], 1u);
        const unsigned gen = old / nloc;
        if (old + 1u == (gen + 1u) * nloc) {
            __builtin_amdgcn_fence(__ATOMIC_RELEASE, "agent");
            asm volatile("s_waitcnt vmcnt(0)" ::: "memory");
            const unsigned og = xb_add(&bar[XB_TOP], 1u);
            const unsigned tg = og / nx;
            if (og + 1u == (tg + 1u) * nx) xb_add(&bar[XB_TOPGEN], 1u);
            else XB_SPIN(xb_ld(&bar[XB_TOPGEN]) == tg, bar);
            __builtin_amdgcn_fence(__ATOMIC_ACQUIRE, "agent");
            xb_add(&bar[XB_XGEN(b.x)], 1u);
            asm volatile("s_waitcnt vmcnt(0)" ::: "memory");
        } else {
            XB_SPIN(xb_ld(&bar[XB_XGEN(b.x)]) == gen, bar);
            __builtin_amdgcn_fence(__ATOMIC_ACQUIRE, "agent");
            asm volatile("s_waitcnt vmcnt(0)" ::: "memory");
        }
    }
    __syncthreads();
}

namespace gg {
constexpr int BM = 256, BK = 64, HALF = 128, HTB = HALF * BK * 2, STAGE_BYTES = 8 * HTB;
__device__ __forceinline__ int lds_byte(int r, int c) { const int st = (r >> 4) * 2 + (c >> 5), rr = r & 15, cc = c & 31, ob = rr * 64 + cc * 2; return st * 1024 + (ob ^ (((ob >> 9) & 1) << 5)); }
__device__ __forceinline__ void stage_rc(int b, int& R, int& C) { const int st = b / 1024, sb = b % 1024, swz = sb ^ (((sb >> 9) & 1) << 5); R = (st >> 1) * 16 + swz / 64; C = (st & 1) * 32 + (swz % 64) / 2; }
__device__ __forceinline__ int perm32(int rho) { const int n = rho >> 4, i = rho & 15; return 8 * (i >> 2) + 4 * n + (i & 3); }
struct Unit { const char* A; const char* B; int kind, pm, pn, aux; };
typedef f32x4 Acc[2][2][4][2];

template <int MODE, bool RX = false, class Epi, class Sched>
__device__ __forceinline__ void gemm_phase(LAS unsigned char* lds, const int ldaB, const int ldbB, const int nt, const Sched& S, const Epi& E) {
    int tid = threadIdx.x; asm volatile("" : "+v"(tid));
    const int wid = __builtin_amdgcn_readfirstlane(tid >> 6), lane = tid & 63, wr = wid >> 2, wc = wid & 3, fr = lane & 15, fq = lane >> 4;
    unsigned voffA[2], voffB[2];
#pragma unroll
    for (int i = 0; i < 2; ++i) { int R, C; stage_rc(tid * 16 + i * 8192, R, C); const int Rb = (R & ~31) + perm32(R & 31);
        voffA[i] = (unsigned)(R * ldaB + C * 2); voffB[i] = (unsigned)(Rb * ldbB + C * 2); }
    const size_t kstep = (size_t)(BK * 2);
    const size_t hstepA = (size_t)HALF * ldaB, hstepB = (size_t)HALF * ldbB;
    const unsigned ldsw = (unsigned)wid * 1024u;
    const int aoff = lds_byte(wr * 64 + fr, fq * 8), boff = lds_byte(wc * 32 + fr, fq * 8);
#define PG8_SA(b, h) (((b) * 2 + (h)) * HTB)
#define PG8_SB(b, h) ((4 + (b) * 2 + (h)) * HTB)
#define PG8_STAGE(bufoff, gbase, voff) do { _Pragma("unroll") for (int _i = 0; _i < 2; ++_i) \
        __builtin_amdgcn_global_load_lds((const unsigned*)((const char*)(gbase) + (voff)[_i]), (LAS unsigned*)(lds + (bufoff) + ldsw + _i * 8192), 16, 0, 0); } while (0)
#define PG8_LDA(dst, b, h) do { _Pragma("unroll") for (int m = 0; m < 4; ++m) { if constexpr (MODE == 1) { const u32x4 p0_ = *(const LAS u32x4*)(lds + PG8_SA(b, h) + aoff + m * 2048), p1_ = *(const LAS u32x4*)(lds + PG8_SA(b, h) + aoff + m * 2048 + 1024); \
        dst##8[m] = __builtin_shufflevector(p0_, p1_, 0, 1, 2, 3, 4, 5, 6, 7); } else { _Pragma("unroll") for (int k = 0; k < 2; ++k) dst[m][k] = *(const LAS bf16x8*)(lds + PG8_SA(b, h) + aoff + m * 2048 + k * 1024); } } } while (0)
#define PG8_LDB(dst, b, h) do { _Pragma("unroll") for (int n = 0; n < 2; ++n) { if constexpr (MODE == 1) { const u32x4 p0_ = *(const LAS u32x4*)(lds + PG8_SB(b, h) + boff + n * 2048), p1_ = *(const LAS u32x4*)(lds + PG8_SB(b, h) + boff + n * 2048 + 1024); \
        dst##8[n] = __builtin_shufflevector(p0_, p1_, 0, 1, 2, 3, 4, 5, 6, 7); } else { _Pragma("unroll") for (int k = 0; k < 2; ++k) dst[n][k] = *(const LAS bf16x8*)(lds + PG8_SB(b, h) + boff + n * 2048 + k * 1024); } } } while (0)
#define PG8_MMA(ai, bj, At, Bt) do { __builtin_amdgcn_s_setprio(1); _Pragma("unroll") for (int m = 0; m < 4; ++m) _Pragma("unroll") for (int n = 0; n < 2; ++n) { \
        if constexpr (MODE == 1) { asm volatile("v_mfma_scale_f32_16x16x128_f8f6f4 %0, %1, %2, %0, %3, %3 op_sel_hi:[0,0,0]" : "+v"(acc[ai][bj][m][n]) : "v"(Bt##8[n]), "v"(At##8[m]), "v"(sc127)); } \
        else if constexpr (MODE == 2) { _Pragma("unroll") for (int k = 0; k < 2; ++k) acc[ai][bj][m][n] = __builtin_bit_cast(f32x4, __builtin_amdgcn_mfma_i32_16x16x64_i8(__builtin_bit_cast(i32x4, Bt[n][k]), __builtin_bit_cast(i32x4, At[m][k]), __builtin_bit_cast(i32x4, acc[ai][bj][m][n]), 0, 0, 0)); } \
        else { _Pragma("unroll") for (int k = 0; k < 2; ++k) acc[ai][bj][m][n] = __builtin_amdgcn_mfma_f32_16x16x32_bf16(Bt[n][k], At[m][k], acc[ai][bj][m][n], 0, 0, 0); } } \
        __builtin_amdgcn_s_setprio(0); } while (0)
#define PG8_WAIT_V(n) asm volatile("s_waitcnt vmcnt(" #n ")" ::: "memory")
#define PG8_WAIT_V2(flag) asm volatile("s_cmp_lg_u32 %0, 0\n\ts_cbranch_scc1 1f\n\ts_waitcnt vmcnt(8)\n\ts_branch 2f\n1:\n\ts_waitcnt vmcnt(24)\n2:" :: "s"(flag) : "scc", "memory")
#define PG8_WAIT_L(n) asm volatile("s_waitcnt lgkmcnt(" #n ")" ::: "memory")
#define PG8_BAR __builtin_amdgcn_s_barrier()
#define PG8_SCHED __builtin_amdgcn_sched_barrier(0)
    Unit cur, nxt; int ui = 0;
    if (!S.next(0, cur)) return;
    Acc acc;
#pragma unroll
    for (int a = 0; a < 2; ++a)
#pragma unroll
        for (int b = 0; b < 2; ++b)
#pragma unroll
            for (int m = 0; m < 4; ++m)
#pragma unroll
                for (int n = 0; n < 2; ++n) acc[a][b][m][n] = (f32x4){0.f, 0.f, 0.f, 0.f};
    bf16x8 At[4][2], B0[2][2], B1[2][2]; u32x8 At8[4], B08[2], B18[2]; const int sc127 = 127;
    const char* cA = cur.A; const char* cB = cur.B;
    PG8_STAGE(PG8_SB(0, 0), cB, voffB); PG8_STAGE(PG8_SB(0, 1), cB + hstepB, voffB); PG8_STAGE(PG8_SA(0, 0), cA, voffA); PG8_STAGE(PG8_SA(0, 1), cA + hstepA, voffA);
    if (wr == 1) PG8_BAR;
    PG8_WAIT_V(2); PG8_BAR;
    PG8_STAGE(PG8_SB(1, 0), cB + kstep, voffB); PG8_STAGE(PG8_SA(1, 0), cA + kstep, voffA); PG8_STAGE(PG8_SB(1, 1), cB + hstepB + kstep, voffB);
    PG8_WAIT_V(6); PG8_BAR;
    bool relax = false;
    for (;;) {
        const bool has_next = S.next(ui + 1, nxt);
        const char* nA = has_next ? nxt.A : cA; const char* nB = has_next ? nxt.B : cB;
        const int unt = cur.aux ? cur.aux : nt;
#define PG8_PAIR(W0) { \
            const bool last = (t == unt - 2); const int rxf = __builtin_amdgcn_readfirstlane((relax && t == 0) ? 1 : 0); \
            const char* a1 = cA + (size_t)(t + 1) * kstep; \
            const char* a2 = last ? nA : cA + (size_t)(t + 2) * kstep; const char* b2 = last ? nB : cB + (size_t)(t + 2) * kstep; \
            const char* a3 = a2 + kstep; const char* b3 = b2 + kstep; \
              \
            PG8_LDB(B0, 0, 0); PG8_LDB(B1, 0, 1); PG8_SCHED; PG8_LDA(At, 0, 0); PG8_STAGE(PG8_SA(1, 1), a1 + hstepA, voffA); \
            if constexpr (RX) PG8_WAIT_V2(rxf); else PG8_WAIT_V(8); PG8_WAIT_L(0); PG8_BAR; PG8_MMA(0, 0, At, B0); PG8_MMA(0, 1, At, B1); PG8_BAR; PG8_SCHED; \
              \
            PG8_LDA(At, 0, 1); PG8_STAGE(PG8_SB(0, 0), b2, voffB); PG8_STAGE(PG8_SB(0, 1), b2 + hstepB, voffB); PG8_STAGE(PG8_SA(0, 0), a2, voffA); \
            if constexpr (RX) PG8_WAIT_V2(rxf); else PG8_WAIT_V(8); PG8_WAIT_L(0); PG8_BAR; PG8_MMA(1, 0, At, B0); PG8_MMA(1, 1, At, B1); PG8_BAR; PG8_SCHED; \
              \
            PG8_LDB(B0, 1, 0); PG8_LDB(B1, 1, 1); PG8_SCHED; PG8_LDA(At, 1, 0); PG8_STAGE(PG8_SA(0, 1), a2 + hstepA, voffA); \
            PG8_WAIT_V(8); PG8_WAIT_L(0); PG8_BAR; PG8_MMA(0, 0, At, B0); PG8_MMA(0, 1, At, B1); PG8_BAR; PG8_SCHED; \
              \
            PG8_LDA(At, 1, 1); PG8_STAGE(PG8_SB(1, 0), b3, voffB); PG8_STAGE(PG8_SB(1, 1), b3 + hstepB, voffB); PG8_STAGE(PG8_SA(1, 0), a3, voffA); \
            PG8_WAIT_V(8); PG8_WAIT_L(0); PG8_BAR; PG8_MMA(1, 0, At, B0); PG8_MMA(1, 1, At, B1); PG8_BAR; PG8_SCHED; }
        for (int t = 0; t < unt; t += 2) PG8_PAIR(8)
#undef PG8_PAIR
        if constexpr (MODE == 1) asm volatile("s_nop 15\n\ts_nop 15" ::: "memory");
        if (wr == 0) PG8_BAR;
        const bool reset = E(acc, cur, wr, wc, fr, fq, wid, lane);
        if constexpr (RX) relax = (E.nst(cur) >= 16);
        asm volatile("" ::: "memory");
        if (!has_next) break;
        if (reset) {
#pragma unroll
            for (int a = 0; a < 2; ++a)
#pragma unroll
                for (int b = 0; b < 2; ++b)
#pragma unroll
                    for (int m = 0; m < 4; ++m)
#pragma unroll
                        for (int n = 0; n < 2; ++n) acc[a][b][m][n] = (f32x4){0.f, 0.f, 0.f, 0.f};
        }
        cur = nxt; cA = nA; cB = nB; ++ui;
        if (wr == 1) PG8_BAR;
    }
    PG8_WAIT_V(0);
    PG8_BAR;
#undef PG8_SA
#undef PG8_SB
#undef PG8_STAGE
#undef PG8_LDA
#undef PG8_LDB
#undef PG8_MMA
#undef PG8_WAIT_V
#undef PG8_WAIT_L
#undef PG8_BAR
#undef PG8_SCHED
}

__device__ __forceinline__ bool tile_order(long L, int nM, int nN, int& pm, int& pn) {
    const int nwg = nM * nN; if (L >= nwg) return false;
    const int q = nwg / 8, xcd = (int)(L % 8), off = (int)(L / 8); const int wgid = xcd * q + off;
    const int nig = 8 * nN, gid = wgid / nig, fm = gid * 8;
    pm = fm + ((wgid % nig) % 8); pn = (wgid % nig) / 8; return true;
}
__device__ __forceinline__ void store_bf16_tile(const Acc& acc, bf16_t* base, int ldc, int row0, int col0, int wr, int wc, int fr, int fq) {
#pragma unroll
    for (int ai = 0; ai < 2; ++ai)
#pragma unroll
        for (int m = 0; m < 4; ++m) { bf16_t* rowp = base + (size_t)(row0 + ai * HALF + wr * 64 + m * 16 + fr) * ldc + col0 + wc * 32 + 8 * fq;
#pragma unroll
            for (int bj = 0; bj < 2; ++bj) { const f32x4 v0 = acc[ai][bj][m][0], v1 = acc[ai][bj][m][1];
                u32x4 w; w.x = pk2(v0[0], v0[1]); w.y = pk2(v0[2], v0[3]); w.z = pk2(v1[0], v1[1]); w.w = pk2(v1[2], v1[3]);
                *(u32x4*)(rowp + bj * HALF) = w; } }
}
}

struct Args { const float* in[21]; float* out; unsigned char* ws; };
struct Frame {
    LAS unsigned char* lds;
    int tid, lane, wave, G, bid;
    unsigned char* ws;
    __device__ __forceinline__ void refresh() { int t = threadIdx.x; asm volatile("" : "+v"(t)); tid = t; lane = t & 63; wave = __builtin_amdgcn_readfirstlane(t >> 6); }
};

__device__ __forceinline__ int src_col(int n) { return n < 6144 ? n : (n < O_AL ? n + 16 : (n < O_AL + 16 ? n - O_AL + 6144 : -1)); }
__device__ __forceinline__ void transpose_item(const float* W, int K, int N, int NT, bf16_t* WT, LAS float* scr, int item, int lane, bool remap, unsigned char* W8 = nullptr, bf16_t* WQ = nullptr, const unsigned* cmax = nullptr, float* sw = nullptr, bool i8perm = false) {
    const int nblk = NT / 32, kb = item / nblk, nb = item % nblk, k0 = 64 * kb, n0 = 32 * nb;
    const int q = lane & 7, r8 = lane >> 3;
    const int n = n0 + 4 * q; const int src = remap ? src_col(n) : n;
    f32x4 v[8];
#pragma unroll
    for (int i = 0; i < 8; ++i) v[i] = (src >= 0) ? *(const f32x4*)(W + (size_t)(k0 + 8 * i + r8) * N + src) : (f32x4){0.f, 0.f, 0.f, 0.f};
    if (remap && n0 >= O_QX && n0 < O_GT) {
#pragma unroll
        for (int i = 0; i < 8; ++i) *(u32x2*)(WQ + (size_t)(k0 + 8 * i + r8) * 2048 + (n0 - O_QX) + 4 * q) = (u32x2){pk2(v[i].x, v[i].y), pk2(v[i].z, v[i].w)};
        return;
    }
#pragma unroll
    for (int i = 0; i < 8; ++i) { LAS float* d = scr + (8 * i + r8) * 33 + 4 * q; d[0] = v[i].x; d[1] = v[i].y; d[2] = v[i].z; d[3] = v[i].w; }
    LDS_WAIT(); asm volatile("" ::: "memory");
    const int c = lane & 7;
    if (i8perm) {
#pragma unroll
        for (int j = 0; j < 4; ++j) { const int nn = (lane >> 3) + 8 * j; const LAS float* s = scr + (8 * c) * 33 + nn;
            const float mx = fmaxf(__uint_as_float(xb_ld((unsigned*)cmax + n0 + nn)), 1e-30f), inv = 127.0f / mx;
            int qv[8];
#pragma unroll
            for (int e = 0; e < 8; ++e) qv[e] = (int)rintf(s[e * 33] * inv) & 255;
            *(u32x2*)(W8 + (size_t)(n0 + nn) * K + k0 + 8 * c) = (u32x2){(unsigned)(qv[0] | (qv[2] << 8) | (qv[4] << 16) | (qv[6] << 24)), (unsigned)(qv[1] | (qv[3] << 8) | (qv[5] << 16) | (qv[7] << 24))};
            if (kb == 0 && c == 0) sw[n0 + nn] = mx * (1.0f / 127.0f); }
    } else if (remap && n0 < O_AL && w_row_is8(n0)) {
#pragma unroll
        for (int j = 0; j < 4; ++j) { const int nn = (lane >> 3) + 8 * j; const LAS float* s = scr + (8 * c) * 33 + nn;
            const float mx = fmaxf(__uint_as_float(xb_ld((unsigned*)cmax + src_col(n0 + nn))), 1e-30f), inv = 127.0f / mx;
            int qv[8];
#pragma unroll
            for (int e = 0; e < 8; ++e) qv[e] = (int)rintf(s[e * 33] * inv) & 255;
            *(u32x2*)(W8 + w_row_off(n0 + nn) + k0 + 8 * c) = (u32x2){(unsigned)(qv[0] | (qv[1] << 8) | (qv[2] << 16) | (qv[3] << 24)), (unsigned)(qv[4] | (qv[5] << 8) | (qv[6] << 16) | (qv[7] << 24))};
            if (kb == 0 && c == 0) sw[n0 + nn] = mx * (1.0f / 127.0f); }
    } else if (remap && n0 < O_AL) {
#pragma unroll
        for (int j = 0; j < 4; ++j) { const int nn = (lane >> 3) + 8 * j; const LAS float* s = scr + (8 * c) * 33 + nn;
            u32x4 o; o.x = pk2(s[0 * 33], s[1 * 33]); o.y = pk2(s[2 * 33], s[3 * 33]); o.z = pk2(s[4 * 33], s[5 * 33]); o.w = pk2(s[6 * 33], s[7 * 33]);
            *(u32x4*)(W8 + w_row_off(n0 + nn) + (size_t)(k0 + 8 * c) * 2) = o; }
    } else {
        const int rowoff = remap ? O_AL : 0;
#pragma unroll
        for (int j = 0; j < 4; ++j) { const int nn = (lane >> 3) + 8 * j; const LAS float* s = scr + (8 * c) * 33 + nn;
            u32x4 o; o.x = pk2(s[0 * 33], s[1 * 33]); o.y = pk2(s[2 * 33], s[3 * 33]); o.z = pk2(s[4 * 33], s[5 * 33]); o.w = pk2(s[6 * 33], s[7 * 33]);
            *(u32x4*)(WT + (size_t)(n0 - rowoff + nn) * K + k0 + 8 * c) = o; }
    }
    LDS_WAIT(); asm volatile("" ::: "memory");
}
__device__ __forceinline__ void rms_row_bf16(const float* xrow, const float* gain, bf16_t* orow, int lane) {
    const f32x4* xr = (const f32x4*)xrow + lane;
    f32x4 v[16]; float s = 0.f;
#pragma unroll
    for (int j = 0; j < 16; ++j) { v[j] = xr[64 * j]; s += (v[j].x * v[j].x + v[j].y * v[j].y) + (v[j].z * v[j].z + v[j].w * v[j].w); }
    const float rstd = rsqrtf(wave_sum(s) * (1.f / D) + EPS);
    u32x2* o8 = (u32x2*)orow + lane; const f32x4* gr = (const f32x4*)gain + lane;
#pragma unroll
    for (int j = 0; j < 16; ++j) { const f32x4 g = gr[64 * j]; u32x2 w; w.x = pk2(v[j].x * rstd * g.x, v[j].y * rstd * g.y); w.y = pk2(v[j].z * rstd * g.z, v[j].w * rstd * g.w); o8[64 * j] = w; }
}
__device__ __forceinline__ void rms_row_bf16_i8n(const float* xrow, const float* gain, bf16_t* orow, unsigned char* o8row, float* scale, int lane) {
    const f32x4* xr = (const f32x4*)xrow + lane;
    f32x4 v[16]; float s = 0.f;
#pragma unroll
    for (int j = 0; j < 16; ++j) { v[j] = xr[64 * j]; s += (v[j].x * v[j].x + v[j].y * v[j].y) + (v[j].z * v[j].z + v[j].w * v[j].w); }
    const float rstd = rsqrtf(wave_sum(s) * (1.f / D) + EPS);
    u32x2* o8 = (u32x2*)orow + lane; const f32x4* gr = (const f32x4*)gain + lane; float m = 0.f;
#pragma unroll
    for (int j = 0; j < 16; ++j) { const f32x4 g = gr[64 * j]; v[j].x *= rstd * g.x; v[j].y *= rstd * g.y; v[j].z *= rstd * g.z; v[j].w *= rstd * g.w;
        u32x2 w; w.x = pk2(v[j].x, v[j].y); w.y = pk2(v[j].z, v[j].w); o8[64 * j] = w;
        m = fmaxf(m, fmaxf(fmaxf(fabsf(v[j].x), fabsf(v[j].y)), fmaxf(fabsf(v[j].z), fabsf(v[j].w)))); }
    m = fmaxf(wave_max(m), 1e-30f); const float inv = 127.0f / m;
    if (lane == 0) *scale = m * (1.0f / 127.0f);
    unsigned* o4 = (unsigned*)o8row + lane;
#pragma unroll
    for (int j = 0; j < 16; ++j) { const int q0 = (int)rintf(v[j].x * inv), q1 = (int)rintf(v[j].y * inv), q2 = (int)rintf(v[j].z * inv), q3 = (int)rintf(v[j].w * inv);
        o4[64 * j] = (unsigned)(q0 & 255) | ((unsigned)(q1 & 255) << 8) | ((unsigned)(q2 & 255) << 16) | ((unsigned)(q3 & 255) << 24); }
}
__device__ __forceinline__ void rms_row_i8(const bf16_t* xrow, const float* gain, unsigned char* o8row, float* scale, float* hsum, int lane) {
    const u32x4* xr = (const u32x4*)xrow + lane;
    f32x4 v[16]; float s = 0.f;
#pragma unroll
    for (int j = 0; j < 8; ++j) { const u32x4 u = xr[64 * j]; v[2 * j] = (f32x4){bflo(u.x), bfhi(u.x), bflo(u.y), bfhi(u.y)}; v[2 * j + 1] = (f32x4){bflo(u.z), bfhi(u.z), bflo(u.w), bfhi(u.w)}; }
#pragma unroll
    for (int j = 0; j < 16; ++j) s += (v[j].x * v[j].x + v[j].y * v[j].y) + (v[j].z * v[j].z + v[j].w * v[j].w);
    const float rstd = rsqrtf(wave_sum(s) * (1.f / D) + EPS);
    const f32x4* gr = (const f32x4*)gain + 2 * lane; float m = 0.f;
#pragma unroll
    for (int j = 0; j < 8; ++j) {
#pragma unroll
        for (int q = 0; q < 2; ++q) { const f32x4 g = gr[128 * j + q]; f32x4& x = v[2 * j + q]; x.x *= rstd * g.x; x.y *= rstd * g.y; x.z *= rstd * g.z; x.w *= rstd * g.w;
            m = fmaxf(m, fmaxf(fmaxf(fabsf(x.x), fabsf(x.y)), fmaxf(fabsf(x.z), fabsf(x.w)))); }
        }
    m = fmaxf(wave_max(m), 1e-30f); const float inv = 127.0f / m;
    int isum = 0;
#pragma unroll
    for (int j = 0; j < 8; ++j) { const f32x4 a = v[2 * j], b = v[2 * j + 1];
        const int q0 = (int)rintf(a.x * inv), q1 = (int)rintf(a.y * inv), q2 = (int)rintf(a.z * inv), q3 = (int)rintf(a.w * inv), q4 = (int)rintf(b.x * inv), q5 = (int)rintf(b.y * inv), q6 = (int)rintf(b.z * inv), q7 = (int)rintf(b.w * inv);
        isum += (q0 + q1) + (q2 + q3) + (q4 + q5) + (q6 + q7);
        u32x2 w; w.x = (unsigned)(q0 & 255) | ((unsigned)(q2 & 255) << 8) | ((unsigned)(q4 & 255) << 16) | ((unsigned)(q6 & 255) << 24);
        w.y = (unsigned)(q1 & 255) | ((unsigned)(q3 & 255) << 8) | ((unsigned)(q5 & 255) << 16) | ((unsigned)(q7 & 255) << 24);
        ((u32x2*)o8row)[lane + 64 * j] = w; }
#pragma unroll
    for (int o = 1; o < 64; o <<= 1) isum += __shfl_xor(isum, o);
    if (lane == 0) { *scale = m * (1.0f / 127.0f); *hsum = (float)isum; }
}
__device__ __forceinline__ void cvt_table(const float* src, bf16_t* dst, size_t n8, size_t gt, size_t ngt) {
    for (size_t i = gt; i < n8; i += ngt) { const f32x4 a = ((const f32x4*)src)[2 * i], b = ((const f32x4*)src)[2 * i + 1];
        u32x4 w; w.x = pk2(a.x, a.y); w.y = pk2(a.z, a.w); w.z = pk2(b.x, b.y); w.w = pk2(b.z, b.w); ((u32x4*)dst)[i] = w; }
}
__device__ __forceinline__ void quant_row_i4_v(const float* xrow, unsigned char* orow, float* scale, int lane) {
    const f32x4* xr = (const f32x4*)xrow + lane;
    f32x4 v[2][4][2]; float s = 0.f;
#pragma unroll
    for (int p = 0; p < 2; ++p)
#pragma unroll
        for (int d = 0; d < 4; ++d)
#pragma unroll
            for (int h = 0; h < 2; ++h) v[p][d][h] = xr[512 * p + 128 * d + 64 * h];
#pragma unroll
    for (int p = 0; p < 2; ++p)
#pragma unroll
        for (int d = 0; d < 4; ++d)
#pragma unroll
            for (int h = 0; h < 2; ++h) { const f32x4 x = v[p][d][h]; s += (x.x * x.x + x.y * x.y) + (x.z * x.z + x.w * x.w); }
    const float sc = fmaxf(2.5f * sqrtf(wave_sum(s) * (1.f / D)) * (1.f / 7.f), 1e-30f), inv = 1.0f / sc;
    if (lane == 0) *scale = sc;
#pragma unroll
    for (int p = 0; p < 2; ++p) { unsigned wd[4];
#pragma unroll
        for (int d = 0; d < 4; ++d) { const f32x4 a = v[p][d][0], b = v[p][d][1]; const float e[8] = {a.x, a.y, a.z, a.w, b.x, b.y, b.z, b.w}; unsigned w = 0u;
#pragma unroll
            for (int i = 0; i < 8; ++i) { const int q = (int)fminf(fmaxf(rintf(e[i] * inv), -7.f), 7.f) + 8; w |= (unsigned)q << (4 * i); }
            wd[d] = w; }
        ((u32x4*)orow)[64 * p + lane] = (u32x4){wd[0], wd[1], wd[2], wd[3]}; }
}
__device__ __forceinline__ void quant_row_i4(const float* xrow, unsigned char* orow, float* scale, int lane) {
    const f32x4* xr = (const f32x4*)xrow + 2 * lane;
    f32x4 v[16]; float s = 0.f;
#pragma unroll
    for (int j = 0; j < 8; ++j) { v[2 * j] = xr[128 * j]; v[2 * j + 1] = xr[128 * j + 1]; }
#pragma unroll
    for (int j = 0; j < 16; ++j) s += (v[j].x * v[j].x + v[j].y * v[j].y) + (v[j].z * v[j].z + v[j].w * v[j].w);
    const float sc = fmaxf(2.5f * sqrtf(wave_sum(s) * (1.f / D)) * (1.f / 7.f), 1e-30f), inv = 1.0f / sc;
    if (lane == 0) *scale = sc;
    unsigned* o4 = (unsigned*)orow + lane;
#pragma unroll
    for (int j = 0; j < 8; ++j) { const f32x4 a = v[2 * j], b = v[2 * j + 1]; const float e[8] = {a.x, a.y, a.z, a.w, b.x, b.y, b.z, b.w}; unsigned w = 0u;
#pragma unroll
        for (int i = 0; i < 8; ++i) { const int q = (int)fminf(fmaxf(rintf(e[i] * inv), -7.f), 7.f) + 8; w |= (unsigned)q << (4 * i); }
        o4[64 * j] = w; }
}
__device__ __forceinline__ int nth_block(int j, bool want8) {
    int nb = -1;
#pragma unroll
    for (int s = 0; s < 9; ++s) { const int b0 = (s < 8 ? SEG_START[s] : O_AL) / 32, b1 = (s < 8 ? SEG_START[s + 1] : NPAD) / 32; const bool is8 = s < 8 && seg_i8(s);
        if (is8 == want8) { if (nb < 0 && j >= 0 && j < b1 - b0) nb = b0 + j; j -= (b1 - b0); } }
    return nb;
}
constexpr int count_blocks8() { int n = 0; for (int s = 0; s < 8; ++s) if (seg_i8(s)) n += (SEG_START[s + 1] - SEG_START[s]) / 32; return n; }
constexpr int NB8 = count_blocks8(), NBX = NPAD / 32 - NB8;
__device__ __forceinline__ void p0_prologue_a(Frame& F, const Args& a) {
    LAS float* scr = (LAS float*)(F.lds + F.wave * 16384);
    const int gw = F.bid * 8 + F.wave, NGW = F.G * 8;
    unsigned char* ws = F.ws;
    constexpr int I_BR = 32 * 128, I_O = 64 * 128, I_KV = 64 * 128;
    constexpr int I_X = 64 * NBX;
    constexpr int NITEMS = 3 * I_BR + I_O + I_KV + I_X;
    for (int it = gw; it < NITEMS; it += NGW) {
        int r = it;
        if (r < I_X) { const int nb = nth_block(r >> 6, false); transpose_item(a.in[3], D, 26640, NPAD, (bf16_t*)(ws + WS_WAL), scr, (r & 63) * (NPAD / 32) + nb, F.lane, true, ws + WS_W8, (bf16_t*)(ws + WS_WQX), (const unsigned*)(ws + WS_CTL + CTL_CMAX), (float*)(ws + WS_SW)); continue; } r -= I_X;
        if (r < I_BR) { transpose_item(a.in[8], 2048, D, D, (bf16_t*)(ws + WS_WBR), scr, r, F.lane, false); continue; } r -= I_BR;
        if (r < I_BR) { transpose_item(a.in[9], 2048, D, D, (bf16_t*)(ws + WS_WBR + 16 * MiB), scr, r, F.lane, false); continue; } r -= I_BR;
        if (r < I_BR) { transpose_item(a.in[11], 2048, D, D, (bf16_t*)(ws + WS_WBR + 32 * MiB), scr, r, F.lane, false); continue; } r -= I_BR;
        if (r < I_O) { transpose_item(a.in[13], D, D, D, (bf16_t*)(ws + WS_WO), scr, r, F.lane, false); continue; } r -= I_O;
        transpose_item(a.in[10], D, D, D, (bf16_t*)(ws + WS_WKV), scr, r, F.lane, false);
    }
    for (int m = gw; m < T; m += NGW) rms_row_bf16_i8n(a.in[0] + (size_t)m * D, a.in[2], (bf16_t*)(ws + WS_HN) + (size_t)m * D, ws + WS_HN8 + (size_t)m * D, (float*)(ws + WS_SHN) + m, F.lane);
    for (int m = gw; m < MEMT; m += NGW) rms_row_bf16(a.in[1] + (size_t)m * D, a.in[14], (bf16_t*)(ws + WS_MEMN) + (size_t)m * D, F.lane);
    const size_t gt = (size_t)F.bid * 512 + F.tid, ngt = (size_t)F.G * 512;
    cvt_table(a.in[17], (bf16_t*)(ws + WS_SUBK), (size_t)8 * 2 * 128 * 128 / 8, gt, ngt);
    { unsigned* cmq = (unsigned*)(ws + WS_CTL + CTL_CMAXPQ);
      for (int u = F.bid; u < 256; u += F.G) { const float* wp = a.in[16] + (size_t)(16 * u) * 2048 + 4 * F.tid; f32x4 m = (f32x4){0.f, 0.f, 0.f, 0.f};
#pragma unroll
          for (int r = 0; r < 16; ++r) { const f32x4 v = *(const f32x4*)(wp + (size_t)r * 2048); m.x = fmaxf(m.x, fabsf(v.x)); m.y = fmaxf(m.y, fabsf(v.y)); m.z = fmaxf(m.z, fabsf(v.z)); m.w = fmaxf(m.w, fabsf(v.w)); }
          atomicMax(cmq + 4 * F.tid + 0, __float_as_uint(m.x)); atomicMax(cmq + 4 * F.tid + 1, __float_as_uint(m.y)); atomicMax(cmq + 4 * F.tid + 2, __float_as_uint(m.z)); atomicMax(cmq + 4 * F.tid + 3, __float_as_uint(m.w)); } }
}
__device__ __forceinline__ void p0_weights8(Frame& F, const Args& a) {
    LAS float* scr = (LAS float*)(F.lds + F.wave * 16384); LAS float* smax = (LAS float*)(F.lds + 131072); LAS float* bmax = smax + 256;
    unsigned char* ws = F.ws; const int lane = F.lane, q = lane & 7, r8 = lane >> 3, c = lane & 7;
    const float* W = a.in[3]; float* sw = (float*)(ws + WS_SW);
    for (int b = F.bid; b < NB8; b += F.G) {
        const int nb = nth_block(b, true), n0 = 32 * nb, src = src_col(n0 + 4 * q);
        const float* wp = W + (size_t)(512 * F.wave + r8) * 26640 + src;
        f32x4 mx = (f32x4){0.f, 0.f, 0.f, 0.f};
#pragma unroll 1
        for (int h = 0; h < 2; ++h) { f32x4 v[32];
#pragma unroll
            for (int i = 0; i < 32; ++i) v[i] = *(const f32x4*)(wp + (size_t)(256 * h + 8 * i) * 26640);
#pragma unroll
            for (int i = 0; i < 32; ++i) { mx.x = fmaxf(mx.x, fabsf(v[i].x)); mx.y = fmaxf(mx.y, fabsf(v[i].y)); mx.z = fmaxf(mx.z, fabsf(v[i].z)); mx.w = fmaxf(mx.w, fabsf(v[i].w)); } }
#pragma unroll
        for (int o_ = 8; o_ < 64; o_ <<= 1) { mx.x = fmaxf(mx.x, __shfl_xor(mx.x, o_)); mx.y = fmaxf(mx.y, __shfl_xor(mx.y, o_)); mx.z = fmaxf(mx.z, __shfl_xor(mx.z, o_)); mx.w = fmaxf(mx.w, __shfl_xor(mx.w, o_)); }
        if (lane < 8) { LAS float* d = smax + F.wave * 32 + 4 * q; d[0] = mx.x; d[1] = mx.y; d[2] = mx.z; d[3] = mx.w; }
        __syncthreads();
        if (F.tid < 32) { float m = 0.f;
#pragma unroll
            for (int w = 0; w < 8; ++w) m = fmaxf(m, smax[w * 32 + F.tid]);
            m = fmaxf(m, 1e-30f); bmax[F.tid] = m; sw[n0 + F.tid] = m * (1.0f / 127.0f); }
        __syncthreads();
        float inv[4]; size_t roff[4];
#pragma unroll
        for (int j = 0; j < 4; ++j) { const int nn = r8 + 8 * j; inv[j] = 127.0f / bmax[nn]; roff[j] = w_row_off(n0 + nn); }
        f32x4 v[8], vn[8];
#pragma unroll
        for (int i = 0; i < 8; ++i) v[i] = *(const f32x4*)(wp + (size_t)(8 * i) * 26640);
#pragma unroll 1
        for (int ck = 0; ck < 8; ++ck) {
            if (ck < 7) {
#pragma unroll
                for (int i = 0; i < 8; ++i) vn[i] = *(const f32x4*)(wp + (size_t)(64 * (ck + 1) + 8 * i) * 26640); }
#pragma unroll
            for (int i = 0; i < 8; ++i) { LAS float* d = scr + (8 * i + r8) * 33 + 4 * q; d[0] = v[i].x; d[1] = v[i].y; d[2] = v[i].z; d[3] = v[i].w; }
            LDS_WAIT(); asm volatile("" ::: "memory");
            const int k0 = 512 * F.wave + 64 * ck;
#pragma unroll
            for (int j = 0; j < 4; ++j) { const int nn = r8 + 8 * j; const LAS float* s_ = scr + (8 * c) * 33 + nn; int qv[8];
#pragma unroll
                for (int e_ = 0; e_ < 8; ++e_) qv[e_] = (int)rintf(s_[e_ * 33] * inv[j]) & 255;
                *(u32x2*)(ws + WS_W8 + roff[j] + k0 + 8 * c) = (u32x2){(unsigned)(qv[0] | (qv[1] << 8) | (qv[2] << 16) | (qv[3] << 24)), (unsigned)(qv[4] | (qv[5] << 8) | (qv[6] << 16) | (qv[7] << 24))}; }
            LDS_WAIT(); asm volatile("" ::: "memory");
#pragma unroll
            for (int i = 0; i < 8; ++i) v[i] = vn[i];
        }
        __syncthreads();
    }
}
__device__ __forceinline__ void peer_wq_convert(Frame& F, const Args& a) {
    LAS float* scr = (LAS float*)(F.lds + F.wave * 16384);
    const int gw = F.bid * 8 + F.wave, NGW = F.G * 8; unsigned char* ws = F.ws;
    for (int it = gw; it < 64 * 64; it += NGW)
        transpose_item(a.in[16], D, 2048, 2048, nullptr, scr, it, F.lane, false, ws + WS_WPQ, nullptr, (const unsigned*)(ws + WS_CTL + CTL_CMAXPQ), (float*)(ws + WS_SWPQ), true);
}

struct P1Sched {
    const char *hn, *wreg, *wal, *memn, *wkv; int G, c;
    __device__ __forceinline__ bool next(int i, gg::Unit& u) const {
        long L = (long)i * G + c; u.aux = 0;
        if (L < 64 * NTB) { int pm, pn; gg::tile_order(L, 64, NTB > 0 ? NTB : 1, pm, pn); pn = map_tile(pn, false);
            u.kind = 0; u.pm = pm; u.pn = pn; u.A = hn + (size_t)pm * 256 * D * 2; u.B = wreg + w_row_off(256 * pn); return true; }
        L -= 64 * NTB;
        if (L < 64) { u.kind = 0; u.pm = (int)L; u.pn = 104; u.A = hn + (size_t)L * 256 * D * 2; u.B = wal; return true; }
        L -= 64;
        if (!V_I8) { if (L < 512) { u.kind = 1; u.pm = (int)(L % 8); u.pn = (int)(L / 8); u.A = wreg + w_row_off(O_VG + 256 * u.pm); u.B = hn + (size_t)u.pn * 256 * D * 2; return true; } L -= 512; }
        if (L < 64) { u.kind = 2; u.pm = (int)(L % 4); u.pn = (int)(L / 4); u.A = memn + (size_t)u.pm * 256 * D * 2; u.B = wkv + (size_t)u.pn * 256 * D * 2; return true; }
        return false;
    }
};
struct I8Sched {
    const char *hn8, *wreg; int G, c;
    __device__ __forceinline__ bool next(int i, gg::Unit& u) const {
        const int rb = NU_B % G, ext = (rb > 0 && NU_8 >= 2 * (G - rb)) ? 2 * (G - rb) : 0, x = (NU_8 - ext) / G, rem = (NU_8 - ext) % G;
        const int cnt1 = x + (c < rem ? 1 : 0);
        long L; u.aux = 0;
        if (i < cnt1) L = (long)i * G + c; else if (ext > 0 && c >= rb && i - cnt1 < 2) L = (long)x * G + rem + 2 * (c - rb) + (i - cnt1); else return false;
        if (L < 64 * NT8) { int pm, pn; gg::tile_order(L, 64, NT8 > 0 ? NT8 : 1, pm, pn); pn = map_tile(pn, true);
            u.kind = 0; u.pm = pm; u.pn = pn; u.A = hn8 + (size_t)pm * 256 * D; u.B = wreg + w_row_off(256 * pn); return true; }
        L -= 64 * NT8;
        if (V_I8 && L < 512) { u.kind = 1; u.pm = (int)(L % 8); u.pn = (int)(L / 8); u.A = wreg + w_row_off(O_VG + 256 * u.pm); u.B = hn8 + (size_t)u.pn * 256 * D; return true; }
        return false;
    }
};
__device__ __forceinline__ size_t gt_off(int pm, int gtile, int ai, int m, int bj, int wid, int lane) { return ((size_t)(pm * 48 + gtile) * 128 + (size_t)(((ai * 4 + m) * 2 + bj) * 8 + wid)) * 512 + (size_t)lane * 8; }
struct I8Epi {
    unsigned char* ws; const float* bgate;
    __device__ __forceinline__ int nst(const gg::Unit& u) const { return 16; }
    __device__ __forceinline__ bool operator()(gg::Acc& acc, const gg::Unit& u, int wr, int wc, int fr, int fq, int wid, int lane) const {
        bf16_t* base; int ldc, col0, mode = 0; const int row0 = u.pm * 256; const float *rs, *cs;
        const float* shn = (const float*)(ws + WS_SHN); const float* sw = (const float*)(ws + WS_SW);
        if (u.kind == 0) { const int c0 = u.pn * 256; rs = shn + row0; cs = sw + c0;
            if (c0 < O_KG) { base = (bf16_t*)(ws + WS_QG); ldc = 1024; col0 = c0; }
            else if (c0 < O_VG) { base = (bf16_t*)(ws + WS_KG); ldc = 1024; col0 = c0 - O_KG; }
            else if (c0 < O_CB) { base = (bf16_t*)(ws + WS_RG); ldc = 2048; col0 = c0 - O_RG; }
            else if (c0 < O_CC) { base = (bf16_t*)(ws + WS_CB); ldc = 2048; col0 = c0 - O_CB; }
            else if (c0 < O_CH) { base = (bf16_t*)(ws + WS_CC); ldc = 2048; col0 = c0 - O_CC; }
            else if (c0 < O_QX) { base = (bf16_t*)(ws + WS_CH); ldc = 2048; col0 = c0 - O_CH; }
            else { base = (bf16_t*)(ws + WS_GT); ldc = 12288; col0 = c0 - O_GT; mode = 1; }
        } else { base = (bf16_t*)(ws + WS_VT); ldc = T; col0 = u.pn * 256; rs = sw + O_VG + row0; cs = shn + col0; }
        float rvv[2][4]; f32x4 cv[2][2], bv[2][2];
#pragma unroll
        for (int ai = 0; ai < 2; ++ai)
#pragma unroll
            for (int m = 0; m < 4; ++m) rvv[ai][m] = rs[ai * 128 + wr * 64 + m * 16 + fr];
#pragma unroll
        for (int bj = 0; bj < 2; ++bj) { const float* cp = cs + bj * 128 + wc * 32 + 8 * fq; cv[bj][0] = *(const f32x4*)cp; cv[bj][1] = *(const f32x4*)(cp + 4);
            bv[bj][0] = (f32x4){0.f, 0.f, 0.f, 0.f}; bv[bj][1] = bv[bj][0];
            if (mode == 1) { const float* bp = bgate + col0 + bj * 128 + wc * 32 + 8 * fq; bv[bj][0] = *(const f32x4*)bp; bv[bj][1] = *(const f32x4*)(bp + 4); } }
#pragma unroll
        for (int bj = 0; bj < 2; ++bj) { const f32x4 c0v = cv[bj][0], c1v = cv[bj][1], b0 = bv[bj][0], b1 = bv[bj][1];
#pragma unroll
            for (int ai = 0; ai < 2; ++ai)
#pragma unroll
                for (int m = 0; m < 4; ++m) { const int r = ai * 128 + wr * 64 + m * 16 + fr; const float rv = rvv[ai][m];
                    const i32x4 i0 = __builtin_bit_cast(i32x4, acc[ai][bj][m][0]), i1 = __builtin_bit_cast(i32x4, acc[ai][bj][m][1]);
                    f32x4 v0 = (f32x4){(float)i0[0], (float)i0[1], (float)i0[2], (float)i0[3]} * (c0v * rv) + b0, v1 = (f32x4){(float)i1[0], (float)i1[1], (float)i1[2], (float)i1[3]} * (c1v * rv) + b1;
                    if (mode == 1) {
#pragma unroll
                        for (int j = 0; j < 4; ++j) { v0[j] = inv_sigmoid(v0[j]); v1[j] = inv_sigmoid(v1[j]); } }
                    u32x4 w; w.x = pk2(v0[0], v0[1]); w.y = pk2(v0[2], v0[3]); w.z = pk2(v1[0], v1[1]); w.w = pk2(v1[2], v1[3]);
                    if (mode == 1) *(u32x4*)(base + gt_off(u.pm, col0 >> 8, ai, m, bj, wid, lane)) = w;
                    else *(u32x4*)(base + (size_t)(row0 + r) * ldc + col0 + bj * 128 + wc * 32 + 8 * fq) = w; } }
        return true;
    }
};
struct P1Epi {
    unsigned char* ws; const float* bgate;
    __device__ __forceinline__ int nst(const gg::Unit& u) const { return 0; }
    __device__ __forceinline__ bool operator()(gg::Acc& acc, const gg::Unit& u, int wr, int wc, int fr, int fq, int wid, int lane) const {
        bf16_t* base; int ldc, col0, mode = 0; const int row0 = u.pm * 256;
        if (u.kind == 0) { const int c0 = u.pn * 256;
            if (c0 < O_KG) { base = (bf16_t*)(ws + WS_QG); ldc = 1024; col0 = c0; }
            else if (c0 < O_VG) { base = (bf16_t*)(ws + WS_KG); ldc = 1024; col0 = c0 - O_KG; }
            else if (c0 < O_CB) { base = (bf16_t*)(ws + WS_RG); ldc = 2048; col0 = c0 - O_RG; }
            else if (c0 < O_CC) { base = (bf16_t*)(ws + WS_CB); ldc = 2048; col0 = c0 - O_CB; }
            else if (c0 < O_CH) { base = (bf16_t*)(ws + WS_CC); ldc = 2048; col0 = c0 - O_CC; }
            else if (c0 < O_QX) { base = (bf16_t*)(ws + WS_CH); ldc = 2048; col0 = c0 - O_CH; }
            else if (c0 < O_GT) { base = (bf16_t*)(ws + WS_QX); ldc = 2048; col0 = c0 - O_QX; }
            else if (c0 < O_AL) { base = (bf16_t*)(ws + WS_GT); ldc = 12288; col0 = c0 - O_GT; mode = 1; }
            else { base = nullptr; ldc = 0; col0 = 0; mode = 2; }
        } else if (u.kind == 1) { base = (bf16_t*)(ws + WS_VT); ldc = T; col0 = u.pn * 256; }
        else { base = (bf16_t*)(ws + WS_KVM); ldc = 4096; col0 = u.pn * 256; }
        if (mode == 0) { gg::store_bf16_tile(acc, base, ldc, row0, col0, wr, wc, fr, fq); }
        else if (mode == 1) {
#pragma unroll
            for (int bj = 0; bj < 2; ++bj) { const float* bp = bgate + col0 + bj * 128 + wc * 32 + 8 * fq; const f32x4 b0 = *(const f32x4*)bp, b1 = *(const f32x4*)(bp + 4);
#pragma unroll
                for (int ai = 0; ai < 2; ++ai)
#pragma unroll
                    for (int m = 0; m < 4; ++m) { f32x4 v0 = acc[ai][bj][m][0] + b0, v1 = acc[ai][bj][m][1] + b1;
#pragma unroll
                        for (int j = 0; j < 4; ++j) { v0[j] = inv_sigmoid(v0[j]); v1[j] = inv_sigmoid(v1[j]); }
                        u32x4 w; w.x = pk2(v0[0], v0[1]); w.y = pk2(v0[2], v0[3]); w.z = pk2(v1[0], v1[1]); w.w = pk2(v1[2], v1[3]);
                        *(u32x4*)(base + gt_off(u.pm, col0 >> 8, ai, m, bj, wid, lane)) = w; } }
        } else {
            if (wc == 0 && fq < 2) { float* alr = (float*)(ws + WS_ALR);
#pragma unroll
                for (int ai = 0; ai < 2; ++ai)
#pragma unroll
                    for (int m = 0; m < 4; ++m) { float* p = alr + (size_t)(row0 + ai * 128 + wr * 64 + m * 16 + fr) * 16 + 8 * fq;
                        *(f32x4*)p = acc[ai][0][m][0]; *(f32x4*)(p + 4) = acc[ai][0][m][1]; } }
        }
        return true;
    }
};

constexpr int PREP_ROWB = 528;
constexpr int PREP_QT = 0, PREP_KI = 2 * 64 * PREP_ROWB, PREP_ALR = 4 * 64 * PREP_ROWB;
constexpr int PREP_KOT_ROWB = 144;
__device__ __forceinline__ void gla_prep_unit(Frame& F, const Args& a, int unit) {
    const int hp = unit & 1, n = (unit >> 1) & 63, b = unit >> 7;
    const int tid = F.tid, hh = tid >> 8, c = tid & 255, h = 2 * hp + hh, lane = F.lane, wid = F.wave;
    const int tok0 = b * SEQ + n * 64;
    unsigned char* ws = F.ws;
    LAS float* alr_s = (LAS float*)(F.lds + PREP_ALR);
    LAS unsigned char* qt_s = F.lds + PREP_QT + hh * 64 * PREP_ROWB;
    LAS unsigned char* ki_s = F.lds + PREP_KI + hh * 64 * PREP_ROWB;
    if (tid < 256) ((LAS f32x4*)alr_s)[tid] = ((const f32x4*)((const float*)(ws + WS_ALR) + (size_t)tok0 * 16))[tid];
    float w[16];
#pragma unroll
    for (int r = 0; r < 16; ++r) w[r] = a.in[4][r * 1024 + h * 256 + c];
    const float ba = a.in[5][h * 256 + c];
    __syncthreads();
    float bt[64]; float cum = 0.f;
#pragma unroll
    for (int t = 0; t < 64; ++t) {
        float z = ba;
#pragma unroll
        for (int r = 0; r < 16; ++r) z += alr_s[t * 16 + r] * w[r];
        const float ls = fminf(z, 0.f) - __logf(1.0f + __expf(-fabsf(z)));
        cum += ls * (1.0f / 16.0f); bt[t] = cum;
    }
    const bf16_t* qg = (const bf16_t*)(ws + WS_QG) + (size_t)tok0 * 1024 + h * 256 + c;
    const bf16_t* kg = (const bf16_t*)(ws + WS_KG) + (size_t)tok0 * 1024 + h * 256 + c;
#pragma unroll
    for (int t = 0; t < 64; ++t) {
        const float q = bf2f(qg[(size_t)t * 1024]), k = bf2f(kg[(size_t)t * 1024]);
        const float eb = __expf(bt[t]);
        *(LAS bf16_t*)(qt_s + t * PREP_ROWB + c * 2) = (bf16_t)f2bf(q * eb * 0.0625f);
        *(LAS bf16_t*)(ki_s + t * PREP_ROWB + c * 2) = (bf16_t)f2bf(k * __expf(-bt[t]));
    }
    unsigned char* blk = ws + WS_GLAB + (size_t)((b * 4 + h) * 64 + n) * GLA_BLK;
    ((float*)(blk + 73728))[c] = __expf(cum);
    __syncthreads();
    {
        const int whh = wid >> 2, mb = wid & 3, fr = lane & 15, fq = lane >> 4;
        LAS unsigned char* qs = F.lds + PREP_QT + whh * 64 * PREP_ROWB; LAS unsigned char* ks = F.lds + PREP_KI + whh * 64 * PREP_ROWB;
        unsigned char* wblk = ws + WS_GLAB + (size_t)((b * 4 + 2 * hp + whh) * 64 + n) * GLA_BLK;
        bf16_t* attf = (bf16_t*)(wblk + 65536);
#pragma unroll
        for (int nb = 0; nb < 4; ++nb) {
            f32x4 acc = (f32x4){0.f, 0.f, 0.f, 0.f};
            if (nb <= mb) {
#pragma unroll
                for (int kk = 0; kk < 8; ++kk) {
                    const bf16x8 av = *(const LAS bf16x8*)(qs + (16 * mb + fr) * PREP_ROWB + (32 * kk + 8 * fq) * 2);
                    const bf16x8 bv = *(const LAS bf16x8*)(ks + (16 * nb + fr) * PREP_ROWB + (32 * kk + 8 * fq) * 2);
                    acc = __builtin_amdgcn_mfma_f32_16x16x32_bf16(av, bv, acc, 0, 0, 0);
                }
            }
            const int s = 16 * nb + fr;
#pragma unroll
            for (int j = 0; j < 4; ++j) { const int t = 16 * mb + 4 * fq + j; const float v = (s <= t) ? acc[j] : 0.f;
                attf[((mb * 2 + (s >> 5)) * 64 + (t & 15) + 16 * ((s & 31) >> 3)) * 8 + (s & 7)] = (bf16_t)f2bf(v); }
        }
        u32x4* qtf = (u32x4*)wblk;
#pragma unroll
        for (int i = 0; i < 8; ++i) { const int f = (wid & 3) * 8 + i, mb2 = f >> 3, kk = f & 7;
            const LAS unsigned char* rowp = qs + (16 * mb2 + fr) * PREP_ROWB + (32 * kk + 4 * fq) * 2;
            const u32x2 lo = *(const LAS u32x2*)rowp, hi = *(const LAS u32x2*)(rowp + 32);
            u32x4 o; o.x = lo.x; o.y = lo.y; o.z = hi.x; o.w = hi.y; qtf[f * 64 + lane] = o; }
    }
    __syncthreads();
    {
        LAS unsigned char* kot = F.lds + hh * 256 * PREP_KOT_ROWB + c * PREP_KOT_ROWB;
#pragma unroll
        for (int t8 = 0; t8 < 8; ++t8) { float v[8];
#pragma unroll
            for (int j = 0; j < 8; ++j) { const int t = t8 * 8 + j; v[j] = bf2f(kg[(size_t)t * 1024]) * __expf(cum - bt[t]); }
            u32x4 o; o.x = pk2(v[0], v[1]); o.y = pk2(v[2], v[3]); o.z = pk2(v[4], v[5]); o.w = pk2(v[6], v[7]);
            *(LAS u32x4*)(kot + t8 * 16) = o; }
    }
    __syncthreads();
    {
        const int whh = wid >> 2, fr = lane & 15, fq = lane >> 4;
        unsigned char* wblk = ws + WS_GLAB + (size_t)((b * 4 + 2 * hp + whh) * 64 + n) * GLA_BLK;
        u32x4* kof = (u32x4*)(wblk + 32768);
        const LAS unsigned char* kb = F.lds + whh * 256 * PREP_KOT_ROWB;
#pragma unroll
        for (int i = 0; i < 8; ++i) { const int f = (wid & 3) * 8 + i, mbc = f >> 1, kk2 = f & 1;
            kof[f * 64 + lane] = *(const LAS u32x4*)(kb + (16 * mbc + fr) * PREP_KOT_ROWB + (32 * kk2 + 8 * fq) * 2); }
    }
    __syncthreads();
}

__device__ __forceinline__ void conv_phase(Frame& F, const Args& a, int wg, int nwg) {
    unsigned char* ws = F.ws;
    const size_t gt = (size_t)wg * 512 + F.tid, ngt = (size_t)nwg * 512;
    u32x4* cb = (u32x4*)(ws + WS_CB); const u32x4* cc = (const u32x4*)(ws + WS_CC); const u32x4* ch = (const u32x4*)(ws + WS_CH);
    const float* cw = a.in[7];
    for (size_t p = gt; p < (size_t)T * 256; p += ngt) {
        const int t = (int)(p >> 8), c8 = (int)(p & 255) * 8, pos = t & (SEQ - 1);
        float accv[8];
#pragma unroll
        for (int j = 0; j < 8; ++j) accv[j] = 0.f;
#pragma unroll
        for (int d = 0; d < 3; ++d) {
            if (pos >= d) { const u32x4 x = cc[p - (size_t)d * 256], y = ch[p - (size_t)d * 256];
                const f32x4 w0 = *(const f32x4*)(cw + d * 2048 + c8), w1 = *(const f32x4*)(cw + d * 2048 + c8 + 4);
                accv[0] += w0.x * (bflo(x.x) * bflo(y.x)); accv[1] += w0.y * (bfhi(x.x) * bfhi(y.x));
                accv[2] += w0.z * (bflo(x.y) * bflo(y.y)); accv[3] += w0.w * (bfhi(x.y) * bfhi(y.y));
                accv[4] += w1.x * (bflo(x.z) * bflo(y.z)); accv[5] += w1.y * (bfhi(x.z) * bfhi(y.z));
                accv[6] += w1.z * (bflo(x.w) * bflo(y.w)); accv[7] += w1.w * (bfhi(x.w) * bfhi(y.w)); }
        }
        const u32x4 bv = cb[p]; u32x4 o;
        o.x = pk2(bflo(bv.x) * accv[0], bfhi(bv.x) * accv[1]); o.y = pk2(bflo(bv.y) * accv[2], bfhi(bv.y) * accv[3]);
        o.z = pk2(bflo(bv.z) * accv[4], bfhi(bv.z) * accv[5]); o.w = pk2(bflo(bv.w) * accv[6], bfhi(bv.w) * accv[7]);
        cb[p] = o;
    }
}

struct XsSched {
    const char *hn, *wkt; int G, c;
    __device__ __forceinline__ bool next(int i, gg::Unit& u) const {
        const long L = (long)i * G + c; if (L >= 256) return false;
        const int xcd = (int)(L % 8), off = (int)(L / 8), w = xcd * 32 + off;
        const int pm = w >> 2, h = w & 3, b = pm >> 4;
        u.kind = 0; u.pm = pm; u.pn = h; u.aux = 0;
        u.A = hn + (size_t)pm * 256 * D * 2; u.B = wkt + ((size_t)(b * 1024 + h * 256) * D) * 2; return true;
    }
};
struct WkSched {
    const char *kvm, *wqx; int G, c;
    __device__ __forceinline__ bool next(int i, gg::Unit& u) const {
        const long L = (long)i * G + c; if (L >= 256) return false;
        const int bh = (int)(L >> 4), ntile = (int)(L & 15), b = bh >> 2, h = bh & 3;
        u.kind = 0; u.pm = b * 4 + h; u.pn = ntile; u.aux = 0;
        u.A = kvm + ((size_t)(b * 256) * 4096 + h * 512) * 2; u.B = wqx + ((size_t)(ntile * 256) * 2048 + h * 512) * 2; return true;
    }
};
struct WkEpi {
    bf16_t* wkt;
    __device__ __forceinline__ int nst(const gg::Unit& u) const { return 16; }
    __device__ __forceinline__ bool operator()(gg::Acc& acc, const gg::Unit& u, int wr, int wc, int fr, int fq, int wid, int lane) const {
        gg::store_bf16_tile(acc, wkt, D, u.pm * 256, u.pn * 256, wr, wc, fr, fq); return true;
    }
};
struct XsEpi {
    bf16_t* prob; LAS unsigned char* ex;
    __device__ __forceinline__ int nst(const gg::Unit& u) const { return 0; }
    __device__ __forceinline__ bool operator()(gg::Acc& acc, const gg::Unit& u, int wr, int wc, int fr, int fq, int wid, int lane) const {
        LAS float* MX = (LAS float*)ex; LAS float* SM = (LAS float*)(ex + 4096);
        const float sc = 0.04419417382f * 1.44269504089f;
#pragma unroll
        for (int ai = 0; ai < 2; ++ai)
#pragma unroll
            for (int m = 0; m < 4; ++m) { float v = -3.0e38f;
#pragma unroll
                for (int bj = 0; bj < 2; ++bj)
#pragma unroll
                    for (int n = 0; n < 2; ++n) { const f32x4 x = acc[ai][bj][m][n]; v = fmaxf(v, fmaxf(fmaxf(x[0], x[1]), fmaxf(x[2], x[3]))); }
                v = fmaxf(v, __shfl_xor(v, 16)); v = fmaxf(v, __shfl_xor(v, 32));
                if (fq == 0) MX[(ai * 128 + wr * 64 + m * 16 + fr) * 4 + wc] = v; }
        LDS_WAIT(); __builtin_amdgcn_s_barrier(); asm volatile("" ::: "memory");
#pragma unroll
        for (int ai = 0; ai < 2; ++ai)
#pragma unroll
            for (int m = 0; m < 4; ++m) { const f32x4 q = *(const LAS f32x4*)(MX + (ai * 128 + wr * 64 + m * 16 + fr) * 4);
                const float rm = fmaxf(fmaxf(q[0], q[1]), fmaxf(q[2], q[3])); float s = 0.f;
#pragma unroll
                for (int bj = 0; bj < 2; ++bj)
#pragma unroll
                    for (int n = 0; n < 2; ++n) {
#pragma unroll
                        for (int j = 0; j < 4; ++j) { const float e = __builtin_amdgcn_exp2f((acc[ai][bj][m][n][j] - rm) * sc); acc[ai][bj][m][n][j] = e; s += e; } }
                s += __shfl_xor(s, 16); s += __shfl_xor(s, 32);
                if (fq == 0) SM[(ai * 128 + wr * 64 + m * 16 + fr) * 4 + wc] = s; }
        LDS_WAIT(); __builtin_amdgcn_s_barrier(); asm volatile("" ::: "memory");
        const int b = u.pm >> 4, panel = u.pm & 15, h = u.pn;
#pragma unroll
        for (int ai = 0; ai < 2; ++ai)
#pragma unroll
            for (int m = 0; m < 4; ++m) { const f32x4 q = *(const LAS f32x4*)(SM + (ai * 128 + wr * 64 + m * 16 + fr) * 4);
                const float inv = 1.0f / ((q[0] + q[1]) + (q[2] + q[3]));
                bf16_t* rowp = prob + (size_t)(b * SEQ + panel * 256 + ai * 128 + wr * 64 + m * 16 + fr) * 2048 + h * 256 + wc * 32 + 8 * fq;
#pragma unroll
                for (int bj = 0; bj < 2; ++bj) { const f32x4 v0 = acc[ai][bj][m][0] * inv, v1 = acc[ai][bj][m][1] * inv;
                    u32x4 w; w.x = pk2(v0[0], v0[1]); w.y = pk2(v0[2], v0[3]); w.z = pk2(v1[0], v1[1]); w.w = pk2(v1[2], v1[3]);
                    *(u32x4*)(rowp + bj * 128) = w; } }
        return true;
    }
};

__device__ __forceinline__ void gla_scan_unit(Frame& F, const Args& a, int unit) {
    const int dvq = (unit >> 3) & 3, bh = (unit & 7) + 8 * (unit >> 5), h = bh & 3, b = bh >> 2;
    const int lane = F.lane, wid = F.wave, fr = lane & 15, fq = lane >> 4;
    unsigned char* ws = F.ws;
    const unsigned char* blk0 = ws + WS_GLAB + (size_t)((b * 4 + h) * 64) * GLA_BLK;
    const int dvcol = 16 * (8 * dvq + wid);
    const bf16_t* vt = (const bf16_t*)(ws + WS_VT) + (size_t)(h * 512 + dvcol + fr) * T + (size_t)b * SEQ + 8 * fq;
    bf16_t* og = (bf16_t*)(ws + WS_OG) + (size_t)(b * SEQ) * 2048 + h * 512 + dvcol + fr;
    f32x4 S[16];
#pragma unroll
    for (int i = 0; i < 16; ++i) S[i] = (f32x4){0.f, 0.f, 0.f, 0.f};
    for (int p = wid; p < 73; p += 8)
        __builtin_amdgcn_global_load_lds((const unsigned*)(blk0 + (size_t)p * 1024 + lane * 16), (LAS unsigned*)(F.lds + p * 1024), 16, 0, 0);
    bf16x8 vf[2], vn[2];
    vf[0] = *(const bf16x8*)(vt); vf[1] = *(const bf16x8*)(vt + 32);
    vn[0] = vf[0]; vn[1] = vf[1];
    VM_WAIT(); __syncthreads();
    for (int n = 0; n < 64; ++n) {
        LAS unsigned char* buf = F.lds + (n & 1) * GLA_BLK;
        if (n < 63) {
            const unsigned char* nb = blk0 + (size_t)(n + 1) * GLA_BLK; LAS unsigned char* dst = F.lds + ((n + 1) & 1) * GLA_BLK;
            for (int p = wid; p < 73; p += 8)
                __builtin_amdgcn_global_load_lds((const unsigned*)(nb + (size_t)p * 1024 + lane * 16), (LAS unsigned*)(dst + p * 1024), 16, 0, 0);
            vn[0] = *(const bf16x8*)(vt + 64 * (n + 1)); vn[1] = *(const bf16x8*)(vt + 64 * (n + 1) + 32);
        }
        f32x4 o[4];
#pragma unroll
        for (int mb = 0; mb < 4; ++mb) o[mb] = (f32x4){0.f, 0.f, 0.f, 0.f};
#pragma unroll
        for (int kk = 0; kk < 8; ++kk) {
            u32x4 bw; bw.x = pk2(S[2 * kk][0], S[2 * kk][1]); bw.y = pk2(S[2 * kk][2], S[2 * kk][3]); bw.z = pk2(S[2 * kk + 1][0], S[2 * kk + 1][1]); bw.w = pk2(S[2 * kk + 1][2], S[2 * kk + 1][3]);
            const bf16x8 bfr = __builtin_bit_cast(bf16x8, bw);
#pragma unroll
            for (int mb = 0; mb < 4; ++mb) { const bf16x8 af = *(const LAS bf16x8*)(buf + ((mb * 8 + kk) * 64 + lane) * 16);
                o[mb] = __builtin_amdgcn_mfma_f32_16x16x32_bf16(af, bfr, o[mb], 0, 0, 0); }
        }
#pragma unroll
        for (int kk = 0; kk < 2; ++kk)
#pragma unroll
            for (int mb = 0; mb < 4; ++mb) { const bf16x8 af = *(const LAS bf16x8*)(buf + 65536 + ((mb * 2 + kk) * 64 + lane) * 16);
                o[mb] = __builtin_amdgcn_mfma_f32_16x16x32_bf16(af, vf[kk], o[mb], 0, 0, 0); }
        {
            bf16_t* op = og + (size_t)(64 * n) * 2048;
#pragma unroll
            for (int mb = 0; mb < 4; ++mb)
#pragma unroll
                for (int j = 0; j < 4; ++j) op[(size_t)(16 * mb + 4 * fq + j) * 2048] = (bf16_t)f2bf(o[mb][j]);
        }
#pragma unroll
        for (int mb = 0; mb < 16; ++mb) {
            const f32x4 dc = *(const LAS f32x4*)(buf + 73728 + (16 * mb + 4 * fq) * 4);
            S[mb] = S[mb] * dc;
#pragma unroll
            for (int kk = 0; kk < 2; ++kk) { const bf16x8 af = *(const LAS bf16x8*)(buf + 32768 + ((mb * 2 + kk) * 64 + lane) * 16);
                S[mb] = __builtin_amdgcn_mfma_f32_16x16x32_bf16(af, vf[kk], S[mb], 0, 0, 0); }
        }
        vf[0] = vn[0]; vf[1] = vn[1];
        VM_WAIT(); __syncthreads();
    }
}

struct VwSched {
    const char *wxa, *kvm; int G, c;
    __device__ __forceinline__ bool next(int i, gg::Unit& u) const {
        const long L = (long)i * G + c; if (L >= 256) return false;
        const int bh = (int)(L >> 4), pm = (int)(L & 15), b = bh >> 2, h = bh & 3;
        u.kind = 0; u.pm = b * 16 + pm; u.pn = h; u.aux = 0;
        u.A = wxa + ((size_t)(pm * 256) * 2048 + h * 512) * 2; u.B = kvm + ((size_t)(b * 256) * 4096 + 2048 + h * 512) * 2; return true;
    }
};
struct VwEpi {
    bf16_t* vwt;
    __device__ __forceinline__ int nst(const gg::Unit& u) const { return 16; }
    __device__ __forceinline__ bool operator()(gg::Acc& acc, const gg::Unit& u, int wr, int wc, int fr, int fq, int wid, int lane) const {
        gg::store_bf16_tile(acc, vwt, 2048, u.pm * 256, u.pn * 256, wr, wc, fr, fq); return true;
    }
};

__device__ __forceinline__ void gla_post_phase(Frame& F, const Args& a) {
    unsigned char* ws = F.ws;
    const int gw = F.bid * 8 + F.wave, NGW = F.G * 8, lane = F.lane;
    const float* gn = a.in[6];
    const f32x4 g0 = *(const f32x4*)(gn + lane * 8), g1 = *(const f32x4*)(gn + lane * 8 + 4);
    for (int t = gw; t < T; t += NGW) {
        const u32x4* orow = (const u32x4*)((const bf16_t*)(ws + WS_OG) + (size_t)t * 2048); u32x4* rrow = (u32x4*)((bf16_t*)(ws + WS_RG) + (size_t)t * 2048);
#pragma unroll
        for (int h = 0; h < 4; ++h) {
            const u32x4 ov = orow[h * 64 + lane], rv = rrow[h * 64 + lane];
            float o[8] = {bflo(ov.x), bfhi(ov.x), bflo(ov.y), bfhi(ov.y), bflo(ov.z), bfhi(ov.z), bflo(ov.w), bfhi(ov.w)};
            float r[8] = {bflo(rv.x), bfhi(rv.x), bflo(rv.y), bfhi(rv.y), bflo(rv.z), bfhi(rv.z), bflo(rv.w), bfhi(rv.w)};
            float s = 0.f;
#pragma unroll
            for (int j = 0; j < 8; ++j) s += o[j] * o[j];
            const float rstd = rsqrtf(wave_sum(s) * (1.f / 512.f) + EPS);
            const float gv[8] = {g0.x, g0.y, g0.z, g0.w, g1.x, g1.y, g1.z, g1.w};
            float y[8];
#pragma unroll
            for (int j = 0; j < 8; ++j) y[j] = o[j] * rstd * gv[j] * (r[j] * fast_sigmoid(r[j]));
            u32x4 w; w.x = pk2(y[0], y[1]); w.y = pk2(y[2], y[3]); w.z = pk2(y[4], y[5]); w.w = pk2(y[6], y[7]);
            rrow[h * 64 + lane] = w;
        }
    }
}

struct MgSched {
    const char *a0, *a1, *a2, *wbr, *vwt; int G, c;
    __device__ __forceinline__ bool next(int i, gg::Unit& u) const {
        const int ti = i / 3, br = i - 3 * ti; int pm, pn;
        if (!gg::tile_order((long)ti * G + c, 64, 16, pm, pn)) return false;
        u.kind = br; u.pm = pm; u.pn = pn; u.aux = br == 2 ? 16 : 32;
        const char* ab = br == 0 ? a0 : (br == 1 ? a1 : a2);
        u.A = ab + (size_t)pm * 256 * 2048 * 2;
        u.B = br == 2 ? vwt + ((size_t)((pm >> 4) * 4096 + pn * 256) * 2048) * 2 : wbr + (size_t)br * 16 * MiB + (size_t)pn * 256 * 2048 * 2; return true;
    }
};
struct MgEpi {
    const bf16_t* gt; bf16_t* merged;
    __device__ __forceinline__ int nst(const gg::Unit& u) const { return u.kind == 2 ? 16 : 0; }
    __device__ __forceinline__ bool operator()(gg::Acc& acc, const gg::Unit& u, int wr, int wc, int fr, int fq, int wid, int lane) const {
        const int br = u.kind;
#pragma unroll
        for (int ai = 0; ai < 2; ++ai) {
            u32x4 ga[4][2], gb[4][2];
#pragma unroll
            for (int m = 0; m < 4; ++m) { const size_t row = (size_t)(u.pm * 256 + ai * 128 + wr * 64 + m * 16 + fr);
#pragma unroll
                for (int bj = 0; bj < 2; ++bj) { const int col = u.pn * 256 + bj * 128 + wc * 32 + 8 * fq;
                    ga[m][bj] = *(const u32x4*)(gt + gt_off(u.pm, br * 16 + u.pn, ai, m, bj, wid, lane));
                    gb[m][bj] = (br < 2) ? *(const u32x4*)(gt + gt_off(u.pm, (br + 1) * 16 + u.pn, ai, m, bj, wid, lane)) : (u32x4){0x3f803f80u, 0x3f803f80u, 0x3f803f80u, 0x3f803f80u}; } }
#pragma unroll
            for (int m = 0; m < 4; ++m) { const size_t row = (size_t)(u.pm * 256 + ai * 128 + wr * 64 + m * 16 + fr);
#pragma unroll
                for (int bj = 0; bj < 2; ++bj) { const int col = u.pn * 256 + bj * 128 + wc * 32 + 8 * fq;
                    const u32x4 a4 = ga[m][bj], b4 = gb[m][bj];
                    float g[8] = {bflo(a4.x), bfhi(a4.x), bflo(a4.y), bfhi(a4.y), bflo(a4.z), bfhi(a4.z), bflo(a4.w), bfhi(a4.w)};
                    if (br < 2) { const float d[8] = {bflo(b4.x), bfhi(b4.x), bflo(b4.y), bfhi(b4.y), bflo(b4.z), bfhi(b4.z), bflo(b4.w), bfhi(b4.w)};
#pragma unroll
                        for (int j = 0; j < 8; ++j) g[j] = d[j] * __builtin_amdgcn_rcpf(g[j]); }
                    else {
#pragma unroll
                        for (int j = 0; j < 8; ++j) g[j] = __builtin_amdgcn_rcpf(g[j]); }
                    f32x4 v0 = acc[ai][bj][m][0], v1 = acc[ai][bj][m][1];
                    v0[0] *= g[0]; v0[1] *= g[1]; v0[2] *= g[2]; v0[3] *= g[3]; v1[0] *= g[4]; v1[1] *= g[5]; v1[2] *= g[6]; v1[3] *= g[7];
                    if (br < 2) { acc[ai][bj][m][0] = v0; acc[ai][bj][m][1] = v1; }
                    else { u32x4 w; w.x = pk2(v0[0], v0[1]); w.y = pk2(v0[2], v0[3]); w.z = pk2(v1[0], v1[1]); w.w = pk2(v1[2], v1[3]);
                        *(u32x4*)(merged + row * D + col) = w; } } }
        }
        return br == 2;
    }
};

struct GridSched {
    const char *A, *B; int nM, nN, lda2, ldb2, G, c;
    __device__ __forceinline__ bool next(int i, gg::Unit& u) const {
        int pm, pn; if (!gg::tile_order((long)i * G + c, nM, nN, pm, pn)) return false;
        u.kind = 0; u.pm = pm; u.pn = pn; u.aux = 0; u.A = A + (size_t)pm * 256 * lda2; u.B = B + (size_t)pn * 256 * ldb2; return true;
    }
};
struct ResEpi {
    const float* x; bf16_t* x1b;
    __device__ __forceinline__ int nst(const gg::Unit& u) const { return 16; }
    __device__ __forceinline__ bool operator()(gg::Acc& acc, const gg::Unit& u, int wr, int wc, int fr, int fq, int wid, int lane) const {
#pragma unroll
        for (int ai = 0; ai < 2; ++ai) {
            f32x4 xv[4][2][2];
#pragma unroll
            for (int m = 0; m < 4; ++m) { const size_t off = (size_t)(u.pm * 256 + ai * 128 + wr * 64 + m * 16 + fr) * D + u.pn * 256 + wc * 32 + 8 * fq;
#pragma unroll
                for (int bj = 0; bj < 2; ++bj) { xv[m][bj][0] = *(const f32x4*)(x + off + bj * 128); xv[m][bj][1] = *(const f32x4*)(x + off + bj * 128 + 4); } }
#pragma unroll
            for (int m = 0; m < 4; ++m) { const size_t off = (size_t)(u.pm * 256 + ai * 128 + wr * 64 + m * 16 + fr) * D + u.pn * 256 + wc * 32 + 8 * fq;
#pragma unroll
                for (int bj = 0; bj < 2; ++bj) { const f32x4 v0 = xv[m][bj][0] + acc[ai][bj][m][0], v1 = xv[m][bj][1] + acc[ai][bj][m][1];
                    u32x4 w; w.x = pk2(v0[0], v0[1]); w.y = pk2(v0[2], v0[3]); w.z = pk2(v1[0], v1[1]); w.w = pk2(v1[2], v1[3]);
                    *(u32x4*)(x1b + off + bj * 128) = w; } }
        }
        return true;
    }
};
struct PqEpi {
    bf16_t* o; const float* rs; const float* cs;
    __device__ __forceinline__ int nst(const gg::Unit& u) const { return 16; }
    __device__ __forceinline__ bool operator()(gg::Acc& acc, const gg::Unit& u, int wr, int wc, int fr, int fq, int wid, int lane) const {
        const int row0 = u.pm * 256, col0 = u.pn * 256;
        float rvv[2][4]; f32x4 cv[2][2];
#pragma unroll
        for (int ai = 0; ai < 2; ++ai)
#pragma unroll
            for (int m = 0; m < 4; ++m) rvv[ai][m] = rs[row0 + ai * 128 + wr * 64 + m * 16 + fr];
#pragma unroll
        for (int bj = 0; bj < 2; ++bj) { const float* cp = cs + col0 + bj * 128 + wc * 32 + 8 * fq; cv[bj][0] = *(const f32x4*)cp; cv[bj][1] = *(const f32x4*)(cp + 4); }
#pragma unroll
        for (int bj = 0; bj < 2; ++bj) { const f32x4 c0v = cv[bj][0], c1v = cv[bj][1];
#pragma unroll
            for (int ai = 0; ai < 2; ++ai)
#pragma unroll
                for (int m = 0; m < 4; ++m) { const int r = row0 + ai * 128 + wr * 64 + m * 16 + fr; const float rv = rvv[ai][m];
                    const i32x4 i0 = __builtin_bit_cast(i32x4, acc[ai][bj][m][0]), i1 = __builtin_bit_cast(i32x4, acc[ai][bj][m][1]);
                    const f32x4 v0 = (f32x4){(float)i0[0], (float)i0[1], (float)i0[2], (float)i0[3]} * (c0v * rv), v1 = (f32x4){(float)i1[0], (float)i1[1], (float)i1[2], (float)i1[3]} * (c1v * rv);
                    u32x4 w; w.x = pk2(v0[0], v0[1]); w.y = pk2(v0[2], v0[3]); w.z = pk2(v1[0], v1[1]); w.w = pk2(v1[2], v1[3]);
                    *(u32x4*)(o + (size_t)r * 2048 + col0 + bj * 128 + wc * 32 + 8 * fq) = w; } }
        return true;
    }
};
struct Bf16Epi {
    bf16_t* o; int ldc;
    __device__ __forceinline__ int nst(const gg::Unit& u) const { return 16; }
    __device__ __forceinline__ bool operator()(gg::Acc& acc, const gg::Unit& u, int wr, int wc, int fr, int fq, int wid, int lane) const {
        gg::store_bf16_tile(acc, o, ldc, u.pm * 256, u.pn * 256, wr, wc, fr, fq); return true;
    }
};

__device__ __forceinline__ int f2ord(float f) { const int b = __float_as_int(f); return b ^ ((b >> 31) & 0x7fffffff); }
__device__ __forceinline__ float ord2f(int o) { return __int_as_float(o ^ ((o >> 31) & 0x7fffffff)); }
__device__ __forceinline__ void cex_desc(int& hi, int& lo) { const int a = hi, b = lo; hi = a > b ? a : b; lo = a > b ? b : a; }
__device__ __forceinline__ void bsort16_desc(int (&a)[16]) {
#pragma unroll
    for (int k = 2; k <= 16; k <<= 1)
#pragma unroll
        for (int j = k >> 1; j > 0; j >>= 1)
#pragma unroll
            for (int i = 0; i < 16; ++i) { const int l = i ^ j; if (l > i) { if ((i & k) == 0) cex_desc(a[i], a[l]); else cex_desc(a[l], a[i]); } }
}
__device__ __forceinline__ void bmerge16_desc(int (&a)[16]) {
#pragma unroll
    for (int j = 8; j > 0; j >>= 1)
#pragma unroll
        for (int i = 0; i < 16; ++i) { const int l = i ^ j; if (l > i) cex_desc(a[i], a[l]); }
}
__device__ __forceinline__ void top16_merge(int (&a)[16], const int (&b)[16]) {
#pragma unroll
    for (int i = 0; i < 16; ++i) a[i] = a[i] > b[15 - i] ? a[i] : b[15 - i];
    bmerge16_desc(a);
}
constexpr int RT_SKROW = 272;
constexpr int RT_SK = 2 * 128 * RT_SKROW;
__device__ __forceinline__ void route_topk16(const f32x4 (&acc)[8], int fq, int (&res)[16]) {
    int a[16], b[16];
#pragma unroll
    for (int mb = 0; mb < 4; ++mb)
#pragma unroll
        for (int j = 0; j < 4; ++j) { a[mb * 4 + j] = (f2ord(acc[mb][j]) & ~127) | (127 - (16 * mb + 4 * fq + j)); b[mb * 4 + j] = (f2ord(acc[mb + 4][j]) & ~127) | (127 - (16 * (mb + 4) + 4 * fq + j)); }
    bsort16_desc(a); bsort16_desc(b); top16_merge(a, b);
#pragma unroll
    for (int x = 16; x <= 32; x <<= 1) {
#pragma unroll
        for (int i = 0; i < 16; ++i) b[i] = __shfl_xor(a[i], x);
        top16_merge(a, b);
    }
#pragma unroll
    for (int i = 0; i < 16; ++i) res[i] = a[i];
}
__device__ __forceinline__ void route_job(Frame& F, const Args& a, int job) {
    unsigned char* ws = F.ws;
    const int tid = F.tid, lane = F.lane, wid = F.wave, fr = lane & 15, fq = lane >> 4;
    const int h = job & 7, chunk = job >> 3;
    const bf16_t* pq = (const bf16_t*)(ws + WS_PQ); const bf16_t* sk = (const bf16_t*)(ws + WS_SUBK) + (size_t)h * 2 * 128 * 128;
    for (int p = tid; p < 4096; p += 512) { const int row = p >> 4, pc = p & 15; *(LAS u32x4*)(F.lds + row * RT_SKROW + pc * 16) = ((const u32x4*)sk)[p]; }
    __syncthreads();
    LAS int* IX = (LAS int*)(F.lds + RT_SK) + wid * 512;
#pragma unroll 1
    for (int it = 0; it < 4; ++it) {
        const int tok0 = (chunk * 32 + wid * 4 + it) * 16;
        int top[2][16];
#pragma unroll
        for (int c = 0; c < 2; ++c) {
            f32x4 acc[8];
#pragma unroll
            for (int mb = 0; mb < 8; ++mb) acc[mb] = (f32x4){0.f, 0.f, 0.f, 0.f};
            bf16x8 bfr[4];
#pragma unroll
            for (int kk = 0; kk < 4; ++kk) bfr[kk] = *(const bf16x8*)(pq + (size_t)(tok0 + fr) * 2048 + h * 256 + c * 128 + 32 * kk + 8 * fq);
#pragma unroll
            for (int kk = 0; kk < 4; ++kk)
#pragma unroll
                for (int mb = 0; mb < 8; ++mb) { const bf16x8 af = *(const LAS bf16x8*)(F.lds + (c * 128 + 16 * mb + fr) * RT_SKROW + (32 * kk + 8 * fq) * 2);
                    acc[mb] = __builtin_amdgcn_mfma_f32_16x16x32_bf16(af, bfr[kk], acc[mb], 0, 0, 0); }
            route_topk16(acc, fq, top[c]);
        }
        float f0[16], f1[16];
#pragma unroll
        for (int i = 0; i < 16; ++i) { f0[i] = ord2f(top[0][i] & ~127); f1[i] = ord2f(top[1][i] & ~127); }
        int g[4][16];
#pragma unroll
        for (int q = 0; q < 4; ++q)
#pragma unroll
            for (int i = 0; i < 16; ++i) g[q][i] = (int)0x80000000;
        {
            int nc = 0;
#pragma unroll
            for (int i = 0; i < 16; ++i)
#pragma unroll
                for (int j = 0; j < 16; ++j) if ((i + 1) * (j + 1) <= 16) { g[nc >> 4][nc & 15] = (f2ord(f0[i] + f1[j]) & ~255) | (255 - (i * 16 + j)); ++nc; }
        }
        bsort16_desc(g[0]); bsort16_desc(g[1]); bsort16_desc(g[2]); bsort16_desc(g[3]);
        top16_merge(g[0], g[1]); top16_merge(g[2], g[3]); top16_merge(g[0], g[2]);
        if (fq == 0) {
#pragma unroll
            for (int i = 0; i < 16; ++i) { IX[fr * 32 + i] = 127 - (top[0][i] & 127); IX[fr * 32 + 16 + i] = 127 - (top[1][i] & 127); }
        }
        LDS_WAIT(); asm volatile("" ::: "memory");
        if (fq == 0) {
            const float vmax = ord2f(g[0][0] & ~255); float e[16]; float s = 0.f; int ex[16];
#pragma unroll
            for (int r = 0; r < 16; ++r) { e[r] = __expf(ord2f(g[0][r] & ~255) - vmax); s += e[r]; const int ij = 255 - (g[0][r] & 255); ex[r] = IX[fr * 32 + (ij >> 4)] * 128 + IX[fr * 32 + 16 + (ij & 15)]; }
            const float inv = 1.0f / s;
            int* eidx = (int*)(ws + WS_EIDX) + (size_t)(tok0 + fr) * 128 + h * 16; float* gw = (float*)(ws + WS_GW) + (size_t)(tok0 + fr) * 128 + h * 16;
#pragma unroll
            for (int q = 0; q < 4; ++q) { *(u32x4*)(eidx + 4 * q) = (u32x4){(unsigned)ex[4 * q], (unsigned)ex[4 * q + 1], (unsigned)ex[4 * q + 2], (unsigned)ex[4 * q + 3]};
                *(f32x4*)(gw + 4 * q) = (f32x4){e[4 * q] * inv, e[4 * q + 1] * inv, e[4 * q + 2] * inv, e[4 * q + 3] * inv}; }
        }
        LDS_WAIT(); asm volatile("" ::: "memory");
    }
    __syncthreads();
}

__device__ __forceinline__ float ub0(unsigned w) { return (float)(w & 255u); }
__device__ __forceinline__ float ub1(unsigned w) { return (float)((w >> 8) & 255u); }
__device__ __forceinline__ float ub2(unsigned w) { return (float)((w >> 16) & 255u); }
__device__ __forceinline__ float ub3(unsigned w) { return (float)(w >> 24); }
#define P10_LOADU(buf, kbase) do { _Pragma("unroll") for (int r = 0; r < 4; ++r) { const int k_ = (kbase) + r; const int e_ = __builtin_amdgcn_readlane(k_ < 64 ? ev0 : ev1, k_ & 63); \
        const u32x4* rp_ = (const u32x4*)(ub + (size_t)e_ * 2048); buf[r][0] = rp_[lane]; buf[r][1] = rp_[64 + lane]; } } while (0)
#define P10_COMPU(buf, kbase) do { _Pragma("unroll") for (int r = 0; r < 4; ++r) { int s_ = 0; \
        _Pragma("unroll") for (int p = 0; p < 2; ++p) { const unsigned x0 = buf[r][p].x, x1 = buf[r][p].y, x2 = buf[r][p].z, x3 = buf[r][p].w; \
            s_ = __builtin_amdgcn_sdot4((int)(x0 & 0x0F0F0F0Fu), (int)hv[p][0].x, s_, false); s_ = __builtin_amdgcn_sdot4((int)((x0 >> 4) & 0x0F0F0F0Fu), (int)hv[p][0].y, s_, false); \
            s_ = __builtin_amdgcn_sdot4((int)(x1 & 0x0F0F0F0Fu), (int)hv[p][0].z, s_, false); s_ = __builtin_amdgcn_sdot4((int)((x1 >> 4) & 0x0F0F0F0Fu), (int)hv[p][0].w, s_, false); \
            s_ = __builtin_amdgcn_sdot4((int)(x2 & 0x0F0F0F0Fu), (int)hv[p][1].x, s_, false); s_ = __builtin_amdgcn_sdot4((int)((x2 >> 4) & 0x0F0F0F0Fu), (int)hv[p][1].y, s_, false); \
            s_ = __builtin_amdgcn_sdot4((int)(x3 & 0x0F0F0F0Fu), (int)hv[p][1].z, s_, false); s_ = __builtin_amdgcn_sdot4((int)((x3 >> 4) & 0x0F0F0F0Fu), (int)hv[p][1].w, s_, false); } \
        _Pragma("unroll") for (int o_ = 1; o_ < 64; o_ <<= 1) s_ += __shfl_xor(s_, o_); \
        const int k_ = (kbase) + r; const float av_ = (float)s_; if (k_ < 64) { if (lane == k_) a0 = av_; } else { if (lane == k_ - 64) a1 = av_; } } } while (0)
#define P10_LOADV(buf, kbase) do { _Pragma("unroll") for (int r = 0; r < 4; ++r) { const int k_ = (kbase) + r; const int e_ = __builtin_amdgcn_readlane(k_ < 64 ? ev0 : ev1, k_ & 63); \
        const u32x4* rp_ = (const u32x4*)(vb + (size_t)e_ * 2048); buf[r][0] = rp_[lane]; buf[r][1] = rp_[64 + lane]; } } while (0)
#define P10_COMPV(buf, grp) do { const int wq_ = __builtin_amdgcn_readlane(wqv, (grp)); \
        _Pragma("unroll") for (int p = 0; p < 2; ++p) { const unsigned xr_[4][4] = {{buf[0][p].x, buf[0][p].y, buf[0][p].z, buf[0][p].w}, {buf[1][p].x, buf[1][p].y, buf[1][p].z, buf[1][p].w}, {buf[2][p].x, buf[2][p].y, buf[2][p].z, buf[2][p].w}, {buf[3][p].x, buf[3][p].y, buf[3][p].z, buf[3][p].w}}; \
            _Pragma("unroll") for (int d = 0; d < 4; ++d) { int* oo = o + 32 * p + 8 * d; \
                _Pragma("unroll") for (int h = 0; h < 2; ++h) { \
                    const unsigned b0 = (xr_[0][d] >> (4 * h)) & 0x0F0F0F0Fu, b1 = (xr_[1][d] >> (4 * h)) & 0x0F0F0F0Fu, b2 = (xr_[2][d] >> (4 * h)) & 0x0F0F0F0Fu, b3 = (xr_[3][d] >> (4 * h)) & 0x0F0F0F0Fu; \
                    const unsigned a01 = __builtin_amdgcn_perm(b1, b0, 0x05010400u), c01 = __builtin_amdgcn_perm(b1, b0, 0x07030602u), a23 = __builtin_amdgcn_perm(b3, b2, 0x05010400u), c23 = __builtin_amdgcn_perm(b3, b2, 0x07030602u); \
                    const unsigned t0 = __builtin_amdgcn_perm(a23, a01, 0x05040100u), t1 = __builtin_amdgcn_perm(a23, a01, 0x07060302u), t2 = __builtin_amdgcn_perm(c23, c01, 0x05040100u), t3 = __builtin_amdgcn_perm(c23, c01, 0x07060302u); \
                    oo[0 + h] = __builtin_amdgcn_sdot4((int)t0, wq_, oo[0 + h], false); oo[2 + h] = __builtin_amdgcn_sdot4((int)t1, wq_, oo[2 + h], false); \
                    oo[4 + h] = __builtin_amdgcn_sdot4((int)t2, wq_, oo[4 + h], false); oo[6 + h] = __builtin_amdgcn_sdot4((int)t3, wq_, oo[6 + h], false); } } } } while (0)
__device__ __forceinline__ void peer_token_wave(const Args& a, unsigned char* ws, int tok, int lane) {
    const int* eidx = (const int*)(ws + WS_EIDX) + (size_t)tok * 128; const float* gw = (const float*)(ws + WS_GW) + (size_t)tok * 128;
    const int ev0 = eidx[lane], ev1 = eidx[64 + lane];
    u32x4 hv[2][2];
    const u32x4* hrow = (const u32x4*)(ws + WS_H8 + (size_t)tok * D);
#pragma unroll
    for (int p = 0; p < 2; ++p) { hv[p][0] = hrow[128 * p + 2 * lane]; hv[p][1] = hrow[128 * p + 2 * lane + 1]; }
    const float sh = ((const float*)(ws + WS_SH))[tok], shs = ((const float*)(ws + WS_SHS))[tok];
    const unsigned char* ub = ws + WS_UB; const float* su = (const float*)(ws + WS_SU); const float* sv = (const float*)(ws + WS_SV);
    float a0 = 0.f, a1 = 0.f;
    {
        u32x4 ua[4][2], uc[4][2];
        P10_LOADU(ua, 0);
#pragma unroll 1
        for (int kb = 0; kb < 128; kb += 8) {
            P10_LOADU(uc, kb + 4);
            P10_COMPU(ua, kb);
            P10_LOADU(ua, (kb + 8) & 127);
            P10_COMPU(uc, kb + 4);
        }
    }
    float w0, w1;
    { const float x0 = (a0 - 8.0f * shs) * su[ev0] * sh, x1 = (a1 - 8.0f * shs) * su[ev1] * sh;
      w0 = gw[lane] * 0.5f * x0 * (1.0f + erff(x0 * 0.70710678118f)) * sv[ev0]; w1 = gw[64 + lane] * 0.5f * x1 * (1.0f + erff(x1 * 0.70710678118f)) * sv[ev1]; }
    const float wmax = fmaxf(wave_max(fmaxf(fabsf(w0), fabsf(w1))), 1e-30f), sw = wmax * (1.0f / 127.0f), winv = 127.0f / wmax;
    const int q0 = (int)rintf(w0 * winv), q1 = (int)rintf(w1 * winv);
    int qsum = q0 + q1;
#pragma unroll
    for (int o_ = 1; o_ < 64; o_ <<= 1) qsum += __shfl_xor(qsum, o_);
    int wqv;
    { const int base = (lane & 15) * 4;
      const int s0 = __shfl(lane < 16 ? q0 : q1, base + 0), s1 = __shfl(lane < 16 ? q0 : q1, base + 1), s2 = __shfl(lane < 16 ? q0 : q1, base + 2), s3 = __shfl(lane < 16 ? q0 : q1, base + 3);
      const int a0_ = __shfl(q0, base + 0), a1_ = __shfl(q0, base + 1), a2_ = __shfl(q0, base + 2), a3_ = __shfl(q0, base + 3);
      const int b0_ = __shfl(q1, base + 0), b1_ = __shfl(q1, base + 1), b2_ = __shfl(q1, base + 2), b3_ = __shfl(q1, base + 3);
      (void)s0; (void)s1; (void)s2; (void)s3;
      const bool lowhalf = (lane & 31) < 16;
      const int c0 = lowhalf ? a0_ : b0_, c1 = lowhalf ? a1_ : b1_, c2 = lowhalf ? a2_ : b2_, c3 = lowhalf ? a3_ : b3_;
      wqv = (c0 & 255) | ((c1 & 255) << 8) | ((c2 & 255) << 16) | ((c3 & 255) << 24); }
    int o[64];
#pragma unroll
    for (int j = 0; j < 64; ++j) o[j] = 0;
    const unsigned char* vb = ws + WS_VB;
    {
        u32x4 va[4][2], vc[4][2];
        P10_LOADV(va, 0);
#pragma unroll 1
        for (int kb = 0; kb < 128; kb += 8) {
            P10_LOADV(vc, kb + 4);
            P10_COMPV(va, kb >> 2);
            P10_LOADV(va, (kb + 8) & 127);
            P10_COMPV(vc, (kb >> 2) + 1);
        }
    }
    float* orow = a.out + (size_t)tok * D; const bf16_t* xrow = (const bf16_t*)(ws + WS_X1B) + (size_t)tok * D; float s = 0.f; const int corr = 8 * qsum; float y[64];
#pragma unroll
    for (int p = 0; p < 2; ++p)
#pragma unroll
        for (int q = 0; q < 8; ++q) { const u32x2 xu = *(const u32x2*)(xrow + 2048 * p + 256 * q + 4 * lane); const f32x4 x = (f32x4){bflo(xu.x), bfhi(xu.x), bflo(xu.y), bfhi(xu.y)}; const int* oo = o + 32 * p + 4 * q; float* yy = y + 32 * p + 4 * q;
            yy[0] = x.x + sw * (float)(oo[0] - corr); yy[1] = x.y + sw * (float)(oo[1] - corr); yy[2] = x.z + sw * (float)(oo[2] - corr); yy[3] = x.w + sw * (float)(oo[3] - corr);
            s += (yy[0] * yy[0] + yy[1] * yy[1]) + (yy[2] * yy[2] + yy[3] * yy[3]); }
    const float rstd = rsqrtf(wave_sum(s) * (1.f / D) + EPS);
#pragma unroll
    for (int p = 0; p < 2; ++p)
#pragma unroll
        for (int q = 0; q < 8; ++q) { const f32x4 g = *(const f32x4*)(a.in[20] + 2048 * p + 256 * q + 4 * lane); const float* yy = y + 32 * p + 4 * q;
            *(f32x4*)(orow + 2048 * p + 256 * q + 4 * lane) = (f32x4){yy[0] * rstd * g.x, yy[1] * rstd * g.y, yy[2] * rstd * g.z, yy[3] * rstd * g.w}; }
}

__global__ void __launch_bounds__(512, 2) mega_fwd(Args args) {
    extern __shared__ __attribute__((aligned(16))) unsigned char lds_raw[];
    Frame F;
    F.lds = (LAS unsigned char*)lds_raw;
    F.tid = threadIdx.x; F.lane = F.tid & 63; F.wave = __builtin_amdgcn_readfirstlane(F.tid >> 6);
    F.G = gridDim.x; F.bid = blockIdx.x; F.ws = args.ws;
    unsigned char* ws = args.ws;
    if (F.tid < 64) ((LAS unsigned*)(F.lds + LDS_MISC))[F.tid] = 0u;
    __syncthreads();
    XcdBarrier bar = xcd_barrier_post((unsigned*)(ws + WS_CTL) + 4096, (volatile LAS unsigned*)(F.lds + LDS_MISC + 32));

    F.refresh();
    p0_weights8(F, args);
    F.refresh();
    p0_prologue_a(F, args);
    xcd_barrier(bar);
    {
        P1Sched S{(const char*)(ws + WS_HN), (const char*)(ws + WS_W8), (const char*)(ws + WS_WAL), (const char*)(ws + WS_MEMN), (const char*)(ws + WS_WKV), F.G, F.bid};
        P1Epi E{ws, args.in[12]};
        gg::gemm_phase<0>(F.lds, D * 2, D * 2, 64, S, E);
        I8Sched S8{(const char*)(ws + WS_HN8), (const char*)(ws + WS_W8), F.G, F.bid};
        I8Epi E8{ws, args.in[12]};
        gg::gemm_phase<2, true>(F.lds, D, D, 32, S8, E8);
        xcd_barrier(bar);
    }
    F.refresh();
    for (int u = F.bid; u < 512; u += F.G) gla_prep_unit(F, args, u);
    {
        WkSched Sk{(const char*)(ws + WS_KVM), (const char*)(ws + WS_WQX), F.G, F.bid};
        WkEpi Ek{(bf16_t*)(ws + WS_WKT)};
        gg::gemm_phase<0>(F.lds, 8192, 4096, 8, Sk, Ek);
        VwSched Sv{(const char*)(ws + WS_WBR + 32 * MiB), (const char*)(ws + WS_KVM), F.G, F.bid};
        VwEpi Ev{(bf16_t*)(ws + WS_VWT)};
        gg::gemm_phase<0>(F.lds, 4096, 8192, 8, Sv, Ev);
    }
    xcd_barrier(bar);
    F.refresh();
    {
        {
            XsSched S{(const char*)(ws + WS_HN), (const char*)(ws + WS_WKT), F.G, F.bid};
            XsEpi E{(bf16_t*)(ws + WS_PROB), F.lds + LDS_EX};
            gg::gemm_phase<0>(F.lds, D * 2, D * 2, 64, S, E);
        }
        const int nscan = F.G >= 128 ? 64 : 0;
        if (nscan) { if (F.bid < 64) gla_scan_unit(F, args, F.bid); }
        else for (int u = F.bid; u < 64; u += F.G) gla_scan_unit(F, args, u);
        { const int nq = nscan ? F.G - 64 : F.G, cq = nscan ? F.bid - 64 : F.bid;
          if (cq >= 0) for (int e = cq * 8 + F.wave; e < 16384; e += nq * 8) {
              quant_row_i4(args.in[18] + (size_t)e * D, ws + WS_UB + (size_t)e * 2048, (float*)(ws + WS_SU) + e, F.lane);
              quant_row_i4_v(args.in[19] + (size_t)e * D, ws + WS_VB + (size_t)e * 2048, (float*)(ws + WS_SV) + e, F.lane); }
          if (cq >= 0) conv_phase(F, args, cq, nq); }
    }
    xcd_barrier(bar);
    F.refresh();
    gla_post_phase(F, args);
    F.refresh();
    peer_wq_convert(F, args);
    xcd_barrier(bar);
    {
        MgSched S{(const char*)(ws + WS_RG), (const char*)(ws + WS_CB), (const char*)(ws + WS_PROB), (const char*)(ws + WS_WBR), (const char*)(ws + WS_VWT), F.G, F.bid};
        MgEpi E{(const bf16_t*)(ws + WS_GT), (bf16_t*)(ws + WS_MERGED)};
        gg::gemm_phase<0, true>(F.lds, 4096, 4096, 32, S, E);
    }
    xcd_barrier(bar);
    {
        GridSched S{(const char*)(ws + WS_MERGED), (const char*)(ws + WS_WO), 64, 16, D * 2, D * 2, F.G, F.bid};
        ResEpi E{args.in[0], (bf16_t*)(ws + WS_X1B)};
        gg::gemm_phase<0, true>(F.lds, D * 2, D * 2, 64, S, E);
    }
    xcd_barrier(bar);
    F.refresh();
    {
        const int gw = F.bid * 8 + F.wave, NGW = F.G * 8;
        for (int m = gw; m < T; m += NGW) rms_row_i8((const bf16_t*)(ws + WS_X1B) + (size_t)m * D, args.in[15], ws + WS_H8 + (size_t)m * D, (float*)(ws + WS_SH) + m, (float*)(ws + WS_SHS) + m, F.lane);
    }
    xcd_barrier(bar);
    {
        GridSched S{(const char*)(ws + WS_H8), (const char*)(ws + WS_WPQ), 64, 8, D, D, F.G, F.bid};
        PqEpi E{(bf16_t*)(ws + WS_PQ), (const float*)(ws + WS_SH), (const float*)(ws + WS_SWPQ)};
        gg::gemm_phase<2, true>(F.lds, D, D, 32, S, E);
    }
    xcd_barrier(bar);
    F.refresh();
    for (int u = F.bid; u < 256; u += F.G) route_job(F, args, u);
    xcd_barrier(bar);
    F.refresh();
    for (int tok = F.bid * 8 + F.wave; tok < T; tok += F.G * 8) peer_token_wave(args, ws, tok, F.lane);
}


extern "C" void kernel_launch(void* const* d_in, const int* in_sizes, int n_in, void* d_out, int out_size, void* d_ws, size_t ws_size, hipStream_t stream) {
    static int grid = 0;
    if (grid == 0) {
        if (n_in != 21 || ws_size < WS_END) { fprintf(stderr, "kernel_launch: unexpected inputs (n_in %d, ws %zu < %zu)\n", n_in, ws_size, (size_t)WS_END); grid = -1; return; }
        int dev = 0, cus = 0, per_cu = 0;
        if (hipGetDevice(&dev) != hipSuccess || hipDeviceGetAttribute(&cus, hipDeviceAttributeMultiprocessorCount, dev) != hipSuccess) { grid = -1; return; }
        if (hipFuncSetAttribute((const void*)mega_fwd, hipFuncAttributeMaxDynamicSharedMemorySize, LDS_BYTES) != hipSuccess) { fprintf(stderr, "kernel_launch: hipFuncSetAttribute failed\n"); grid = -1; return; }
        if (hipOccupancyMaxActiveBlocksPerMultiprocessor(&per_cu, (const void*)mega_fwd, 512, LDS_BYTES) != hipSuccess || per_cu < 1)
            fprintf(stderr, "kernel_launch: occupancy query says %d\n", per_cu);
        (void)hipGetLastError();
        grid = cus;
    }
    if (grid < 0) return;
    Args a{};
    for (int i = 0; i < 21; ++i) a.in[i] = (const float*)d_in[i];
    a.out = (float*)d_out; a.ws = (unsigned char*)d_ws;
    hipMemsetAsync((char*)d_ws + WS_CTL, 0, CTL_BYTES, stream);
    hipLaunchKernelGGL(mega_fwd, dim3(grid), dim3(512), LDS_BYTES, stream, a);
}
```
